# Optimizing an MI355X kernel written in HIP

```python
import math
import jax
import jax.numpy as jnp
from jax import lax
import numpy as np

D_MODEL = 1024
BATCH = 16
SEQ = 4096
DEPTH = 4

GRID_W = 64
CTX_LEN = 256

SSM_WIDTH = D_MODEL // 4
SSM_GROUP = 16
SSM_GROUPS = SSM_WIDTH // SSM_GROUP
SSM_STATE = 64
SSM_DT_MIN = 0.001
SSM_DT_MAX = 0.1

DIFF_HEAD_DIM = 64
DIFF_V_DIM = 2 * DIFF_HEAD_DIM
DIFF_WIDTH = D_MODEL // 2
DIFF_HEADS = DIFF_WIDTH // DIFF_V_DIM
DIFF_QK_WIDTH = DIFF_HEADS * 2 * DIFF_HEAD_DIM
Q_BLOCK = 128

NA_WIDTH = D_MODEL - SSM_WIDTH - DIFF_WIDTH
NA_HEAD_DIM = 64
NA_HEADS = NA_WIDTH // NA_HEAD_DIM
NA_WIN_ROWS = 8
NA_WIN_COLS = 16

MIX_WIDTH = SSM_WIDTH + DIFF_WIDTH + NA_WIDTH
IN_SIZES = (SSM_WIDTH, DIFF_QK_WIDTH, DIFF_QK_WIDTH, DIFF_WIDTH, NA_WIDTH, NA_WIDTH, NA_WIDTH)
IN_WIDTH = sum(IN_SIZES)

ROPE_BASE = 10000.0
ROPE_AXIS_PAIRS = DIFF_HEAD_DIM // 4

D_FF = 2816
N_EXPERTS = 8
TOP_K = 2
D_FF_EXPERT = 2816

NORM_EPS = 1e-6
SUBLN_EPS = 1e-5
NEG_INF = -1e30

kernel_name = 'hybrid_s5_diffattn_natten_moe_dit'

F32 = jnp.float32


def rms_norm(x, g, eps=NORM_EPS):
    xf = x.astype(F32)
    xf = xf * lax.rsqrt(jnp.mean(xf * xf, axis=-1, keepdims=True) + eps)
    return (xf * g.astype(F32)).astype(x.dtype)


def modulate(h, shift, scale):
    return h * (1 + scale) + shift


def adaln(cond, w_mod, b_mod):
    m = jax.nn.silu(cond) @ w_mod + b_mod
    return jnp.split(m, 6, axis=-1)


def in_proj_split(p):
    idx = np.cumsum(IN_SIZES)[:-1].tolist()
    return jnp.split(p, idx, axis=-1)


def axial_rope_tables(n_tokens):
    t = jnp.arange(n_tokens, dtype=jnp.int32)
    row = (t // GRID_W).astype(F32)
    col = (t % GRID_W).astype(F32)
    inv = ROPE_BASE ** (-jnp.arange(ROPE_AXIS_PAIRS, dtype=F32) / ROPE_AXIS_PAIRS)
    ang = jnp.concatenate([row[:, None] * inv, col[:, None] * inv], axis=-1)
    return jnp.cos(ang), jnp.sin(ang)


def apply_axial_rope(t, cos, sin):
    L = t.shape[1]
    n_pairs = cos.shape[-1]
    bshape = (1, L) + (1,) * (t.ndim - 3) + (n_pairs,)
    cs = cos.reshape(bshape)
    sn = sin.reshape(bshape)
    tp = t.astype(F32).reshape(t.shape[:-1] + (n_pairs, 2))
    t0 = tp[..., 0]
    t1 = tp[..., 1]
    out = jnp.stack([t0 * cs - t1 * sn, t0 * sn + t1 * cs], axis=-1)
    return out.reshape(t.shape).astype(t.dtype)


def s5_discretise(lam_re, lam_im, b_re, b_im, log_step):
    lam_re = lam_re.astype(F32)
    lam_im = lam_im.astype(F32)
    dt = jnp.exp(log_step.astype(F32))[:, None]
    mag = jnp.exp(lam_re * dt)
    ab_re = mag * jnp.cos(lam_im * dt)
    ab_im = mag * jnp.sin(lam_im * dt)
    den = lam_re * lam_re + lam_im * lam_im
    n_re = ab_re - 1.0
    n_im = ab_im
    f_re = (n_re * lam_re + n_im * lam_im) / den
    f_im = (n_im * lam_re - n_re * lam_im) / den
    b_re = b_re.astype(F32)
    b_im = b_im.astype(F32)
    bb_re = f_re[..., None] * b_re - f_im[..., None] * b_im
    bb_im = f_re[..., None] * b_im + f_im[..., None] * b_re
    return ab_re, ab_im, bb_re, bb_im


def complex_diag_scan(a_re, a_im, b_re, b_im):
    L = b_re.shape[1]
    a_re = jnp.broadcast_to(a_re, (1, L) + a_re.shape)
    a_im = jnp.broadcast_to(a_im, (1, L) + a_im.shape)

    def combine(e1, e2):
        a1r, a1i, b1r, b1i = e1
        a2r, a2i, b2r, b2i = e2
        return (a2r * a1r - a2i * a1i,
                a2r * a1i + a2i * a1r,
                a2r * b1r - a2i * b1i + b2r,
                a2r * b1i + a2i * b1r + b2i)

    _, _, s_re, s_im = lax.associative_scan(combine, (a_re, a_im, b_re, b_im), axis=1)
    return s_re, s_im


def s5_glu(y, w_glu, b_glu):
    g = jax.nn.gelu(y)
    return g * jax.nn.sigmoid(g @ w_glu + b_glu)


def s5_bidirectional(u_lat, u_ctx, lam_re, lam_im, b_re, b_im, c_re, c_im, log_step,
                     d_skip, w_glu, b_glu, need_ctx):
    Bn, L, W = u_lat.shape
    Lc = u_ctx.shape[1]
    ul = u_lat.astype(F32).reshape(Bn, L, SSM_GROUPS, SSM_GROUP)
    uc = u_ctx.astype(F32).reshape(Bn, Lc, SSM_GROUPS, SSM_GROUP)
    seq_fwd = jnp.concatenate([uc, ul], axis=1)
    seq_bwd = jnp.concatenate([uc[:, ::-1], ul[:, ::-1]], axis=1)
    outs = []
    for direction, seq in enumerate((seq_fwd, seq_bwd)):
        ab_re, ab_im, bb_re, bb_im = s5_discretise(lam_re[direction], lam_im[direction],
                                                   b_re[direction], b_im[direction],
                                                   log_step[direction])
        bu_re = jnp.einsum('blgh,gph->blgp', seq, bb_re)
        bu_im = jnp.einsum('blgh,gph->blgp', seq, bb_im)
        s_re, s_im = complex_diag_scan(ab_re, ab_im, bu_re, bu_im)
        cr = c_re[direction].astype(F32)
        ci = c_im[direction].astype(F32)
        outs.append(jnp.einsum('blgp,ghp->blgh', s_re, cr) - jnp.einsum('blgp,ghp->blgh', s_im, ci))
    y_fwd, y_bwd = outs
    dsk = d_skip.astype(F32).reshape(SSM_GROUPS, SSM_GROUP)
    y_lat = y_fwd[:, Lc:] + y_bwd[:, Lc:][:, ::-1] + dsk * ul
    out_lat = s5_glu(y_lat.reshape(Bn, L, W).astype(u_lat.dtype), w_glu, b_glu)
    out_ctx = None
    if need_ctx:
        y_ctx = y_fwd[:, :Lc] + y_bwd[:, :Lc][:, ::-1] + dsk * uc
        out_ctx = s5_glu(y_ctx.reshape(Bn, Lc, W).astype(u_ctx.dtype), w_glu, b_glu)
    return out_lat, out_ctx


def diff_attend(q, k, v, lam):
    s = jnp.einsum('bqhjd,bkhjd->jbhqk', q, k).astype(F32) * (DIFF_HEAD_DIM ** -0.5)
    w = jax.nn.softmax(s[0], axis=-1) - lam * jax.nn.softmax(s[1], axis=-1)
    return jnp.einsum('bhqk,bkhe->bqhe', w.astype(v.dtype), v)


def diff_head_norm(o, g, lam_init):
    Bn, L = o.shape[:2]
    return (rms_norm(o, g, SUBLN_EPS) * (1.0 - lam_init)).reshape(Bn, L, DIFF_WIDTH)


def diff_attention(q_lat, k_lat, v_lat, q_ctx, k_ctx, v_ctx, lam_q1, lam_k1, lam_q2, lam_k2,
                   subln_g, lam_init, cos, sin, need_ctx):
    Bn, L = q_lat.shape[:2]
    lam = (jnp.exp(jnp.sum(lam_q1.astype(F32) * lam_k1.astype(F32)))
           - jnp.exp(jnp.sum(lam_q2.astype(F32) * lam_k2.astype(F32))) + lam_init)
    q_lat = apply_axial_rope(q_lat, cos, sin)
    k_lat = apply_axial_rope(k_lat, cos, sin)
    k_all = jnp.concatenate([k_lat, k_ctx], axis=1)
    v_all = jnp.concatenate([v_lat, v_ctx], axis=1)
    n_blk = L // Q_BLOCK
    q_blocks = q_lat.reshape(Bn, n_blk, Q_BLOCK, DIFF_HEADS, 2, DIFF_HEAD_DIM).swapaxes(0, 1)
    o = lax.map(lambda qb: diff_attend(qb, k_all, v_all, lam), q_blocks)
    o_lat = o.swapaxes(0, 1).reshape(Bn, L, DIFF_HEADS, DIFF_V_DIM)
    out_lat = diff_head_norm(o_lat, subln_g, lam_init)
    out_ctx = None
    if need_ctx:
        out_ctx = diff_head_norm(diff_attend(q_ctx, k_ctx, v_ctx, lam), subln_g, lam_init)
    return out_lat, out_ctx


def neighbourhood_attention(q_lat, k_lat, v_lat, q_ctx, k_ctx, v_ctx, rpb, need_ctx):
    Bn, L, H, d = q_lat.shape
    rows = L // GRID_W
    wr = min(NA_WIN_ROWS, rows)
    scale = d ** -0.5
    qg = q_lat.reshape(Bn, rows, GRID_W, H, d)
    kg = k_lat.reshape(Bn, rows, GRID_W, H, d)
    vg = v_lat.reshape(Bn, rows, GRID_W, H, d)
    cols = jnp.arange(GRID_W, dtype=jnp.int32)
    cstart = jnp.clip(cols - NA_WIN_COLS // 2, 0, GRID_W - NA_WIN_COLS)
    col_valid = (cols[None, :] >= cstart[:, None]) & (cols[None, :] < cstart[:, None] + NA_WIN_COLS)
    col_idx = jnp.clip(cols[None, :] - cols[:, None] + NA_WIN_COLS - 1, 0, 2 * NA_WIN_COLS - 2)

    def row_block(r):
        start = jnp.clip(r - wr // 2, 0, rows - wr)
        qr = lax.dynamic_index_in_dim(qg, r, axis=1, keepdims=False)
        kr = lax.dynamic_slice_in_dim(kg, start, wr, axis=1)
        vr = lax.dynamic_slice_in_dim(vg, start, wr, axis=1)
        row_idx = start + jnp.arange(wr, dtype=jnp.int32) - r + NA_WIN_ROWS - 1
        bias = rpb[:, row_idx[None, :, None], col_idx[:, None, :]].astype(F32)
        s_loc = jnp.einsum('bqhd,bikhd->bhqik', qr, kr).astype(F32) * scale + bias[None]
        s_loc = jnp.where(col_valid[None, None, :, None, :], s_loc, NEG_INF)
        s_ctx = jnp.einsum('bqhd,bkhd->bhqk', qr, k_ctx).astype(F32) * scale
        s = jnp.concatenate([s_loc.reshape(Bn, H, GRID_W, wr * GRID_W), s_ctx], axis=-1)
        p = jax.nn.softmax(s, axis=-1).astype(vr.dtype)
        p_loc = p[..., :wr * GRID_W].reshape(Bn, H, GRID_W, wr, GRID_W)
        p_ctx = p[..., wr * GRID_W:]
        return (jnp.einsum('bhqik,bikhd->bqhd', p_loc, vr)
                + jnp.einsum('bhqk,bkhd->bqhd', p_ctx, v_ctx))

    o = lax.map(row_block, jnp.arange(rows, dtype=jnp.int32))
    out_lat = o.swapaxes(0, 1).reshape(Bn, L, H * d)
    out_ctx = None
    if need_ctx:
        s = jnp.einsum('bqhd,bkhd->bhqk', q_ctx, k_ctx).astype(F32) * scale
        p = jax.nn.softmax(s, axis=-1).astype(v_ctx.dtype)
        out_ctx = jnp.einsum('bhqk,bkhd->bqhd', p, v_ctx).reshape(Bn, -1, H * d)
    return out_lat, out_ctx


def hybrid_mixer(hx, hc, w_in, lam_re, lam_im, b_re, b_im, c_re, c_im, log_step, d_skip,
                 w_glu, b_glu, lam_q1, lam_k1, lam_q2, lam_k2, subln_g, lam_init, rpb,
                 cos, sin, need_ctx):
    Bn, L, _ = hx.shape
    Lc = hc.shape[1]
    u_x, dq_x, dk_x, dv_x, nq_x, nk_x, nv_x = in_proj_split(hx @ w_in)
    u_c, dq_c, dk_c, dv_c, nq_c, nk_c, nv_c = in_proj_split(hc @ w_in)

    ssm_x, ssm_c = s5_bidirectional(u_x, u_c, lam_re, lam_im, b_re, b_im, c_re, c_im,
                                    log_step, d_skip, w_glu, b_glu, need_ctx)

    def qk(t, n):
        return t.reshape(Bn, n, DIFF_HEADS, 2, DIFF_HEAD_DIM)

    diff_x, diff_c = diff_attention(
        qk(dq_x, L), qk(dk_x, L), dv_x.reshape(Bn, L, DIFF_HEADS, DIFF_V_DIM),
        qk(dq_c, Lc), qk(dk_c, Lc), dv_c.reshape(Bn, Lc, DIFF_HEADS, DIFF_V_DIM),
        lam_q1, lam_k1, lam_q2, lam_k2, subln_g, lam_init, cos, sin, need_ctx)

    def nh(t, n):
        return t.reshape(Bn, n, NA_HEADS, NA_HEAD_DIM)

    na_x, na_c = neighbourhood_attention(nh(nq_x, L), nh(nk_x, L), nh(nv_x, L),
                                         nh(nq_c, Lc), nh(nk_c, Lc), nh(nv_c, Lc),
                                         rpb, need_ctx)
    y_lat = jnp.concatenate([ssm_x.astype(hx.dtype), diff_x.astype(hx.dtype), na_x.astype(hx.dtype)], axis=-1)
    y_ctx = None
    if need_ctx:
        y_ctx = jnp.concatenate([ssm_c.astype(hc.dtype), diff_c.astype(hc.dtype), na_c.astype(hc.dtype)], axis=-1)
    return y_lat, y_ctx


def swiglu(h, w1, w3, w2):
    return (jax.nn.silu(h @ w1) * (h @ w3)) @ w2


def moe_swiglu(h, w_router, w1, w3, w2):
    logits = (h @ w_router).astype(F32)
    top_val, top_idx = lax.top_k(logits, TOP_K)
    top_w = jax.nn.softmax(top_val, axis=-1)
    out = jnp.zeros_like(h)
    for e in range(N_EXPERTS):
        gate_e = jnp.sum(jnp.where(top_idx == e, top_w, 0.0), axis=-1)
        out = out + gate_e[..., None].astype(h.dtype) * swiglu(h, w1[e], w3[e], w2[e])
    return out


def channel_mixer(h, layer, ffn_w1, ffn_w3, ffn_w2, moe_router, moe_w1, moe_w3, moe_w2):
    i = layer // 2
    if layer % 2 == 0:
        return swiglu(h, ffn_w1[i], ffn_w3[i], ffn_w2[i])
    return moe_swiglu(h, moe_router[i], moe_w1[i], moe_w3[i], moe_w2[i])


def setup_inputs(seed: int = 0) -> dict:
    key = jax.random.key(seed)
    keys = list(jax.random.split(key, 48))

    def nrm(shape, scale):
        return jax.random.normal(keys.pop(), shape, F32) * scale

    n_dense = (DEPTH + 1) // 2
    n_moe = DEPTH // 2
    G, P, H = SSM_GROUPS, SSM_STATE, SSM_GROUP
    x = nrm((BATCH, SEQ, D_MODEL), 1.0)
    c = nrm((BATCH, D_MODEL), 1.0)
    ctx = nrm((BATCH, CTX_LEN, D_MODEL), 1.0)
    c_ctx = nrm((D_MODEL,), 1.0)
    w_mod = nrm((DEPTH, D_MODEL, 6 * D_MODEL), 0.5 * D_MODEL ** -0.5)
    b_mod = nrm((DEPTH, 6 * D_MODEL), 0.02)
    g_mix = 1.0 + nrm((DEPTH, D_MODEL), 0.02)
    g_ffn = 1.0 + nrm((DEPTH, D_MODEL), 0.02)
    w_in = nrm((DEPTH, D_MODEL, IN_WIDTH), D_MODEL ** -0.5)
    w_out = nrm((DEPTH, MIX_WIDTH, D_MODEL), MIX_WIDTH ** -0.5)
    n_idx = jnp.arange(SSM_STATE, dtype=F32)
    ssm_lam_re = -0.5 + nrm((DEPTH, 2, G, P), 0.01)
    ssm_lam_im = math.pi * n_idx + nrm((DEPTH, 2, G, P), 0.01)
    ssm_b_re = nrm((DEPTH, 2, G, P, H), (2 * H) ** -0.5)
    ssm_b_im = nrm((DEPTH, 2, G, P, H), (2 * H) ** -0.5)
    ssm_c_re = nrm((DEPTH, 2, G, H, P), P ** -0.5)
    ssm_c_im = nrm((DEPTH, 2, G, H, P), P ** -0.5)
    ssm_log_step = jax.random.uniform(keys.pop(), (DEPTH, 2, G), F32,
                                      math.log(SSM_DT_MIN), math.log(SSM_DT_MAX))
    ssm_d = nrm((DEPTH, SSM_WIDTH), 1.0)
    ssm_w_glu = nrm((DEPTH, SSM_WIDTH, SSM_WIDTH), SSM_WIDTH ** -0.5)
    ssm_b_glu = nrm((DEPTH, SSM_WIDTH), 0.02)
    diff_lam_q1 = nrm((DEPTH, DIFF_HEAD_DIM), 0.1)
    diff_lam_k1 = nrm((DEPTH, DIFF_HEAD_DIM), 0.1)
    diff_lam_q2 = nrm((DEPTH, DIFF_HEAD_DIM), 0.1)
    diff_lam_k2 = nrm((DEPTH, DIFF_HEAD_DIM), 0.1)
    diff_subln_g = 1.0 + nrm((DEPTH, DIFF_V_DIM), 0.02)
    na_rpb = nrm((DEPTH, NA_HEADS, 2 * NA_WIN_ROWS - 1, 2 * NA_WIN_COLS - 1), 0.05)
    ffn_w1 = nrm((n_dense, D_MODEL, D_FF), D_MODEL ** -0.5)
    ffn_w3 = nrm((n_dense, D_MODEL, D_FF), D_MODEL ** -0.5)
    ffn_w2 = nrm((n_dense, D_FF, D_MODEL), D_FF ** -0.5)
    moe_router = nrm((n_moe, D_MODEL, N_EXPERTS), D_MODEL ** -0.5)
    moe_w1 = nrm((n_moe, N_EXPERTS, D_MODEL, D_FF_EXPERT), D_MODEL ** -0.5)
    moe_w3 = nrm((n_moe, N_EXPERTS, D_MODEL, D_FF_EXPERT), D_MODEL ** -0.5)
    moe_w2 = nrm((n_moe, N_EXPERTS, D_FF_EXPERT, D_MODEL), D_FF_EXPERT ** -0.5)
    g_final = 1.0 + nrm((D_MODEL,), 0.02)
    return {'x': x, 'c': c, 'ctx': ctx, 'c_ctx': c_ctx, 'w_mod': w_mod, 'b_mod': b_mod,
            'g_mix': g_mix, 'g_ffn': g_ffn, 'w_in': w_in, 'w_out': w_out,
            'ssm_lam_re': ssm_lam_re, 'ssm_lam_im': ssm_lam_im, 'ssm_b_re': ssm_b_re,
            'ssm_b_im': ssm_b_im, 'ssm_c_re': ssm_c_re, 'ssm_c_im': ssm_c_im,
            'ssm_log_step': ssm_log_step, 'ssm_d': ssm_d, 'ssm_w_glu': ssm_w_glu,
            'ssm_b_glu': ssm_b_glu, 'diff_lam_q1': diff_lam_q1, 'diff_lam_k1': diff_lam_k1,
            'diff_lam_q2': diff_lam_q2, 'diff_lam_k2': diff_lam_k2, 'diff_subln_g': diff_subln_g,
            'na_rpb': na_rpb, 'ffn_w1': ffn_w1, 'ffn_w3': ffn_w3, 'ffn_w2': ffn_w2,
            'moe_router': moe_router, 'moe_w1': moe_w1, 'moe_w3': moe_w3, 'moe_w2': moe_w2,
            'g_final': g_final}


def reference(x, c, ctx, c_ctx, w_mod, b_mod, g_mix, g_ffn, w_in, w_out,
              ssm_lam_re, ssm_lam_im, ssm_b_re, ssm_b_im, ssm_c_re, ssm_c_im,
              ssm_log_step, ssm_d, ssm_w_glu, ssm_b_glu,
              diff_lam_q1, diff_lam_k1, diff_lam_q2, diff_lam_k2, diff_subln_g,
              na_rpb, ffn_w1, ffn_w3, ffn_w2, moe_router, moe_w1, moe_w3, moe_w2,
              g_final):
    L = x.shape[1]
    cos, sin = axial_rope_tables(L)
    cx = ctx
    for layer in range(DEPTH):
        need_ctx = layer < DEPTH - 1
        lam_init = 0.8 - 0.6 * math.exp(-0.3 * layer)
        sh1, sc1, gt1, sh2, sc2, gt2 = adaln(c, w_mod[layer], b_mod[layer])
        csh1, csc1, cgt1, csh2, csc2, cgt2 = adaln(c_ctx, w_mod[layer], b_mod[layer])

        hx = modulate(rms_norm(x, g_mix[layer]), sh1[:, None], sc1[:, None])
        hc = modulate(rms_norm(cx, g_mix[layer]), csh1, csc1)
        mx, mc = hybrid_mixer(hx, hc, w_in[layer], ssm_lam_re[layer], ssm_lam_im[layer],
                              ssm_b_re[layer], ssm_b_im[layer], ssm_c_re[layer], ssm_c_im[layer],
                              ssm_log_step[layer], ssm_d[layer], ssm_w_glu[layer], ssm_b_glu[layer],
                              diff_lam_q1[layer], diff_lam_k1[layer], diff_lam_q2[layer],
                              diff_lam_k2[layer], diff_subln_g[layer], lam_init, na_rpb[layer],
                              cos, sin, need_ctx)
        x = x + gt1[:, None] * (mx @ w_out[layer])

        hx = modulate(rms_norm(x, g_ffn[layer]), sh2[:, None], sc2[:, None])
        x = x + gt2[:, None] * channel_mixer(hx, layer, ffn_w1, ffn_w3, ffn_w2,
                                             moe_router, moe_w1, moe_w3, moe_w2)
        if need_ctx:
            cx = cx + cgt1 * (mc @ w_out[layer])
            hc = modulate(rms_norm(cx, g_ffn[layer]), csh2, csc2)
            cx = cx + cgt2 * channel_mixer(hc, layer, ffn_w1, ffn_w3, ffn_w2,
                                           moe_router, moe_w1, moe_w3, moe_w2)
    return rms_norm(x, g_final)
```

```cpp
#include <hip/hip_runtime.h>
#include <cstdio>
#include <cstdint>

#define GAS __attribute__((address_space(1)))
#define LAS __attribute__((address_space(3)))
typedef unsigned short bf16;
typedef short bf16x8 __attribute__((ext_vector_type(8)));
typedef short s16x4 __attribute__((ext_vector_type(4)));
typedef float f32x2 __attribute__((ext_vector_type(2)));
typedef float f32x4 __attribute__((ext_vector_type(4)));
typedef float f32x8 __attribute__((ext_vector_type(8)));
typedef float f32x16 __attribute__((ext_vector_type(16)));
typedef unsigned u32x2 __attribute__((ext_vector_type(2)));
typedef unsigned u32x4 __attribute__((ext_vector_type(4)));

constexpr int DM = 1024, NB = 16, SEQ = 4096, CTXL = 256, RB = SEQ + CTXL, NR = NB * RB, NLAYER = 4;
constexpr int INW = 2560, PW = 2304, FF = 2816, NEXP = 8;
constexpr int PC_DQ = 0, PC_DK = 512, PC_DV = 1024, PC_NQ = 1536, PC_NK = 1792, PC_NV = 2048;
constexpr int NPANEL = NR / 256, PPB = RB / 256;
constexpr int NR16 = NR / 16;
constexpr int GRID = 256, NWAVES = 8, NTHREADS = 512, NGW = GRID * NWAVES, RPW = NR / NGW;
static_assert(RPW * NGW == NR, "rows per wave");
constexpr int MOE_ROWS = 2 * NR + 4096;
constexpr int HCHUNK_PANELS = 256;

constexpr size_t al4k(size_t x) { return (x + 4095) & ~(size_t)4095; }
constexpr size_t WS_CTL = 0, CTL_BYTES = 1u << 20;
constexpr size_t WS_MOD = WS_CTL + CTL_BYTES;                          constexpr size_t SZ_MOD = (size_t)NLAYER * 17 * 6144 * 4;
constexpr size_t WS_ROPE = al4k(WS_MOD + SZ_MOD);                      constexpr size_t SZ_ROPE = 64 * 16 * 8;
constexpr size_t WS_LAM = al4k(WS_ROPE + SZ_ROPE);                     constexpr size_t SZ_LAM = 4096;
constexpr size_t WS_A16 = al4k(WS_LAM + SZ_LAM);                       constexpr size_t SZ_A16 = (size_t)NLAYER * 2 * 16 * 64 * 16;
constexpr size_t WS_S5W1 = al4k(WS_A16 + SZ_A16);                      constexpr size_t SZ_S5W1 = (size_t)NLAYER * 16 * 256 * 256 * 2;
constexpr size_t WS_S5W2 = al4k(WS_S5W1 + SZ_S5W1);                    constexpr size_t SZ_S5W2 = (size_t)NLAYER * 16 * 256 * 512 * 2;
constexpr size_t WS_WIN = al4k(WS_S5W2 + SZ_S5W2);                     constexpr size_t SZ_WIN = (size_t)NLAYER * INW * DM * 2;
constexpr size_t WS_WOUT = al4k(WS_WIN + SZ_WIN);                      constexpr size_t SZ_WOUT = (size_t)NLAYER * DM * DM * 2;
constexpr size_t WS_WGLU = al4k(WS_WOUT + SZ_WOUT);                    constexpr size_t SZ_WGLU = (size_t)NLAYER * 256 * 256 * 2;
constexpr size_t WS_W13D = al4k(WS_WGLU + SZ_WGLU);                    constexpr size_t SZ_W13 = (size_t)2 * FF * DM * 2;
constexpr size_t WS_W2D = al4k(WS_W13D + 2 * SZ_W13);                  constexpr size_t SZ_W2 = (size_t)DM * FF * 2;
constexpr size_t WS_W13M = al4k(WS_W2D + 2 * SZ_W2);
constexpr size_t WS_W2M = al4k(WS_W13M + 16 * SZ_W13);
constexpr size_t SZ_HX = (size_t)NR * DM * 2;
constexpr size_t WS_XR = al4k(WS_W2M + 16 * SZ_W2);
constexpr size_t WS_P = al4k(WS_XR + SZ_HX);                           constexpr size_t SZ_P = (size_t)NR * PW * 2;
constexpr size_t WS_H = WS_P;                                          constexpr size_t SZ_H = (size_t)HCHUNK_PANELS * 256 * FF * 2;
constexpr size_t SZ_A2 = (size_t)16 * NR16 * 512 * 2, SZ_GBUF = (size_t)NR * 256 * 2;
constexpr size_t WS_ZLOC = al4k(WS_P + SZ_P);                          constexpr size_t SZ_ZLOC = (size_t)16 * NR16 * 256 * 4;
constexpr size_t WS_TOKE = al4k(WS_ZLOC + SZ_ZLOC);                    constexpr size_t SZ_TOKE = (size_t)NR * 4;
constexpr size_t WS_TOKG = al4k(WS_TOKE + SZ_TOKE);                    constexpr size_t SZ_TOKG = (size_t)NR * 8;
constexpr size_t WS_WCNT = al4k(WS_TOKG + SZ_TOKG);                    constexpr size_t SZ_WCNT = (size_t)NGW * 16 * 4;
constexpr size_t WS_MBASE = al4k(WS_WCNT + SZ_WCNT);                   constexpr size_t SZ_MBASE = 4096;
constexpr size_t WS_RSRC = al4k(WS_MBASE + SZ_MBASE);                  constexpr size_t SZ_RSRC = (size_t)MOE_ROWS * 4;
constexpr size_t WS_RGATE = al4k(WS_RSRC + SZ_RSRC);                   constexpr size_t SZ_RGATE = (size_t)MOE_ROWS * 4;
constexpr size_t WS_END = al4k(WS_RGATE + SZ_RGATE);
constexpr size_t OUT_HX = 0, OUT_A2 = OUT_HX + SZ_HX, OUT_GBUF = OUT_A2 + SZ_A2;
static_assert(OUT_GBUF + SZ_GBUF <= (size_t)NB * SEQ * DM * 4 && OUT_A2 % 4096 == 0 && OUT_GBUF % 4096 == 0, "scratch tensors inside d_out");
static_assert(WS_ZLOC == WS_P + SZ_P && SZ_H <= SZ_P + SZ_ZLOC, "hidden chunk overlays P and Zloc (both dead during the FFN)");
static_assert(WS_END <= ((size_t)1 << 30), "workspace map must fit 1 GiB");
constexpr int CW_BAR = 4096;

constexpr int RING_BYTES = 131072;
constexpr int LDSCTL_OFF = RING_BYTES;
constexpr int MISC_OFF = LDSCTL_OFF + 320;
constexpr int LDS_BYTES = 147456;

__device__ __forceinline__ unsigned f2bf(float f) { unsigned u = __builtin_bit_cast(unsigned, f); return (u + 0x7fffu + ((u >> 16) & 1u)) >> 16; }
__device__ __forceinline__ unsigned pk2(float lo, float hi) { return f2bf(lo) | (f2bf(hi) << 16); }
__device__ __forceinline__ float bf2f(unsigned h) { return __builtin_bit_cast(float, h << 16); }
__device__ __forceinline__ unsigned cvt_pk_bf16(float lo, float hi) { unsigned r; asm volatile("v_cvt_pk_bf16_f32 %0, %1, %2" : "=v"(r) : "v"(lo), "v"(hi)); return r; }
template <int X> __device__ __forceinline__ float swz_xor(float v) { return __builtin_bit_cast(float, __builtin_amdgcn_ds_swizzle(__builtin_bit_cast(int, v), (X << 10) | 0x1f)); }
__device__ __forceinline__ float half_sum(float v) {
    v += swz_xor<1>(v); v += swz_xor<2>(v); v += swz_xor<4>(v); v += swz_xor<8>(v); v += swz_xor<16>(v); return v; }
__device__ __forceinline__ float wave_sum(float v) {
    v = half_sum(v);
    auto rr = __builtin_amdgcn_permlane32_swap(__float_as_uint(v), __float_as_uint(v), false, false);
    return __uint_as_float(rr[0]) + __uint_as_float(rr[1]);
}
__device__ __forceinline__ int bx_opaque() { int b = (int)blockIdx.x; asm volatile("" : "+s"(b)); return b; }
__device__ __forceinline__ int tid_opaque() { int t = (int)threadIdx.x; asm volatile("" : "+v"(t)); return t; }
#define LDS_WAIT() asm volatile("s_waitcnt lgkmcnt(0)" ::: "memory")
#define VM_WAIT() asm volatile("s_waitcnt vmcnt(0)" ::: "memory")
__device__ __forceinline__ float fast_exp(float x) { return __builtin_amdgcn_exp2f(x * 1.4426950408889634f); }
__device__ __forceinline__ float sigmoidf_(float x) { return __builtin_amdgcn_rcpf(1.f + fast_exp(-x)); }
__device__ __forceinline__ float siluf_(float x) { return x * sigmoidf_(x); }
__device__ __forceinline__ float gelu_tanh(float x) {
    const float u = 0.7978845608028654f * (x + 0.044715f * x * x * x);
    return x * sigmoidf_(2.f * u);
}

#define XB_TMO      128
#define XB_XCNT(j)  (256  + 64 * (j))
#define XB_XSUB(j)  (1280 + 64 * (j))
#define XB_XGEN(j)  (2304 + 64 * (j))
#define XB_TOP      3328
#define XB_TOPGEN   3392
#define XCD_BAR_WORDS 3456
#define XB_SPIN_CAP (1u << 18)

__device__ __forceinline__ unsigned xb_ld(unsigned* p)              { return __hip_atomic_load(p, __ATOMIC_RELAXED, __HIP_MEMORY_SCOPE_AGENT); }
__device__ __forceinline__ unsigned xb_add(unsigned* p, unsigned v) { return __hip_atomic_fetch_add(p, v, __ATOMIC_RELAXED, __HIP_MEMORY_SCOPE_AGENT); }
__device__ __forceinline__ unsigned xb_xcc_id() { return (unsigned)__builtin_amdgcn_s_getreg((3 << 11) | 20) & 0xFu; }
#define XB_SPIN(cond, bar) do { unsigned _sp = 0; while (cond) { __builtin_amdgcn_s_sleep(1); \
    if ((++_sp & 255u) == 0u) { if (xb_ld(&(bar)[XB_TMO])) break; if (_sp > XB_SPIN_CAP) { atomicAdd(&(bar)[XB_TMO], 1u); break; } } } } while (0)

struct XcdBarrier {
    unsigned* bar; unsigned x;
    volatile LAS unsigned* st;
};
__device__ __forceinline__ XcdBarrier xcd_barrier_post(unsigned* bar, volatile LAS unsigned* st) {
    XcdBarrier b; b.bar = bar; b.x = xb_xcc_id(); b.st = st;
    if (threadIdx.x == 0) (void)xb_add(&bar[XB_XCNT(b.x)], 1u);
    return b;
}
__device__ __forceinline__ void xcd_barrier_complete(unsigned* bar, unsigned x, unsigned& nloc, unsigned& nx) {
    const unsigned G = gridDim.x * gridDim.y * gridDim.z;
    unsigned sum, cnt, mine, sp = 0u;
    for (;;) {
        sum = 0u; cnt = 0u; mine = 0u;
#pragma unroll
        for (unsigned j = 0; j < 16; ++j) { const unsigned c = xb_ld(&bar[XB_XCNT(j)]); sum += c; cnt += (c > 0u) ? 1u : 0u; mine = (j == x) ? c : mine; }
        if (sum == G) break;
        __builtin_amdgcn_s_sleep(1);
        if ((++sp & 255u) == 0u) { if (xb_ld(&bar[XB_TMO])) break; if (sp > XB_SPIN_CAP) { atomicAdd(&bar[XB_TMO], 1u); break; } }
    }
    nloc = mine > 0u ? mine : 1u; nx = cnt > 0u ? cnt : 1u;
}
template <bool FIRST>
__device__ __forceinline__ void xcd_barrier(const XcdBarrier& b) {
    asm volatile("s_waitcnt vmcnt(0)" ::: "memory");
    __syncthreads();
    if (threadIdx.x == 0) {
        unsigned* bar = b.bar;
        __builtin_amdgcn_s_waitcnt(0);
        unsigned nloc = b.st[0], nx = b.st[1];
        if constexpr (FIRST) { if (nloc == 0u) { xcd_barrier_complete(bar, b.x, nloc, nx); b.st[0] = nloc; b.st[1] = nx; } }
        else { nloc = nloc ? nloc : 1u; nx = nx ? nx : 1u; }
        const unsigned old = xb_add(&bar[XB_XSUB(b.x)], 1u);
        const unsigned gen = old / nloc;
        if (old + 1u == (gen + 1u) * nloc) {
            __builtin_amdgcn_fence(__ATOMIC_RELEASE, "agent");
            asm volatile("s_waitcnt vmcnt(0)" ::: "memory");
            const unsigned og = xb_add(&bar[XB_TOP], 1u);
            const unsigned tg = og / nx;
            if (og + 1u == (tg + 1u) * nx) xb_add(&bar[XB_TOPGEN], 1u);
            else XB_SPIN(xb_ld(&bar[XB_TOPGEN]) == tg, bar);
            __builtin_amdgcn_fence(__ATOMIC_ACQUIRE, "agent");
            xb_add(&bar[XB_XGEN(b.x)], 1u);
            asm volatile("s_waitcnt vmcnt(0)" ::: "memory");
        } else {
            XB_SPIN(xb_ld(&bar[XB_XGEN(b.x)]) == gen, bar);
            __builtin_amdgcn_fence(__ATOMIC_ACQUIRE, "agent");
            asm volatile("s_waitcnt vmcnt(0)" ::: "memory");
        }
    }
    __syncthreads();
}

namespace pg8 {
__device__ __forceinline__ void glds16_s(const void* sbase, unsigned voff, unsigned lds_dst) {
    unsigned keep;
    asm volatile("s_mov_b32 %0, m0\n\ts_mov_b32 m0, %3\n\ts_nop 0\n\tglobal_load_lds_dwordx4 %1, %2\n\ts_mov_b32 m0, %0" : "=&s"(keep) : "v"(voff), "s"(sbase), "s"(lds_dst) : "memory");
}
constexpr int BM = 256, BK = 64, HALF = 128, HTB = HALF * BK * 2, STAGE_BYTES = 8 * HTB, NXCD = 8;
__host__ __device__ __forceinline__ int lds_byte(int r, int c) { const int st = (r >> 4) * 2 + (c >> 5), rr = r & 15, cc = c & 31, ob = rr * 64 + cc * 2; return st * 1024 + (ob ^ (((ob >> 9) & 1) << 5)); }
__host__ __device__ __forceinline__ void stage_rc(int b, int& R, int& C) { const int st = b / 1024, sb = b % 1024, swz = sb ^ (((sb >> 9) & 1) << 5); R = (st >> 1) * 16 + swz / 64; C = (st & 1) * 32 + (swz % 64) / 2; }
__host__ __device__ __forceinline__ int perm32(int rho) { const int n = rho >> 4, i = rho & 15; return 8 * (i >> 2) + 4 * n + (i & 3); }

struct GUnit { const char* A; const char* B; int pm, pn, aux; const int* rows; };

__device__ __forceinline__ bool tile_order(int i, int G, int c, int nM, int nN, int WGM, int& pm, int& pn) {
    const int nwg = nM * nN; const long L = (long)i * G + c; if (L >= nwg) return false;
    int wgid = (int)L; { const int q = nwg / NXCD, r = nwg % NXCD, xcd = wgid % NXCD, off = wgid / NXCD; wgid = (xcd < r ? xcd * (q + 1) : r * (q + 1) + (xcd - r) * q) + off; }
    const int nig = WGM * nN, gid = wgid / nig, fm = gid * WGM, gsz = (nM - fm) < WGM ? (nM - fm) : WGM;
    pm = fm + ((wgid % nig) % gsz); pn = (wgid % nig) / gsz; return true;
}

template <class Epi, class Sched, bool GATHER>
__device__ __forceinline__ void gemm_phase(LAS unsigned char* lds, const int K, const int lda, const int ldb, const Sched& S, const Epi& E) {
    const int tid = tid_opaque(), wid = __builtin_amdgcn_readfirstlane(tid >> 6), lane = tid & 63, wr = wid >> 2, wc = wid & 3, fr = lane & 15, fq = lane >> 4;
    int nt = K / BK; asm volatile("" : "+s"(nt));
    int sR[2], sC[2]; unsigned voffB[2];
#pragma unroll
    for (int i = 0; i < 2; ++i) { stage_rc(tid * 16 + i * 8192, sR[i], sC[i]); const int Rb = (sR[i] & ~31) + perm32(sR[i] & 31); voffB[i] = (unsigned)(Rb * ldb + sC[i]) * 2u; }
    const size_t kstep = (size_t)(BK * 2);
    const size_t hstepB = (size_t)HALF * ldb * 2;
    const unsigned ldsb = (unsigned)(uintptr_t)lds + (unsigned)wid * 1024u;
    const int aoff = lds_byte(wr * 64 + fr, fq * 8), boff = lds_byte(wc * 32 + fr, fq * 8);
#define PG8_SA(b, h) (((b) * 2 + (h)) * HTB)
#define PG8_SB(b, h) ((4 + (b) * 2 + (h)) * HTB)
#define PG8_STAGE(bufoff, gbase, voff) do { _Pragma("unroll") for (int _i = 0; _i < 2; ++_i) \
        glds16_s((const void*)(gbase), (voff)[_i], ldsb + (unsigned)((bufoff) + _i * 8192)); } while (0)
#define PG8_LDA(dst, b, h) do { _Pragma("unroll") for (int m = 0; m < 4; ++m) _Pragma("unroll") for (int k = 0; k < 2; ++k) dst[m][k] = *(const LAS bf16x8*)(lds + PG8_SA(b, h) + aoff + m * 2048 + k * 1024); } while (0)
#define PG8_LDB(dst, b, h) do { _Pragma("unroll") for (int n = 0; n < 2; ++n) _Pragma("unroll") for (int k = 0; k < 2; ++k) dst[n][k] = *(const LAS bf16x8*)(lds + PG8_SB(b, h) + boff + n * 2048 + k * 1024); } while (0)
#define PG8_MMA(ai, bj, At, Bt) do { __builtin_amdgcn_s_setprio(1); _Pragma("unroll") for (int m = 0; m < 4; ++m) _Pragma("unroll") for (int n = 0; n < 2; ++n) _Pragma("unroll") for (int k = 0; k < 2; ++k) \
        acc[ai][bj][m][n] = __builtin_amdgcn_mfma_f32_16x16x32_bf16(Bt[n][k], At[m][k], acc[ai][bj][m][n], 0, 0, 0); __builtin_amdgcn_s_setprio(0); } while (0)
#define PG8_WAIT_V(n) asm volatile("s_waitcnt vmcnt(" #n ")" ::: "memory")
#define PG8_WAIT_L(n) asm volatile("s_waitcnt lgkmcnt(" #n ")" ::: "memory")
#define PG8_BAR __builtin_amdgcn_s_barrier()
#define PG8_SCHED __builtin_amdgcn_sched_barrier(0)
#define PG8_AOFF(dst, u) do { _Pragma("unroll") for (int _h = 0; _h < 2; ++_h) _Pragma("unroll") for (int _i = 0; _i < 2; ++_i) { \
        if constexpr (GATHER) { int _r = (u).rows[_h * HALF + sR[_i]]; _r = _r < 0 ? 0 : _r; dst[_h][_i] = (unsigned)(_r * lda + sC[_i]) * 2u; } \
        else dst[_h][_i] = (unsigned)((_h * HALF + sR[_i]) * lda + sC[_i]) * 2u; } } while (0)
    GUnit cur, nxt; int ui = 0;
    if (!S.next(0, cur)) return;
    f32x4 acc[2][2][4][2];
#pragma unroll
    for (int a = 0; a < 2; ++a)
#pragma unroll
        for (int b = 0; b < 2; ++b)
#pragma unroll
            for (int m = 0; m < 4; ++m)
#pragma unroll
                for (int n = 0; n < 2; ++n) acc[a][b][m][n] = (f32x4){0.f, 0.f, 0.f, 0.f};
    bf16x8 At[4][2], B0[2][2], B1[2][2];
    unsigned oC[2][2], oN[2][2];
    PG8_AOFF(oC, cur);
    const char* cA = cur.A; const char* cB = cur.B;
    PG8_STAGE(PG8_SB(0, 0), cB, voffB); PG8_STAGE(PG8_SB(0, 1), cB + hstepB, voffB); PG8_STAGE(PG8_SA(0, 0), cA, oC[0]); PG8_STAGE(PG8_SA(0, 1), cA, oC[1]);
    if (wr == 1) PG8_BAR;
    PG8_WAIT_V(2); PG8_BAR;
    PG8_STAGE(PG8_SB(1, 0), cB + kstep, voffB); PG8_STAGE(PG8_SA(1, 0), cA + kstep, oC[0]); PG8_STAGE(PG8_SB(1, 1), cB + hstepB + kstep, voffB);
    PG8_WAIT_V(6); PG8_BAR;
    for (;;) {
        const bool has_next = S.next(ui + 1, nxt);
        const char* nA = has_next ? nxt.A : cA; const char* nB = has_next ? nxt.B : cB;
        if (has_next) { PG8_AOFF(oN, nxt); } else {
#pragma unroll
            for (int h = 0; h < 2; ++h)
#pragma unroll
                for (int i = 0; i < 2; ++i) oN[h][i] = oC[h][i]; }
        for (int t = 0; t < nt; t += 2) {
            const bool last = (t == nt - 2);
            const char* a1 = cA + (size_t)(t + 1) * kstep;
            const char* a2 = last ? nA : cA + (size_t)(t + 2) * kstep; const char* b2 = last ? nB : cB + (size_t)(t + 2) * kstep;
            const char* a3 = a2 + kstep; const char* b3 = b2 + kstep;
            unsigned o2[2][2];
#pragma unroll
            for (int h = 0; h < 2; ++h)
#pragma unroll
                for (int i = 0; i < 2; ++i) o2[h][i] = last ? oN[h][i] : oC[h][i];
            PG8_LDB(B0, 0, 0); PG8_LDB(B1, 0, 1); PG8_SCHED; PG8_LDA(At, 0, 0); PG8_STAGE(PG8_SA(1, 1), a1, oC[1]);
            PG8_WAIT_V(8); PG8_WAIT_L(0); PG8_BAR; PG8_MMA(0, 0, At, B0); PG8_MMA(0, 1, At, B1); PG8_BAR; PG8_SCHED;
            PG8_LDA(At, 0, 1); PG8_STAGE(PG8_SB(0, 0), b2, voffB); PG8_STAGE(PG8_SB(0, 1), b2 + hstepB, voffB); PG8_STAGE(PG8_SA(0, 0), a2, o2[0]);
            PG8_WAIT_V(8); PG8_WAIT_L(0); PG8_BAR; PG8_MMA(1, 0, At, B0); PG8_MMA(1, 1, At, B1); PG8_BAR; PG8_SCHED;
            PG8_LDB(B0, 1, 0); PG8_LDB(B1, 1, 1); PG8_SCHED; PG8_LDA(At, 1, 0); PG8_STAGE(PG8_SA(0, 1), a2, o2[1]);
            PG8_WAIT_V(8); PG8_WAIT_L(0); PG8_BAR; PG8_MMA(0, 0, At, B0); PG8_MMA(0, 1, At, B1); PG8_BAR; PG8_SCHED;
            PG8_LDA(At, 1, 1); PG8_STAGE(PG8_SB(1, 0), b3, voffB); PG8_STAGE(PG8_SB(1, 1), b3 + hstepB, voffB); PG8_STAGE(PG8_SA(1, 0), a3, o2[0]);
            PG8_WAIT_V(8); PG8_WAIT_L(0); PG8_BAR; PG8_MMA(1, 0, At, B0); PG8_MMA(1, 1, At, B1); PG8_BAR; PG8_SCHED;
        }
        if (wr == 0) PG8_BAR;
        E(acc, cur, wr, wc, fr, fq);
        if (!has_next) break;
#pragma unroll
        for (int a = 0; a < 2; ++a)
#pragma unroll
            for (int b = 0; b < 2; ++b)
#pragma unroll
                for (int m = 0; m < 4; ++m)
#pragma unroll
                    for (int n = 0; n < 2; ++n) acc[a][b][m][n] = (f32x4){0.f, 0.f, 0.f, 0.f};
        cur = nxt; cA = nA; cB = nB; ++ui;
#pragma unroll
        for (int h = 0; h < 2; ++h)
#pragma unroll
            for (int i = 0; i < 2; ++i) oC[h][i] = oN[h][i];
        if (wr == 1) PG8_BAR;
    }
    PG8_WAIT_V(0);
    PG8_BAR;
#undef PG8_SA
#undef PG8_SB
#undef PG8_STAGE
#undef PG8_LDA
#undef PG8_LDB
#undef PG8_MMA
#undef PG8_WAIT_V
#undef PG8_WAIT_L
#undef PG8_BAR
#undef PG8_SCHED
#undef PG8_AOFF
}
}
namespace att {
constexpr float QSCALE = 0.125f * 1.4426950408889634f;
constexpr float THR2 = 8.f * 1.4426950408889634f;
constexpr int SHM_V = 16384, SHM_K = 8192;
constexpr int OFF_V = 0, OFF_K = 2 * SHM_V, OFF_WS = OFF_K + 2 * SHM_K, OFF_RPB = OFF_WS + NWAVES * 64 * 4, ATT_LDS = OFF_RPB + 2048;
#define ATT_KSWZ(row, colB) ((row) * 128 + ((colB) ^ ((((row) >> 1) & 7) << 4)))
#define ATT_SBAR() __builtin_amdgcn_sched_barrier(0)
__device__ __forceinline__ int crow(int r, int hi) { return (r & 3) + 8 * (r >> 2) + 4 * hi; }

template <bool FIRST>
__device__ __forceinline__ void partialSM(f32x16& p0, f32x16& p1, float& mhat, f32x16& negm, float& alpha) {
#define ATT_MX3(a, b, c) __builtin_fmaxf(__builtin_fmaxf((a), (b)), (c))
    float a = ATT_MX3(p0[0], p0[1], p1[0]), b = ATT_MX3(p0[2], p0[3], p1[1]); a = ATT_MX3(a, p1[2], p1[3]);
#pragma unroll
    for (int r = 4; r < 16; r += 4) { a = ATT_MX3(a, p0[r], p0[r + 1]); b = ATT_MX3(b, p0[r + 2], p0[r + 3]); a = ATT_MX3(a, p1[r], p1[r + 1]); b = ATT_MX3(b, p1[r + 2], p1[r + 3]); }
#undef ATT_MX3
    float pmax = fmaxf(a, b);
    { auto rr = __builtin_amdgcn_permlane32_swap(__float_as_uint(pmax), __float_as_uint(pmax), false, false);
      pmax = fmaxf(__uint_as_float(rr[0]), __uint_as_float(rr[1])); }
    alpha = 1.f;
    if (FIRST || !__builtin_expect(__all(pmax <= THR2), 1)) { const float dl = FIRST ? pmax : fmaxf(pmax, 0.f); mhat += dl;
#pragma unroll
        for (int r = 0; r < 16; ++r) { p0[r] -= dl; p1[r] -= dl; }
#pragma unroll
        for (int r = 0; r < 16; ++r) negm[r] = -mhat;
        alpha = __builtin_amdgcn_exp2f(-dl); }
#pragma unroll
    for (int r = 0; r < 16; ++r) p0[r] = __builtin_amdgcn_exp2f(p0[r]);
}
__device__ __forceinline__ void finishSM(f32x16& p0, f32x16& p1, float alpha, float& l_reg, bf16x8& pa0, bf16x8& pa1, bf16x8& pa2, bf16x8& pa3) {
#pragma unroll
    for (int r = 0; r < 16; ++r) p1[r] = __builtin_amdgcn_exp2f(p1[r]);
    { f32x2 s2 = (f32x2){p0[0], p0[1]} + (f32x2){p1[0], p1[1]};
#pragma unroll
      for (int r = 2; r < 16; r += 2) { s2 += (f32x2){p0[r], p0[r + 1]}; s2 += (f32x2){p1[r], p1[r + 1]}; }
      float ps = s2[0] + s2[1];
      auto rr = __builtin_amdgcn_permlane32_swap(__float_as_uint(ps), __float_as_uint(ps), false, false);
      ps = __uint_as_float(rr[0]) + __uint_as_float(rr[1]);
      l_reg = l_reg * alpha + ps; }
#define ATT_PK4(P, BASE, OUT) do { u32x4 w = {cvt_pk_bf16(P[BASE + 0], P[BASE + 1]), cvt_pk_bf16(P[BASE + 2], P[BASE + 3]), cvt_pk_bf16(P[BASE + 4], P[BASE + 5]), cvt_pk_bf16(P[BASE + 6], P[BASE + 7])}; \
    OUT = __builtin_bit_cast(bf16x8, w); } while (0)
    ATT_PK4(p0, 0, pa0); ATT_PK4(p0, 8, pa1); ATT_PK4(p1, 0, pa2); ATT_PK4(p1, 8, pa3);
#undef ATT_PK4
}
__device__ __forceinline__ void qkt(f32x16& p0, f32x16& p1, const LAS unsigned char* Ks, const bf16x8* qr, const f32x16& negm, int r32, int hi) {
    p0 = negm; p1 = negm;
#pragma unroll
    for (int d0 = 0; d0 < 4; ++d0) { const int cb = (d0 * 16 + hi * 8) * 2;
        const bf16x8 b0 = *(const LAS bf16x8*)(Ks + ATT_KSWZ(r32, cb));
        const bf16x8 b1 = *(const LAS bf16x8*)(Ks + ATT_KSWZ(32 + r32, cb));
        p0 = __builtin_amdgcn_mfma_f32_32x32x16_bf16(b0, qr[d0], p0, 0, 0, 0);
        p1 = __builtin_amdgcn_mfma_f32_32x32x16_bf16(b1, qr[d0], p1, 0, 0, 0); }
}
__device__ __forceinline__ int v_st(int k, int c) { const int kk = k;     return ((kk >> 3) * 4 + (c >> 5)) * 512 + ((kk & 7) * 32 + (c & 31)) * 2; }
__device__ __forceinline__ int v_rd_base(int lane) { return ((lane & 3) << 3) | (((lane >> 2) & 3) << 6) | (((lane >> 4) & 1) << 5) | (((lane >> 5) & 1) << 8); }
constexpr int v_rd_off(int d0, int ks, int half) { return d0 * 512 + ks * 4096 + half * 2048; }
template <int OFF> __device__ __forceinline__ s16x4 tr_read(int vb) {
    s16x4 r; asm volatile("ds_read_b64_tr_b16 %0, %1 offset:%2" : "=&v"(r) : "v"(vb), "i"(OFF) : "memory"); return r;
}
template <int D0> __device__ __forceinline__ void pv_one(f32x16& od, int vb, bf16x8 pa0, bf16x8 pa1, bf16x8 pa2, bf16x8 pa3) {
    const s16x4 l0 = tr_read<v_rd_off(D0, 0, 0)>(vb), h0 = tr_read<v_rd_off(D0, 0, 1)>(vb), l1 = tr_read<v_rd_off(D0, 1, 0)>(vb), h1 = tr_read<v_rd_off(D0, 1, 1)>(vb);
    const s16x4 l2 = tr_read<v_rd_off(D0, 2, 0)>(vb), h2 = tr_read<v_rd_off(D0, 2, 1)>(vb), l3 = tr_read<v_rd_off(D0, 3, 0)>(vb), h3 = tr_read<v_rd_off(D0, 3, 1)>(vb);
    asm volatile("s_waitcnt lgkmcnt(0)" ::: "memory"); ATT_SBAR();
#define ATT_PKV(L, H) (bf16x8){L[0], L[1], L[2], L[3], H[0], H[1], H[2], H[3]}
    od = __builtin_amdgcn_mfma_f32_32x32x16_bf16(pa0, ATT_PKV(l0, h0), od, 0, 0, 0);
    od = __builtin_amdgcn_mfma_f32_32x32x16_bf16(pa1, ATT_PKV(l1, h1), od, 0, 0, 0);
    od = __builtin_amdgcn_mfma_f32_32x32x16_bf16(pa2, ATT_PKV(l2, h2), od, 0, 0, 0);
    od = __builtin_amdgcn_mfma_f32_32x32x16_bf16(pa3, ATT_PKV(l3, h3), od, 0, 0, 0);
#undef ATT_PKV
}
template <int DV> __device__ __forceinline__ void pv_all(f32x16* o, int vb, bf16x8 pa0, bf16x8 pa1, bf16x8 pa2, bf16x8 pa3) {
    pv_one<0>(o[0], vb, pa0, pa1, pa2, pa3); pv_one<1>(o[1], vb, pa0, pa1, pa2, pa3);
    if constexpr (DV == 128) { pv_one<2>(o[2], vb, pa0, pa1, pa2, pa3); pv_one<3>(o[3], vb, pa0, pa1, pa2, pa3); }
}
__device__ __forceinline__ void na_mask(f32x16& p0, f32x16& p1, int krow, int qrow, int cq, int hi, const LAS float* tbl) {
    const int start = min(max(qrow - 4, 0), 56); const bool rv = (krow >= start) && (krow < start + 8);
    const int ridx = min(max(krow - qrow + 7, 0), 14); const int cst = min(max(cq - 8, 0), 48);
    const LAS float* trow = tbl + ridx * 31 + (15 - cq);
#pragma unroll
    for (int r = 0; r < 16; ++r) { const int kc = crow(r, hi);
        const bool ok0 = rv && ((unsigned)(kc - cst) < 16u), ok1 = rv && ((unsigned)(kc + 32 - cst) < 16u);
        const float b0 = trow[ok0 ? kc : cq], b1 = trow[ok1 ? kc + 32 : cq];
        p0[r] = ok0 ? p0[r] + b0 : -1e30f; p1[r] = ok1 ? p1[r] + b1 : -1e30f; }
}

template <int DV, int MODE>
__device__ __forceinline__ void attn_body(const bf16* __restrict__ Qp, const bf16* __restrict__ Kp, const bf16* __restrict__ Vp, int baseA, int nA, int baseB, int NT,
                                          LAS unsigned char* lds, f32x16 (&o)[DV / 32], int qrow, int kmin) {
    const int tid = tid_opaque(), wid = __builtin_amdgcn_readfirstlane(tid >> 6), lane = tid & 63, r32 = lane & 31, hi = lane >> 5;
    LAS unsigned char* V_lds = lds + OFF_V; LAS unsigned char* K_lds = lds + OFF_K;
    LAS float* al_l = (LAS float*)(lds + OFF_WS) + wid * 64; LAS float* li_l = al_l + 32;
    const LAS float* tbl = (const LAS float*)(lds + OFF_RPB);
    const int cq = (wid & 1) * 32 + r32;
    float mhat = 0.f, l_reg = 0.f; f32x16 negm = f32x16{}; bf16x8 qr[4];
#pragma unroll
    for (int d = 0; d < DV / 32; ++d) o[d] = f32x16{};
    { const bf16* Qw = Qp + (size_t)(wid * 32 + r32) * PW + hi * 8;
#pragma unroll
      for (int d0 = 0; d0 < 4; ++d0) qr[d0] = *(const bf16x8*)(Qw + d0 * 16); }
    const int kr = tid >> 3, kc8 = (tid & 7) * 8, kst = ATT_KSWZ(kr, kc8 * 2);
    const int sr = (DV == 128) ? (tid >> 4) : (tid >> 3), sc = (DV == 128) ? (tid & 15) * 8 : (tid & 7) * 8;
    const int vst0 = v_st(sr, sc), vst1 = v_st(32 + sr, sc);
    const int vb0 = (int)(unsigned)(uintptr_t)V_lds + v_rd_base(lane);
    struct { bf16x8 vs0, vs1, ks; } sr_[2];
#define ATT_TROW(t) ((t) < nA ? baseA + 64 * (t) : baseB + 64 * ((t) - nA))
#define ATT_SLOAD(i, t) do { const int rb_ = ATT_TROW(t); sr_[i].vs0 = *(const bf16x8*)(Vp + (size_t)(rb_ + sr) * PW + sc); \
    if constexpr (DV == 128) sr_[i].vs1 = *(const bf16x8*)(Vp + (size_t)(rb_ + 32 + sr) * PW + sc); \
    sr_[i].ks = *(const bf16x8*)(Kp + (size_t)(rb_ + kr) * PW + kc8); } while (0)
#define ATT_SWRITE(b, i) do { *(LAS bf16x8*)(V_lds + (b) * SHM_V + vst0) = sr_[i].vs0; \
    if constexpr (DV == 128) *(LAS bf16x8*)(V_lds + (b) * SHM_V + vst1) = sr_[i].vs1; \
    *(LAS bf16x8*)(K_lds + (b) * SHM_K + kst) = sr_[i].ks; } while (0)
#define ATT_SWAIT() do { if constexpr (DV == 128) asm volatile("s_waitcnt vmcnt(3)" ::: "memory"); else asm volatile("s_waitcnt vmcnt(2)" ::: "memory"); } while (0)
#define ATT_RESC(a) do { if (__any((a) < 1.f)) { if (hi == 0) al_l[r32] = (a); asm volatile("s_waitcnt lgkmcnt(0)" ::: "memory"); \
    _Pragma("unroll") for (int r = 0; r < 16; ++r) { const float f_ = al_l[crow(r, hi)]; _Pragma("unroll") for (int d = 0; d < DV / 32; ++d) o[d][r] *= f_; } } } while (0)
#define ATT_MASK(P0, P1, t) do { if constexpr (MODE == 1) { if ((t) >= nA) na_mask(P0, P1, kmin + (t) - nA, qrow, cq, hi, tbl); } } while (0)
    f32x16 pA0, pA1, pB0, pB1; float alA, alB; bf16x8 pa0, pa1, pa2, pa3;
    constexpr int SE = 0, SO = 1;
    __syncthreads();
    ATT_SLOAD(SE, 0); asm volatile("s_waitcnt vmcnt(0)" ::: "memory"); ATT_SWRITE(0, SE); __syncthreads();
    qkt(pA0, pA1, K_lds, qr, negm, r32, hi); ATT_MASK(pA0, pA1, 0); partialSM<true>(pA0, pA1, mhat, negm, alA);
    ATT_SLOAD(SO, 1); if (2 < NT) ATT_SLOAD(SE, 2);
    ATT_SWAIT(); ATT_SWRITE(1, SO); __syncthreads();
    for (int j = 1; j + 1 < NT; j += 2) {
        ATT_SBAR(); qkt(pB0, pB1, K_lds + SHM_K, qr, negm, r32, hi); ATT_MASK(pB0, pB1, j);
        finishSM(pA0, pA1, alA, l_reg, pa0, pa1, pa2, pa3); ATT_SBAR();
        ATT_SLOAD(SO, j + 2); ATT_SBAR();
        pv_all<DV>(o, vb0, pa0, pa1, pa2, pa3); partialSM<false>(pB0, pB1, mhat, negm, alB);
        __syncthreads(); ATT_SWAIT(); ATT_SWRITE(0, SE);
        ATT_RESC(alB); __syncthreads();
        ATT_SBAR(); qkt(pA0, pA1, K_lds, qr, negm, r32, hi); ATT_MASK(pA0, pA1, j + 1);
        finishSM(pB0, pB1, alB, l_reg, pa0, pa1, pa2, pa3); ATT_SBAR();
        if (j + 3 < NT) ATT_SLOAD(SE, j + 3); ATT_SBAR();
        pv_all<DV>(o, vb0 + SHM_V, pa0, pa1, pa2, pa3); partialSM<false>(pA0, pA1, mhat, negm, alA);
        __syncthreads(); ATT_SWAIT(); ATT_SWRITE(1, SO);
        ATT_RESC(alA); __syncthreads();
    }
    ATT_SBAR(); qkt(pB0, pB1, K_lds + SHM_K, qr, negm, r32, hi); ATT_MASK(pB0, pB1, NT - 1);
    finishSM(pA0, pA1, alA, l_reg, pa0, pa1, pa2, pa3); ATT_SBAR();
    pv_all<DV>(o, vb0, pa0, pa1, pa2, pa3); partialSM<false>(pB0, pB1, mhat, negm, alB);
    __syncthreads(); ATT_RESC(alB);
    finishSM(pB0, pB1, alB, l_reg, pa0, pa1, pa2, pa3); ATT_SBAR();
    pv_all<DV>(o, vb0 + SHM_V, pa0, pa1, pa2, pa3);
    if (hi == 0) li_l[r32] = l_reg; asm volatile("s_waitcnt lgkmcnt(0)" ::: "memory");
#pragma unroll
    for (int r = 0; r < 16; ++r) { const float rl = __builtin_amdgcn_rcpf(li_l[crow(r, hi)]);
#pragma unroll
        for (int d = 0; d < DV / 32; ++d) o[d][r] *= rl; }
#undef ATT_TROW
#undef ATT_SLOAD
#undef ATT_SWRITE
#undef ATT_SWAIT
#undef ATT_RESC
#undef ATT_MASK
}
}
struct Params { const float* in[34]; float* out; unsigned char* ws; };
#define CAS __attribute__((address_space(4)))
struct KA { const CAS unsigned char* k;
    __device__ __forceinline__ const float* in(int i) const { return *(const float* const CAS*)(k + 8 * i); }
    __device__ __forceinline__ float* out() const { return *(float* const CAS*)(k + 8 * 34); }
    __device__ __forceinline__ unsigned char* ws() const { return *(unsigned char* const CAS*)(k + 8 * 35); } };
enum { I_X = 0, I_C, I_CTX, I_CCTX, I_WMOD, I_BMOD, I_GMIX, I_GFFN, I_WIN, I_WOUT, I_LAMRE, I_LAMIM, I_BRE, I_BIM, I_CRE, I_CIM, I_LOGSTEP, I_SSMD, I_WGLU, I_BGLU,
       I_LQ1, I_LK1, I_LQ2, I_LK2, I_SUBLN, I_RPB, I_FW1, I_FW3, I_FW2, I_ROUTER, I_MW1, I_MW3, I_MW2, I_GFINAL };

__device__ __forceinline__ size_t res_off(int r, bool& is_ctx) { const int b = r / RB, n = r - b * RB; is_ctx = n >= SEQ; return is_ctx ? ((size_t)b * CTXL + (n - SEQ)) * DM : ((size_t)b * SEQ + n) * DM; }

using pg8::GUnit;
#define EPI_ROWS_COLS const int row0 = wr * 64 + fr, col0 = wc * 32 + 8 * fq
__device__ __forceinline__ u32x4 pack8(f32x4 a, f32x4 b) { u32x4 w; w.x = cvt_pk_bf16(a[0], a[1]); w.y = cvt_pk_bf16(a[2], a[3]); w.z = cvt_pk_bf16(b[0], b[1]); w.w = cvt_pk_bf16(b[2], b[3]); return w; }

struct EpiInProj {
    bf16* P; bf16* A2; const float* rope;
    __device__ __forceinline__ void operator()(const f32x4 (&acc)[2][2][4][2], const GUnit& u, int wr, int wc, int fr, int fq) const {
        EPI_ROWS_COLS; const int pl = u.pm % PPB; const bool lat = pl < 16;
        if (u.pn == 0) {
#pragma unroll
            for (int ai = 0; ai < 2; ++ai)
#pragma unroll
                for (int m = 0; m < 4; ++m) { const int r = u.pm * 256 + ai * 128 + row0 + m * 16;
#pragma unroll
                    for (int bj = 0; bj < 2; ++bj) { const int c = bj * 128 + col0, g = c >> 4, h0 = c & 15;
                        *(u32x4*)(A2 + ((size_t)g * NR16 + (r >> 4)) * 512 + 256 + (r & 15) * 16 + h0) = pack8(acc[ai][bj][m][0], acc[ai][bj][m][1]); } }
        } else {
            const bool rope_on = lat && u.pn <= 4; const int pcol0 = u.pn * 256 - 256;
            const float qs = (u.pn <= 2 || u.pn == 7) ? att::QSCALE : 1.f;
#pragma unroll
            for (int ai = 0; ai < 2; ++ai)
#pragma unroll
                for (int m = 0; m < 4; ++m) { const int rl = ai * 128 + row0 + m * 16, r = u.pm * 256 + rl, t = pl * 256 + rl;
#pragma unroll
                    for (int bj = 0; bj < 2; ++bj) { const int c = bj * 128 + col0; f32x4 v0 = acc[ai][bj][m][0] * qs, v1 = acc[ai][bj][m][1] * qs;
                        if (rope_on) { const int i0 = (c & 63) >> 1, axis = i0 >> 4, k0 = i0 & 15, pos = axis ? (t & 63) : (t >> 6);
                            const f32x4 cs0 = *(const f32x4*)(rope + (pos * 16 + k0) * 2), cs1 = *(const f32x4*)(rope + (pos * 16 + k0) * 2 + 4);
                            f32x4 w0, w1;
                            w0[0] = v0[0] * cs0[0] - v0[1] * cs0[1]; w0[1] = v0[0] * cs0[1] + v0[1] * cs0[0];
                            w0[2] = v0[2] * cs0[2] - v0[3] * cs0[3]; w0[3] = v0[2] * cs0[3] + v0[3] * cs0[2];
                            w1[0] = v1[0] * cs1[0] - v1[1] * cs1[1]; w1[1] = v1[0] * cs1[1] + v1[1] * cs1[0];
                            w1[2] = v1[2] * cs1[2] - v1[3] * cs1[3]; w1[3] = v1[2] * cs1[3] + v1[3] * cs1[2];
                            v0 = w0; v1 = w1; }
                        *(u32x4*)(P + (size_t)r * PW + pcol0 + c) = pack8(v0, v1); } }
        }
    }
};
struct EpiZ {
    float* Z;
    __device__ __forceinline__ void operator()(const f32x4 (&acc)[2][2][4][2], const GUnit& u, int wr, int wc, int fr, int fq) const {
        EPI_ROWS_COLS;
#pragma unroll
        for (int ai = 0; ai < 2; ++ai)
#pragma unroll
            for (int m = 0; m < 4; ++m) { float* rp = Z + ((size_t)u.aux * NR16 + u.pm * 256 + ai * 128 + row0 + m * 16) * 256;
#pragma unroll
                for (int bj = 0; bj < 2; ++bj) { *(f32x4*)(rp + bj * 128 + col0) = acc[ai][bj][m][0]; *(f32x4*)(rp + bj * 128 + col0 + 4) = acc[ai][bj][m][1]; } }
    }
};
struct EpiY {
    bf16* G;
    __device__ __forceinline__ void operator()(const f32x4 (&acc)[2][2][4][2], const GUnit& u, int wr, int wc, int fr, int fq) const {
        EPI_ROWS_COLS;
#pragma unroll
        for (int ai = 0; ai < 2; ++ai)
#pragma unroll
            for (int m = 0; m < 4; ++m) { const int r16 = u.pm * 256 + ai * 128 + row0 + m * 16;
#pragma unroll
                for (int bj = 0; bj < 2; ++bj) { const int c = bj * 128 + col0, i = c >> 4, h0 = c & 15; f32x4 v0 = acc[ai][bj][m][0], v1 = acc[ai][bj][m][1];
#pragma unroll
                    for (int k = 0; k < 4; ++k) { v0[k] = gelu_tanh(v0[k]); v1[k] = gelu_tanh(v1[k]); }
                    *(u32x4*)(G + ((size_t)r16 * 16 + i) * 256 + u.aux * 16 + h0) = pack8(v0, v1); } }
    }
};
struct EpiGlu {
    const bf16* G; bf16* Y; const float* bglu;
    __device__ __forceinline__ void operator()(const f32x4 (&acc)[2][2][4][2], const GUnit& u, int wr, int wc, int fr, int fq) const {
        EPI_ROWS_COLS;
#pragma unroll
        for (int bj = 0; bj < 2; ++bj) { const int c = bj * 128 + col0; const f32x4 b0 = *(const f32x4*)(bglu + c), b1 = *(const f32x4*)(bglu + c + 4);
#pragma unroll
            for (int ai = 0; ai < 2; ++ai)
#pragma unroll
                for (int m = 0; m < 4; ++m) { const size_t r = (size_t)u.pm * 256 + ai * 128 + row0 + m * 16;
                    const u32x4 gw = *(const u32x4*)(G + r * 256 + c); f32x4 v0 = acc[ai][bj][m][0] + b0, v1 = acc[ai][bj][m][1] + b1;
                    v0[0] = bf2f(gw.x & 0xffffu) * sigmoidf_(v0[0]); v0[1] = bf2f(gw.x >> 16) * sigmoidf_(v0[1]); v0[2] = bf2f(gw.y & 0xffffu) * sigmoidf_(v0[2]); v0[3] = bf2f(gw.y >> 16) * sigmoidf_(v0[3]);
                    v1[0] = bf2f(gw.z & 0xffffu) * sigmoidf_(v1[0]); v1[1] = bf2f(gw.z >> 16) * sigmoidf_(v1[1]); v1[2] = bf2f(gw.w & 0xffffu) * sigmoidf_(v1[2]); v1[3] = bf2f(gw.w >> 16) * sigmoidf_(v1[3]);
                    *(u32x4*)(Y + r * DM + c) = pack8(v0, v1); } }
    }
};
template <bool F32SRC>
struct EpiRes {
    const float* srcL; const float* srcC; bf16* XR; const float* gate;
    __device__ __forceinline__ void operator()(const f32x4 (&acc)[2][2][4][2], const GUnit& u, int wr, int wc, int fr, int fq) const {
        EPI_ROWS_COLS; const int b = u.pm / PPB, pl = u.pm - b * PPB; const bool isc = pl >= 16;
        const float* src = isc ? srcC + (size_t)b * CTXL * DM : srcL + ((size_t)b * SEQ + pl * 256) * DM; bf16* dst = XR + (size_t)u.pm * 256 * DM; const float* gv = gate + (isc ? 16 : b) * 6144;
        if constexpr (F32SRC) {
#pragma unroll
            for (int bj = 0; bj < 2; ++bj) { const int c = u.pn * 256 + bj * 128 + col0; const f32x4 g0 = *(const f32x4*)(gv + c), g1 = *(const f32x4*)(gv + c + 4);
#pragma unroll
                for (int ai = 0; ai < 2; ++ai)
#pragma unroll
                    for (int m = 0; m < 4; ++m) { const size_t o = (size_t)(ai * 128 + row0 + m * 16) * DM + c; const f32x4 x0 = *(const f32x4*)(src + o), x1 = *(const f32x4*)(src + o + 4);
                        *(u32x4*)(dst + o) = pack8(x0 + g0 * acc[ai][bj][m][0], x1 + g1 * acc[ai][bj][m][1]); } }
        } else {
            u32x4 xw[2][2][4];
#pragma unroll
            for (int bj = 0; bj < 2; ++bj)
#pragma unroll
                for (int ai = 0; ai < 2; ++ai)
#pragma unroll
                    for (int m = 0; m < 4; ++m) xw[bj][ai][m] = *(const u32x4*)(dst + (size_t)(ai * 128 + row0 + m * 16) * DM + u.pn * 256 + bj * 128 + col0);
#pragma unroll
            for (int bj = 0; bj < 2; ++bj) { const int c = u.pn * 256 + bj * 128 + col0; const f32x4 g0 = *(const f32x4*)(gv + c), g1 = *(const f32x4*)(gv + c + 4);
#pragma unroll
                for (int ai = 0; ai < 2; ++ai)
#pragma unroll
                    for (int m = 0; m < 4; ++m) { const size_t o = (size_t)(ai * 128 + row0 + m * 16) * DM + c; const u32x4 w = xw[bj][ai][m];
                        const f32x4 x0 = {bf2f(w.x & 0xffffu), bf2f(w.x >> 16), bf2f(w.y & 0xffffu), bf2f(w.y >> 16)}, x1 = {bf2f(w.z & 0xffffu), bf2f(w.z >> 16), bf2f(w.w & 0xffffu), bf2f(w.w >> 16)};
                        *(u32x4*)(dst + o) = pack8(x0 + g0 * acc[ai][bj][m][0], x1 + g1 * acc[ai][bj][m][1]); } }
        }
    }
};
struct EpiSwi {
    bf16* H;
    __device__ __forceinline__ void operator()(const f32x4 (&acc)[2][2][4][2], const GUnit& u, int wr, int wc, int fr, int fq) const {
        EPI_ROWS_COLS; const int c = u.pn * 128 + col0;
#pragma unroll
        for (int ai = 0; ai < 2; ++ai)
#pragma unroll
            for (int m = 0; m < 4; ++m) { const size_t r = (size_t)u.aux * 256 + ai * 128 + row0 + m * 16; f32x4 v0, v1;
#pragma unroll
                for (int k = 0; k < 4; ++k) { v0[k] = siluf_(acc[ai][0][m][0][k]) * acc[ai][1][m][0][k]; v1[k] = siluf_(acc[ai][0][m][1][k]) * acc[ai][1][m][1][k]; }
                *(u32x4*)(H + r * FF + c) = pack8(v0, v1); }
    }
};
struct EpiMoeDown {
    bf16* XR; const float* gate; const int* rsrc; const float* rgate;
    __device__ __forceinline__ void operator()(const f32x4 (&acc)[2][2][4][2], const GUnit& u, int wr, int wc, int fr, int fq) const {
        EPI_ROWS_COLS;
#pragma unroll
        for (int ai = 0; ai < 2; ++ai)
#pragma unroll
            for (int m = 0; m < 4; ++m) { const int pos = u.aux + ai * 128 + row0 + m * 16; const int tok = rsrc[pos];
                if (tok >= 0) { const float rg = rgate[pos]; const int b = tok / RB; const bool isc = (tok - b * RB) >= SEQ; bf16* dst = XR + (size_t)tok * DM; const float* gv = gate + (isc ? 16 : b) * 6144;
#pragma unroll
                    for (int bj = 0; bj < 2; ++bj) { const int c = u.pn * 256 + bj * 128 + col0;
                        const f32x4 g0 = *(const f32x4*)(gv + c) * rg, g1 = *(const f32x4*)(gv + c + 4) * rg; const u32x4 w = *(const u32x4*)(dst + c);
                        const f32x4 x0 = {bf2f(w.x & 0xffffu), bf2f(w.x >> 16), bf2f(w.y & 0xffffu), bf2f(w.y >> 16)}, x1 = {bf2f(w.z & 0xffffu), bf2f(w.z >> 16), bf2f(w.w & 0xffffu), bf2f(w.w >> 16)};
                        *(u32x4*)(dst + c) = pack8(x0 + g0 * acc[ai][bj][m][0], x1 + g1 * acc[ai][bj][m][1]); } } }
    }
};

struct SchedRows {
    const char* A; const char* B; size_t a_tile, b_tile; int nM, nN, pm0, a_local, wgm, lat_only;
    __device__ __forceinline__ bool next(int i, GUnit& u) const { int pm, pn; if (!pg8::tile_order(i, GRID, bx_opaque(), nM, nN, wgm, pm, pn)) return false;
        u.pm = lat_only ? pm + (pm >> 4) : pm0 + pm; u.pn = pn; u.aux = pm; u.rows = nullptr; u.A = A + (size_t)(a_local ? pm : u.pm) * a_tile; u.B = B + (size_t)pn * b_tile; return true; }
};
struct SchedS5 {
    const char* A; const char* B; size_t b_group;
    __device__ __forceinline__ bool next(int i, GUnit& u) const { const int L = i * GRID + bx_opaque(); if (L >= 17 * 16) return false;
        const int g = L & 15, pm = L >> 4; u.pm = pm; u.pn = 0; u.aux = g; u.rows = nullptr;
        u.A = A + ((size_t)g * NR16 + (size_t)pm * 256) * 512 * 2; u.B = B + (size_t)g * b_group; return true; }
};
struct SchedMoe {
    const char* A; const char* B; const int* rsrc; const LAS int* mbase; int np, nN, p0, slot, down; size_t b_exp, b_tile; int wgm;
    __device__ __forceinline__ bool next(int i, GUnit& u) const { int pm, pn; if (!pg8::tile_order(i, GRID, bx_opaque(), np, nN, wgm, pm, pn)) return false;
        const int gp = p0 + pm; int e = 0;
#pragma unroll
        for (int k = 1; k < 8; ++k) e += (gp * 256 >= mbase[slot * 8 + k]) ? 1 : 0;
        e = __builtin_amdgcn_readfirstlane(e);
        u.pm = gp; u.pn = pn; u.B = B + (size_t)e * b_exp + (size_t)pn * b_tile;
        if (down) { u.aux = gp * 256; u.rows = nullptr; u.A = A + (size_t)pm * 256 * FF * 2; }
        else { u.aux = pm; u.rows = rsrc + (size_t)gp * 256; u.A = A; }
        return true; }
};
__device__ __forceinline__ void transpose_item(const float* __restrict__ W, int N, bf16* __restrict__ WT, int Kd, int dst_row0, int k0, int n0, LAS float* scr, int lane) {
    { const int kq = lane >> 3, n4 = (lane & 7) * 4; f32x4 v[8];
#pragma unroll
      for (int i = 0; i < 8; ++i) v[i] = *(const f32x4*)(W + (size_t)(k0 + kq + 8 * i) * N + n0 + n4);
#pragma unroll
      for (int i = 0; i < 8; ++i) { LAS float* d = scr + (kq + 8 * i) * 33 + n4; d[0] = v[i][0]; d[1] = v[i][1]; d[2] = v[i][2]; d[3] = v[i][3]; } }
    LDS_WAIT(); asm volatile("" ::: "memory");
    const int c = lane & 7;
#pragma unroll
    for (int j = 0; j < 4; ++j) { const int n = (lane >> 3) + 8 * j; const LAS float* s = scr + (8 * c) * 33 + n;
        u32x4 o; o.x = pk2(s[0 * 33], s[1 * 33]); o.y = pk2(s[2 * 33], s[3 * 33]); o.z = pk2(s[4 * 33], s[5 * 33]); o.w = pk2(s[6 * 33], s[7 * 33]);
        *(u32x4*)(WT + (size_t)(dst_row0 + n) * Kd + k0 + 8 * c) = o; }
    LDS_WAIT(); asm volatile("" ::: "memory");
}
__device__ __forceinline__ void prologue_weights(const KA& p, LAS unsigned char* lds, int wid, int lane) {
    LAS float* scr = (LAS float*)(lds + wid * 16384);
    const int gw = bx_opaque() * NWAVES + wid;
    constexpr int PER_LAYER = 1280 + 512 + 32, N_A = NLAYER * PER_LAYER, PER_F = 3 * 1408, N_ALL = N_A + 18 * PER_F;
    unsigned char* ws = p.ws();
    for (int it = gw; it < N_ALL; it += NGW) {
        if (it < N_A) { const int l = it / PER_LAYER; int r = it - l * PER_LAYER;
            if (r < 1280) { transpose_item(p.in(I_WIN) + (size_t)l * DM * INW, INW, (bf16*)(ws + WS_WIN) + (size_t)l * INW * DM, DM, 32 * (r % 80), 64 * (r / 80), 32 * (r % 80), scr, lane); continue; } r -= 1280;
            if (r < 512) { transpose_item(p.in(I_WOUT) + (size_t)l * DM * DM, DM, (bf16*)(ws + WS_WOUT) + (size_t)l * DM * DM, DM, 32 * (r % 32), 64 * (r / 32), 32 * (r % 32), scr, lane); continue; } r -= 512;
            transpose_item(p.in(I_WGLU) + (size_t)l * 65536, 256, (bf16*)(ws + WS_WGLU) + (size_t)l * 65536, 256, 32 * (r % 8), 64 * (r / 8), 32 * (r % 8), scr, lane);
        } else { const int r0 = it - N_A, f = r0 / PER_F, r = r0 - f * PER_F, which = r / 1408, q = r - which * 1408;
            const bool dense = f < 2; const int mi = dense ? f : f - 2;
            const size_t wo = (size_t)mi * DM * FF;
            if (which < 2) { const float* W = (which == 0 ? (dense ? p.in(I_FW1) : p.in(I_MW1)) : (dense ? p.in(I_FW3) : p.in(I_MW3))) + wo;
                bf16* WT = (bf16*)(ws + (dense ? WS_W13D : WS_W13M) + (size_t)mi * SZ_W13);
                const int kb = q / 88, nb = q % 88, n0 = 32 * nb;
                transpose_item(W, FF, WT, DM, (n0 >> 7) * 256 + which * 128 + (n0 & 127), 64 * kb, n0, scr, lane);
            } else { const float* W = (dense ? p.in(I_FW2) : p.in(I_MW2)) + wo; bf16* WT = (bf16*)(ws + (dense ? WS_W2D : WS_W2M) + (size_t)mi * SZ_W2);
                const int kb = q / 32, nb = q % 32; transpose_item(W, DM, WT, FF, 32 * nb, 64 * kb, 32 * nb, scr, lane); }
        }
    }
}
__device__ __forceinline__ void prologue_mod(const KA& p, LAS unsigned char* lds, int tid, int wid, int lane) {
    LAS float* sc = (LAS float*)lds; LAS float* red = (LAS float*)(lds + 17 * 1024 * 4);
    __syncthreads();
    for (int idx = tid; idx < 17 * 1024; idx += NTHREADS) { const int cond = idx >> 10, k = idx & 1023; const float v = cond < 16 ? p.in(I_C)[cond * 1024 + k] : p.in(I_CCTX)[k]; sc[idx] = v / (1.f + expf(-v)); }
    __syncthreads();
    float* MOD = (float*)(p.ws() + WS_MOD);
    for (int u = bx_opaque(); u < NLAYER * 96; u += GRID) { const int l = u / 96, cb = u % 96;
        float acc[17];
#pragma unroll
        for (int c = 0; c < 17; ++c) acc[c] = 0.f;
        const float* wp = p.in(I_WMOD) + ((size_t)l * 1024 + wid * 128) * 6144 + cb * 64 + lane;
        for (int k = 0; k < 128; k += 16) { float w[16];
#pragma unroll
            for (int q = 0; q < 16; ++q) w[q] = wp[(size_t)(k + q) * 6144];
#pragma unroll
            for (int q = 0; q < 16; q += 4)
#pragma unroll
                for (int c = 0; c < 17; ++c) { const f32x4 s = *(const LAS f32x4*)(sc + c * 1024 + wid * 128 + k + q); acc[c] += s[0] * w[q] + s[1] * w[q + 1] + s[2] * w[q + 2] + s[3] * w[q + 3]; } }
#pragma unroll
        for (int c = 0; c < 17; ++c) red[(wid * 17 + c) * 64 + lane] = acc[c];
        __syncthreads();
        for (int o = tid; o < 17 * 64; o += NTHREADS) { const int c = o >> 6, j = o & 63; float s = p.in(I_BMOD)[l * 6144 + cb * 64 + j];
#pragma unroll
            for (int w = 0; w < 8; ++w) s += red[(w * 17 + c) * 64 + j];
            MOD[((size_t)l * 17 + c) * 6144 + cb * 64 + j] = s; }
        __syncthreads();
    }
}
__device__ __forceinline__ void prologue_small_tables(const KA& p, int tid) {
    float* rope = (float*)(p.ws() + WS_ROPE); float* lamt = (float*)(p.ws() + WS_LAM);
    for (int i = tid; i < 1024; i += NTHREADS) { const int pos = i >> 4, k = i & 15; const float inv = exp2f(-(float)k * (13.287712379549449f / 16.f)); const float a = (float)pos * inv; rope[2 * i] = cosf(a); rope[2 * i + 1] = sinf(a); }
    if (tid < NLAYER) { const int l = tid; float d1 = 0.f, d2 = 0.f;
        for (int k = 0; k < 64; ++k) { d1 += p.in(I_LQ1)[l * 64 + k] * p.in(I_LK1)[l * 64 + k]; d2 += p.in(I_LQ2)[l * 64 + k] * p.in(I_LK2)[l * 64 + k]; }
        const float li = 0.8f - 0.6f * expf(-0.3f * (float)l); lamt[2 * l] = expf(d1) - expf(d2) + li; lamt[2 * l + 1] = li; }
}
__device__ __forceinline__ f32x2 cpow_turns(float lre_dt, double rev, int k) {
    const float mag = expf((float)k * lre_dt); double tk = rev * (double)k; tk -= __builtin_floor(tk + 0.5); const float ang = (float)(tk * 6.283185307179586);
    return (f32x2){mag * cosf(ang), mag * sinf(ang)};
}
__device__ __forceinline__ void prologue_s5(const KA& p, LAS unsigned char* lds, int tid, int l, int g) {
    LAS f32x2* apow = (LAS f32x2*)lds;
    LAS f32x2* bb = (LAS f32x2*)(lds + 17408);
    LAS f32x2* cc = (LAS f32x2*)(lds + 33792);
    LAS float* KT = (LAS float*)(lds + 50176);
    __syncthreads();
    if (tid < 128) { const int dir = tid >> 6, pp = tid & 63, gi = (l * 2 + dir) * 16 + g, idx = gi * 64 + pp;
        const float lre = p.in(I_LAMRE)[idx], lim = p.in(I_LAMIM)[idx], dt = expf(p.in(I_LOGSTEP)[gi]);
        const double rev = (double)lim * (double)dt * 0.15915494309189535; const float lre_dt = lre * dt;
        for (int k = 0; k <= 16; ++k) apow[(dir * 17 + k) * 64 + pp] = cpow_turns(lre_dt, rev, k);
        const f32x2 a1 = cpow_turns(lre_dt, rev, 1), a16 = cpow_turns(lre_dt, rev, 16), a544 = cpow_turns(lre_dt, rev, 544);
        ((f32x4*)(p.ws() + WS_A16))[idx] = (f32x4){a16.x, a16.y, a544.x, a544.y};
        const float nre = a1.x - 1.f, nim = a1.y, den = lre * lre + lim * lim, fre = (nre * lre + nim * lim) / den, fim = (nim * lre - nre * lim) / den;
        for (int h = 0; h < 16; ++h) { const float br = p.in(I_BRE)[(size_t)idx * 16 + h], bi = p.in(I_BIM)[(size_t)idx * 16 + h]; bb[(dir * 64 + pp) * 16 + h] = (f32x2){fre * br - fim * bi, fre * bi + fim * br}; } }
    for (int e = tid; e < 2048; e += NTHREADS) { const int dir = e >> 10, h = (e >> 6) & 15, pp = e & 63; const size_t ci = ((size_t)((l * 2 + dir) * 16 + g) * 16 + h) * 64 + pp;
        cc[e] = (f32x2){p.in(I_CRE)[ci], p.in(I_CIM)[ci]}; }
    __syncthreads();
    bf16* W1 = (bf16*)(p.ws() + WS_S5W1) + (size_t)(l * 16 + g) * 65536; bf16* W2 = (bf16*)(p.ws() + WS_S5W2) + (size_t)(l * 16 + g) * 131072;
    for (int it = 0; it < 128; ++it) { const int e = it * NTHREADS + tid, n = e >> 8, k = e & 255;
        { const int dir = n >> 7, part = (n >> 6) & 1, pp = n & 63, j = k >> 4, hh = k & 15, pw = dir == 0 ? 15 - j : j;
          const f32x2 a = apow[(dir * 17 + pw) * 64 + pp], b = bb[(dir * 64 + pp) * 16 + hh];
          W1[e] = (bf16)f2bf(part ? (a.x * b.y + a.y * b.x) : (a.x * b.x - a.y * b.y)); }
        { const int i = n >> 4, h = n & 15, dir = k >> 7, part = (k >> 6) & 1, pp = k & 63, pw = dir == 0 ? i + 1 : 16 - i;
          const f32x2 a = apow[(dir * 17 + pw) * 64 + pp], c = cc[(dir * 16 + h) * 64 + pp];
          W2[(size_t)n * 512 + k] = (bf16)f2bf(part ? -(c.x * a.y + c.y * a.x) : (c.x * a.x - c.y * a.y)); } }
    { const int dir = tid >> 8, h = (tid >> 4) & 15, hh = tid & 15;
      for (int lag = 0; lag < 16; ++lag) { float s = 0.f;
          for (int pp = 0; pp < 64; ++pp) { const f32x2 c = cc[(dir * 16 + h) * 64 + pp], a = apow[(dir * 17 + lag) * 64 + pp], b = bb[(dir * 64 + pp) * 16 + hh];
              const float cax = c.x * a.x - c.y * a.y, cay = c.x * a.y + c.y * a.x; s += cax * b.x - cay * b.y; }
          KT[(dir * 16 + lag) * 256 + h * 16 + hh] = s; } }
    __syncthreads();
    for (int it = 0; it < 128; ++it) { const int e = it * NTHREADS + tid, n = e >> 8, kk = e & 255, i = n >> 4, h = n & 15, j = kk >> 4, hh = kk & 15;
        float v = 0.f; if (j <= i) v += KT[(i - j) * 256 + h * 16 + hh]; if (j >= i) v += KT[(16 + j - i) * 256 + h * 16 + hh];
        if (i == j && h == hh) v += p.in(I_SSMD)[l * 256 + g * 16 + h];
        W2[(size_t)n * 512 + 256 + kk] = (bf16)f2bf(v); }
    __syncthreads();
}

template <bool ROUTER, bool F32SRC>
__device__ __forceinline__ void norm_phase(const KA& p, LAS unsigned char* lds, int tid, int wid, int lane, const float* srcL, const float* srcC, const float* gvec, const float* shiftv, const float* scalev,
                                           const float* router, bool skip_ctx) {
    bf16* HX = (bf16*)((unsigned char*)p.out() + OUT_HX); const bf16* XR = (const bf16*)(p.ws() + WS_XR);
    const int gw = bx_opaque() * NWAVES + wid;
    LAS int* wcnt = (LAS int*)lds + wid * 16;
    f32x4 wr0[ROUTER ? 16 : 1], wr1[ROUTER ? 16 : 1];
    if constexpr (ROUTER) {
        __syncthreads(); if (lane < 16) wcnt[lane] = 0;
        int* rsrc = (int*)(p.ws() + WS_RSRC); for (int i = bx_opaque() * NTHREADS + tid; i < MOE_ROWS; i += GRID * NTHREADS) rsrc[i] = -1;
#pragma unroll
        for (int j = 0; j < 4; ++j)
#pragma unroll
            for (int k = 0; k < 4; ++k) { const int c = 4 * lane + 256 * j + k; wr0[j * 4 + k] = *(const f32x4*)(router + (size_t)c * 8); wr1[j * 4 + k] = *(const f32x4*)(router + (size_t)c * 8 + 4); }
    }
    f32x4 Av[4], Bv[4]; int cur_cond = -1;
    constexpr int NB_ROWS = F32SRC ? 4 : (ROUTER ? 3 : 9);
    for (int rr0 = 0; rr0 < RPW; rr0 += NB_ROWS) {
        f32x4 rawf[F32SRC ? NB_ROWS : 1][4]; u32x2 rawh[F32SRC ? 1 : NB_ROWS][4];
#pragma unroll
        for (int d = 0; d < NB_ROWS; ++d) if (rr0 + d < RPW) { const int r = gw * RPW + rr0 + d;
            if constexpr (F32SRC) { bool isc; const size_t ro = res_off(r, isc); const float* xr = (isc ? srcC : srcL) + ro;
#pragma unroll
                for (int j = 0; j < 4; ++j) rawf[d][j] = *(const f32x4*)(xr + 4 * lane + 256 * j); }
            else {
#pragma unroll
                for (int j = 0; j < 4; ++j) rawh[d][j] = *(const u32x2*)(XR + (size_t)r * DM + 4 * lane + 256 * j); } }
#pragma unroll
        for (int d = 0; d < NB_ROWS; ++d) if (rr0 + d < RPW) { const int r = gw * RPW + rr0 + d; const int bq = r / RB; const bool isc = (r - bq * RB) >= SEQ; const int cond = isc ? 16 : bq;
        if (cond != cur_cond) { cur_cond = cond;
#pragma unroll
            for (int j = 0; j < 4; ++j) { const int c = 4 * lane + 256 * j; const f32x4 g = *(const f32x4*)(gvec + c), s = *(const f32x4*)(scalev + (size_t)cond * 6144 + c); Av[j] = g * (s + 1.f); Bv[j] = *(const f32x4*)(shiftv + (size_t)cond * 6144 + c); } }
        f32x4 v[4]; float ss = 0.f;
#pragma unroll
        for (int j = 0; j < 4; ++j) {
            if constexpr (F32SRC) v[j] = rawf[d][j];
            else { const u32x2 w = rawh[d][j]; v[j] = (f32x4){bf2f(w.x & 0xffffu), bf2f(w.x >> 16), bf2f(w.y & 0xffffu), bf2f(w.y >> 16)}; }
            ss += (v[j][0] * v[j][0] + v[j][1] * v[j][1]) + (v[j][2] * v[j][2] + v[j][3] * v[j][3]); }
        const float rinv = 1.f / sqrtf(wave_sum(ss) * (1.f / DM) + 1e-6f);
#pragma unroll
        for (int j = 0; j < 4; ++j) { v[j] = v[j] * rinv * Av[j] + Bv[j]; *(u32x2*)(HX + (size_t)r * DM + 4 * lane + 256 * j) = (u32x2){pk2(v[j][0], v[j][1]), pk2(v[j][2], v[j][3])}; }
        if constexpr (ROUTER) {
            int* toke = (int*)(p.ws() + WS_TOKE); f32x2* tokg = (f32x2*)(p.ws() + WS_TOKG);
            if (isc && skip_ctx) { if (lane == 0) toke[r] = 0xFFFF; }
            else { f32x4 l0 = {0.f, 0.f, 0.f, 0.f}, l1 = {0.f, 0.f, 0.f, 0.f};
#pragma unroll
                for (int j = 0; j < 4; ++j)
#pragma unroll
                    for (int k = 0; k < 4; ++k) { l0 += wr0[j * 4 + k] * v[j][k]; l1 += wr1[j * 4 + k] * v[j][k]; }
                float lg[8];
#pragma unroll
                for (int e = 0; e < 4; ++e) { lg[e] = wave_sum(l0[e]); lg[4 + e] = wave_sum(l1[e]); }
                int e0 = 0; float v0 = lg[0];
#pragma unroll
                for (int e = 1; e < 8; ++e) if (lg[e] > v0) { v0 = lg[e]; e0 = e; }
                int e1 = -1; float v1 = -3.0e38f;
#pragma unroll
                for (int e = 0; e < 8; ++e) if (e != e0 && lg[e] > v1) { v1 = lg[e]; e1 = e; }
                const float g0 = 1.f / (1.f + expf(v1 - v0));
                if (lane == 0) { toke[r] = e0 | (e1 << 8); tokg[r] = (f32x2){g0, 1.f - g0}; wcnt[e0] += 1; wcnt[8 + e1] += 1; } }
        }
        }
    }
    if constexpr (ROUTER) { LDS_WAIT(); if (lane < 16) ((int*)(p.ws() + WS_WCNT))[gw * 16 + lane] = wcnt[lane]; }
}
__device__ __forceinline__ void route2_phase(const KA& p, LAS unsigned char* lds, LAS int* mbase_lds, int tid, int wid, int lane) {
    LAS int* segsum = (LAS int*)lds;
    LAS int* wpre = segsum + 512;
    LAS int* tot = wpre + 128;
    LAS int* wstart = tot + 16;
    const int* wcnt = (const int*)(p.ws() + WS_WCNT);
    __syncthreads();
    { const int seg = tid >> 4, bin = tid & 15, myseg = bx_opaque() >> 3, wg0 = (bx_opaque() & 7) * 8; int s = 0;
      for (int k = 0; k < 64; ++k) { const int c = wcnt[(seg * 64 + k) * 16 + bin]; if (seg == myseg && k >= wg0 && k < wg0 + 8) wpre[(k - wg0) * 16 + bin] = s; s += c; }
      segsum[seg * 16 + bin] = s; }
    __syncthreads();
    if (tid < 16) { int s = 0; for (int k = 0; k < 32; ++k) s += segsum[k * 16 + tid]; tot[tid] = s; }
    __syncthreads();
    if (tid == 0) { int b = 0; for (int k = 0; k < 16; ++k) { mbase_lds[k] = b; b += (tot[k] + 255) & ~255; } mbase_lds[16] = b; }
    __syncthreads();
    if (bx_opaque() == 0 && tid < 17) ((int*)(p.ws() + WS_MBASE))[tid] = mbase_lds[tid];
    if (tid < 128) { const int w = tid >> 4, bin = tid & 15, myseg = bx_opaque() >> 3; int s = mbase_lds[bin] + wpre[w * 16 + bin]; for (int k = 0; k < myseg; ++k) s += segsum[k * 16 + bin]; wstart[w * 16 + bin] = s; }
    __syncthreads();
    if (lane == 0) { const int gw = bx_opaque() * NWAVES + wid; const int* toke = (const int*)(p.ws() + WS_TOKE); const f32x2* tokg = (const f32x2*)(p.ws() + WS_TOKG);
        int* rsrc = (int*)(p.ws() + WS_RSRC); float* rgate = (float*)(p.ws() + WS_RGATE);
        for (int rr = 0; rr < RPW; ++rr) { const int r = gw * RPW + rr; const int te = toke[r]; if (te == 0xFFFF) continue; const f32x2 g = tokg[r];
            const int e0 = te & 255, e1 = te >> 8; const int p0 = wstart[wid * 16 + e0]; wstart[wid * 16 + e0] = p0 + 1; const int p1 = wstart[wid * 16 + 8 + e1]; wstart[wid * 16 + 8 + e1] = p1 + 1;
            rsrc[p0] = r; rgate[p0] = g.x; rsrc[p1] = r; rgate[p1] = g.y; } }
    __syncthreads();
}
__device__ __forceinline__ void carry_phase(const KA& p, LAS unsigned char* lds, int tid, int wid, int lane, int l) {
    LAS f32x2* segend = (LAS f32x2*)lds;
    const float* Z = (const float*)(p.ws() + WS_ZLOC); bf16* A2 = (bf16*)((unsigned char*)p.out() + OUT_A2);
    for (int u = bx_opaque(); u < NB * 16 * 2; u += GRID) { const int dir = u & 1, g = (u >> 1) & 15, b = u >> 5;
        const f32x4 at = ((const f32x4*)(p.ws() + WS_A16))[((l * 2 + dir) * 16 + g) * 64 + lane];
        const float ar = at[0], ai = at[1];
        const size_t zrow0 = (size_t)g * NR16 + (size_t)b * 272;
        float zr = 0.f, zi = 0.f;
        for (int k = 0; k < 34; ++k) { const int q = wid * 34 + k, cp = dir == 0 ? (q < 16 ? 256 + q : q - 16) : 271 - q;
            const float* zp = Z + (zrow0 + cp) * 256 + dir * 128 + lane; const float lr = zp[0], li = zp[64];
            const float nr = ar * zr - ai * zi + lr, ni = ar * zi + ai * zr + li; zr = nr; zi = ni; }
        __syncthreads();
        segend[wid * 64 + lane] = (f32x2){zr, zi};
        __syncthreads();
        float cr = 0.f, ci = 0.f;
        for (int w = 0; w < wid; ++w) { const f32x2 s = segend[w * 64 + lane]; const float nr = at[2] * cr - at[3] * ci + s.x, ni = at[2] * ci + at[3] * cr + s.y; cr = nr; ci = ni; }
        zr = cr; zi = ci;
        for (int k = 0; k < 34; ++k) { const int q = wid * 34 + k, cp = dir == 0 ? (q < 16 ? 256 + q : q - 16) : 271 - q;
            const float* zp = Z + (zrow0 + cp) * 256 + dir * 128 + lane; const float lr = zp[0], li = zp[64];
            bf16* ap = A2 + (zrow0 + cp) * 512 + dir * 128 + lane; ap[0] = (bf16)f2bf(zr); ap[64] = (bf16)f2bf(zi);
            const float nr = ar * zr - ai * zi + lr, ni = ar * zi + ai * zr + li; zr = nr; zi = ni; }
    }
    __syncthreads();
}
__device__ __forceinline__ void final_phase(const KA& p, int wid, int lane) {
    const int gw = bx_opaque() * NWAVES + wid; f32x4 g[4]; const bf16* XR = (const bf16*)(p.ws() + WS_XR);
#pragma unroll
    for (int j = 0; j < 4; ++j) g[j] = *(const f32x4*)(p.in(I_GFINAL) + 4 * lane + 256 * j);
    for (int rl0 = gw * 32; rl0 < gw * 32 + 32; rl0 += 8) { u32x2 raw[8][4];
#pragma unroll
        for (int d = 0; d < 8; ++d) { const int rl = rl0 + d, b = rl >> 12, n = rl & 4095; const bf16* xr = XR + ((size_t)b * RB + n) * DM;
#pragma unroll
            for (int j = 0; j < 4; ++j) raw[d][j] = *(const u32x2*)(xr + 4 * lane + 256 * j); }
#pragma unroll
        for (int d = 0; d < 8; ++d) { float* orow = p.out() + (size_t)(rl0 + d) * DM; f32x4 v[4]; float ss = 0.f;
#pragma unroll
            for (int j = 0; j < 4; ++j) { const u32x2 w = raw[d][j]; v[j] = (f32x4){bf2f(w.x & 0xffffu), bf2f(w.x >> 16), bf2f(w.y & 0xffffu), bf2f(w.y >> 16)};
                ss += (v[j][0] * v[j][0] + v[j][1] * v[j][1]) + (v[j][2] * v[j][2] + v[j][3] * v[j][3]); }
            const float rinv = 1.f / sqrtf(wave_sum(ss) * (1.f / DM) + 1e-6f);
#pragma unroll
            for (int j = 0; j < 4; ++j) *(f32x4*)(orow + 4 * lane + 256 * j) = v[j] * rinv * g[j]; } }
}

constexpr int DIFF_STASH_OFF = 57344;
__device__ __forceinline__ void diff_unit(const bf16* P, bf16* Y, int rows0, int h, int kbase, int NT, const float* lamp, const float* gsub, LAS unsigned char* lds) {
    const int tid = tid_opaque(), lane = tid & 63, wid = __builtin_amdgcn_readfirstlane(tid >> 6), r32 = lane & 31, hi = lane >> 5;
    LAS bf16* st = (LAS bf16*)(lds + DIFF_STASH_OFF) + wid * 4096 + r32;
    {
        f32x16 o[4];
        att::attn_body<128, 0>(P + (size_t)rows0 * PW + PC_DQ + h * 128, P + PC_DK + h * 128, P + PC_DV + h * 128, kbase, NT, 0, NT, lds, o, 0, 0);
#pragma unroll
        for (int r = 0; r < 16; ++r)
#pragma unroll
            for (int d = 0; d < 4; ++d) st[att::crow(r, hi) * 128 + d * 32] = (bf16)f2bf(o[d][r]);
    }
    asm volatile("s_waitcnt lgkmcnt(0)" ::: "memory"); __builtin_amdgcn_sched_barrier(0);
    {
        f32x16 o[4];
        att::attn_body<128, 0>(P + (size_t)rows0 * PW + PC_DQ + h * 128 + 64, P + PC_DK + h * 128 + 64, P + PC_DV + h * 128, kbase, NT, 0, NT, lds, o, 0, 0);
        bf16* yw = Y + (size_t)(rows0 + wid * 32) * DM + 256 + h * 128 + r32;
        const float lam = lamp[0], lam_init = lamp[1];
        float ss[16];
#pragma unroll
        for (int r = 0; r < 16; ++r) { ss[r] = 0.f;
#pragma unroll
            for (int d = 0; d < 4; ++d) { const float o1 = bf2f((unsigned)st[att::crow(r, hi) * 128 + d * 32]); const float v = o1 - lam * o[d][r]; o[d][r] = v; ss[r] += v * v; } }
#pragma unroll
        for (int r = 0; r < 16; ++r) {
            ss[r] = half_sum(ss[r]);
            ss[r] = (1.f / sqrtf(ss[r] * (1.f / 128.f) + 1e-5f)) * (1.f - lam_init); }
        float gs[4];
#pragma unroll
        for (int d = 0; d < 4; ++d) gs[d] = gsub[d * 32 + r32];
#pragma unroll
        for (int r = 0; r < 16; ++r)
#pragma unroll
            for (int d = 0; d < 4; ++d) yw[(size_t)att::crow(r, hi) * DM + d * 32] = (bf16)f2bf(o[d][r] * ss[r] * gs[d]);
    }
}
__device__ __forceinline__ void na_unit(const bf16* P, bf16* Y, const float* rpb_h, int b, int h, int qb, LAS unsigned char* lds) {
    const int tid = tid_opaque(), lane = tid & 63, wid = __builtin_amdgcn_readfirstlane(tid >> 6), r32 = lane & 31, hi = lane >> 5; const int rows0 = b * RB + qb * 256, r0 = qb * 4;
    const int kmin = min(min(max(r0 - 4, 0), 56), 52);
    __syncthreads();
    { LAS float* tbl = (LAS float*)(lds + att::OFF_RPB); if (tid < 465) tbl[tid] = rpb_h[tid] * 1.4426950408889634f; }
    f32x16 o[2];
    att::attn_body<64, 1>(P + (size_t)rows0 * PW + PC_NQ + h * 64, P + PC_NK + h * 64, P + PC_NV + h * 64, b * RB + SEQ, 4, b * RB + kmin * 64, 16, lds, o, r0 + (wid >> 1), kmin);
    bf16* yw = Y + (size_t)(rows0 + wid * 32) * DM + 768 + h * 64 + r32;
#pragma unroll
    for (int r = 0; r < 16; ++r)
#pragma unroll
        for (int d = 0; d < 2; ++d) yw[(size_t)att::crow(r, hi) * DM + d * 32] = (bf16)f2bf(o[d][r]);
}
__device__ __forceinline__ void na_ctx_unit(const bf16* P, bf16* Y, int b, int h, LAS unsigned char* lds) {
    const int tid = tid_opaque(), lane = tid & 63, wid = __builtin_amdgcn_readfirstlane(tid >> 6), r32 = lane & 31, hi = lane >> 5; const int rows0 = b * RB + SEQ;
    f32x16 o[2];
    att::attn_body<64, 0>(P + (size_t)rows0 * PW + PC_NQ + h * 64, P + PC_NK + h * 64, P + PC_NV + h * 64, rows0, 4, 0, 4, lds, o, 0, 0);
    bf16* yw = Y + (size_t)(rows0 + wid * 32) * DM + 768 + h * 64 + r32;
#pragma unroll
    for (int r = 0; r < 16; ++r)
#pragma unroll
        for (int d = 0; d < 2; ++d) yw[(size_t)att::crow(r, hi) * DM + d * 32] = (bf16)f2bf(o[d][r]);
}
#ifndef WGM_IN
#define WGM_IN 4
#endif
#ifndef WGM_OUT
#define WGM_OUT 4
#endif
#ifndef WGM_UP
#define WGM_UP 4
#endif
#ifndef WGM_DOWN
#define WGM_DOWN 4
#endif
__global__ void __launch_bounds__(NTHREADS, 2) dit_fwd(Params p_unused) {
    (void)p_unused;
    extern __shared__ __attribute__((aligned(16))) unsigned char lds_raw[];
    LAS unsigned char* lds = (LAS unsigned char*)lds_raw;
    volatile LAS unsigned* MISC = (volatile LAS unsigned*)(lds + MISC_OFF);
    LAS int* mbase = (LAS int*)(lds + MISC_OFF + 128);
#define PH_ARGS KA p; p.k = (const CAS unsigned char*)__builtin_amdgcn_kernarg_segment_ptr(); asm volatile("" : "+s"(p.k)); unsigned char* const ws = p.ws(); (void)ws
#define PH_IDS PH_ARGS; const int tid = tid_opaque(), lane = tid & 63, wid = __builtin_amdgcn_readfirstlane(tid >> 6); (void)lane; (void)wid
#define BX (bx_opaque())
#define VCU ((BX & 7) * (GRID / 8) + (BX >> 3))
    for (int u = (int)threadIdx.x; u < (LDS_BYTES - LDSCTL_OFF) / 4; u += NTHREADS) ((LAS unsigned*)(lds + LDSCTL_OFF))[u] = 0u;
    __syncthreads();
    { PH_ARGS; (void)xcd_barrier_post((unsigned*)(ws + WS_CTL) + CW_BAR, MISC + 8); }
#define GRID_BAR_T(FIRST) do { PH_ARGS; XcdBarrier b_; b_.bar = (unsigned*)(ws + WS_CTL) + CW_BAR; b_.x = xb_xcc_id(); b_.st = (volatile LAS unsigned*)(lds + MISC_OFF) + 8; xcd_barrier<FIRST>(b_); } while (0)
#define GRID_BAR() GRID_BAR_T(false)

#define MOD ((float*)(ws + WS_MOD))
#define OUTB ((unsigned char*)p.out())
#define XR ((bf16*)(ws + WS_XR))
#define HX ((bf16*)(OUTB + OUT_HX))
#define P ((bf16*)(ws + WS_P))
#define H ((bf16*)(ws + WS_H))
#define A2 ((bf16*)(OUTB + OUT_A2))
#define ZL ((float*)(ws + WS_ZLOC))
#define GB ((bf16*)(OUTB + OUT_GBUF))
#define MODL (MOD + (size_t)l * 17 * 6144)

    { PH_IDS; prologue_weights(p, lds, wid, lane);
      prologue_mod(p, lds, tid, wid, lane);
      if (BX >= 128 && BX < 192) prologue_s5(p, lds, tid, (BX - 128) >> 4, (BX - 128) & 15);
      if (BX == 255) prologue_small_tables(p, tid); }
    GRID_BAR_T(true);

    for (int l = 0; l < NLAYER; ++l) {
        const int last = (l == NLAYER - 1) ? 1 : 0;
        { PH_IDS; if (l == 0) norm_phase<false, true>(p, lds, tid, wid, lane, p.in(I_X), p.in(I_CTX), p.in(I_GMIX), MODL, MODL + 1024, nullptr, false);
          else norm_phase<false, false>(p, lds, tid, wid, lane, nullptr, nullptr, p.in(I_GMIX) + l * DM, MODL, MODL + 1024, nullptr, false); }
        GRID_BAR();
        { PH_ARGS; SchedRows S{(const char*)HX, (const char*)(ws + WS_WIN) + (size_t)l * INW * DM * 2, (size_t)256 * DM * 2, (size_t)256 * DM * 2, NPANEL, INW / 256, 0, 0, WGM_IN, 0};
          EpiInProj E{P, A2, (const float*)(ws + WS_ROPE)};
          pg8::gemm_phase<EpiInProj, SchedRows, false>(lds, DM, DM, DM, S, E); }
        GRID_BAR();
        { PH_ARGS; SchedS5 S{(const char*)A2 + 512, (const char*)(ws + WS_S5W1) + (size_t)l * 16 * 65536 * 2, (size_t)65536 * 2}; EpiZ E{ZL};
          pg8::gemm_phase<EpiZ, SchedS5, false>(lds, 256, 512, 256, S, E); }
        GRID_BAR();
        { PH_IDS; carry_phase(p, lds, tid, wid, lane, l); }
        GRID_BAR();
        { PH_ARGS; SchedS5 S{(const char*)A2, (const char*)(ws + WS_S5W2) + (size_t)l * 16 * 131072 * 2, (size_t)131072 * 2}; EpiY E{GB};
          pg8::gemm_phase<EpiY, SchedS5, false>(lds, 512, 512, 512, S, E); }
        { PH_ARGS; const float* lamp = (const float*)(ws + WS_LAM) + 2 * l; const float* gsub = p.in(I_SUBLN) + l * 128; const int vcu = VCU;
          for (int it = 0; it < 4; ++it) { const int bh = (vcu >> 4) + 16 * it, b = bh >> 2, h = bh & 3, qb = vcu & 15;
              diff_unit(P, HX, b * RB + qb * 256, h, b * RB, RB / 64, lamp, gsub, lds); }
          if (vcu < 64 && !last) { const int b = vcu >> 2, h = vcu & 3; diff_unit(P, HX, b * RB + SEQ, h, b * RB + SEQ, CTXL / 64, lamp, gsub, lds); }
          for (int it = 0; it < 4; ++it) { const int bh = (vcu >> 4) + 16 * it, b = bh >> 2, h = bh & 3, qb = vcu & 15;
              na_unit(P, HX, p.in(I_RPB) + (size_t)(l * 4 + h) * 465, b, h, qb, lds); }
          if (vcu >= 64 && vcu < 128 && !last) { const int b = (vcu - 64) >> 2, h = vcu & 3; na_ctx_unit(P, HX, b, h, lds); }
          __syncthreads(); }
        GRID_BAR();
        { PH_ARGS; SchedRows S{(const char*)GB, (const char*)(ws + WS_WGLU) + (size_t)l * 65536 * 2, (size_t)256 * 256 * 2, (size_t)256 * 256 * 2, last ? NB * 16 : NPANEL, 1, 0, 0, 4, last};
          EpiGlu E{GB, HX, p.in(I_BGLU) + l * 256};
          pg8::gemm_phase<EpiGlu, SchedRows, false>(lds, 256, 256, 256, S, E); }
        GRID_BAR();
        { PH_ARGS; SchedRows S{(const char*)HX, (const char*)(ws + WS_WOUT) + (size_t)l * DM * DM * 2, (size_t)256 * DM * 2, (size_t)256 * DM * 2, last ? NB * 16 : NPANEL, 4, 0, 0, WGM_OUT, last};
          if (l == 0) { EpiRes<true> E{p.in(I_X), p.in(I_CTX), XR, MODL + 2 * 1024}; pg8::gemm_phase<EpiRes<true>, SchedRows, false>(lds, DM, DM, DM, S, E); }
          else { EpiRes<false> E{nullptr, nullptr, XR, MODL + 2 * 1024}; pg8::gemm_phase<EpiRes<false>, SchedRows, false>(lds, DM, DM, DM, S, E); } }
        GRID_BAR();
        { PH_IDS; if (l & 1) norm_phase<true, false>(p, lds, tid, wid, lane, nullptr, nullptr, p.in(I_GFFN) + l * DM, MODL + 3 * 1024, MODL + 4 * 1024, p.in(I_ROUTER) + (size_t)(l >> 1) * DM * 8, l == NLAYER - 1);
          else norm_phase<false, false>(p, lds, tid, wid, lane, nullptr, nullptr, p.in(I_GFFN) + l * DM, MODL + 3 * 1024, MODL + 4 * 1024, nullptr, false); }
        GRID_BAR();
        if (!(l & 1)) {
            const int fi = l >> 1;
            for (int c = 0; c < 2; ++c) { const int pm0 = c * HCHUNK_PANELS, np = (NPANEL - pm0) < HCHUNK_PANELS ? (NPANEL - pm0) : HCHUNK_PANELS;
                { PH_ARGS; SchedRows S{(const char*)HX, (const char*)(ws + WS_W13D) + (size_t)fi * SZ_W13, (size_t)256 * DM * 2, (size_t)256 * DM * 2, np, 22, pm0, 0, WGM_UP, 0}; EpiSwi E{H};
                  pg8::gemm_phase<EpiSwi, SchedRows, false>(lds, DM, DM, DM, S, E); }
                GRID_BAR();
                { PH_ARGS; SchedRows S{(const char*)H, (const char*)(ws + WS_W2D) + (size_t)fi * SZ_W2, (size_t)256 * FF * 2, (size_t)256 * FF * 2, np, 4, pm0, 1, WGM_DOWN, 0};
                  EpiRes<false> E{nullptr, nullptr, XR, MODL + 5 * 1024};
                  pg8::gemm_phase<EpiRes<false>, SchedRows, false>(lds, FF, FF, FF, S, E); }
                GRID_BAR(); }
        } else {
            const int mi = l >> 1;
            { PH_IDS; route2_phase(p, lds, mbase, tid, wid, lane); }
            GRID_BAR();
            for (int s = 0; s < 2; ++s) { const int P0 = __builtin_amdgcn_readfirstlane(mbase[8 * s] >> 8), P1 = __builtin_amdgcn_readfirstlane(mbase[8 * s + 8] >> 8);
                for (int c = 0; c < 2; ++c) { const int p0 = P0 + c * HCHUNK_PANELS; if (p0 >= P1) break; const int np = (P1 - p0) < HCHUNK_PANELS ? (P1 - p0) : HCHUNK_PANELS;
                    { PH_ARGS; SchedMoe S{(const char*)HX, (const char*)(ws + WS_W13M) + (size_t)mi * 8 * SZ_W13, (const int*)(ws + WS_RSRC), mbase, np, 22, p0, s, 0, SZ_W13, (size_t)256 * DM * 2, WGM_UP}; EpiSwi E{H};
                      pg8::gemm_phase<EpiSwi, SchedMoe, true>(lds, DM, DM, DM, S, E); }
                    GRID_BAR();
                    { PH_ARGS; SchedMoe S{(const char*)H, (const char*)(ws + WS_W2M) + (size_t)mi * 8 * SZ_W2, (const int*)(ws + WS_RSRC), mbase, np, 4, p0, s, 1, SZ_W2, (size_t)256 * FF * 2, WGM_DOWN};
                      EpiMoeDown E{XR, MODL + 5 * 1024, (const int*)(ws + WS_RSRC), (const float*)(ws + WS_RGATE)};
                      pg8::gemm_phase<EpiMoeDown, SchedMoe, false>(lds, FF, FF, FF, S, E); }
                    GRID_BAR(); } }
        }
    }
    { PH_IDS; final_phase(p, wid, lane); }
#undef GRID_BAR
#undef GRID_BAR_T
#undef BX
#undef VCU
#undef MOD
#undef XR
#undef OUTB
#undef HX
#undef P
#undef H
#undef A2
#undef ZL
#undef GB
#undef MODL
}

extern "C" void kernel_launch(void* const* d_in, const int* in_sizes, int n_in, void* d_out, int out_size, void* d_ws, size_t ws_size, hipStream_t stream) {
    static int ready = 0;
    if (ready == 0) {
        if (n_in != 34 || in_sizes[0] != NB * SEQ * DM || out_size != NB * SEQ * DM || ws_size < WS_END) {
            fprintf(stderr, "kernel_launch: shape/workspace mismatch (n_in %d, x %d, out %d, ws %zu, need %zu); nothing launched\n", n_in, n_in > 0 ? in_sizes[0] : -1, out_size, ws_size, (size_t)WS_END); ready = -1; return; }
        if (hipFuncSetAttribute((const void*)dit_fwd, hipFuncAttributeMaxDynamicSharedMemorySize, LDS_BYTES) != hipSuccess) { fprintf(stderr, "kernel_launch: hipFuncSetAttribute failed\n"); ready = -1; return; }
        int per_cu = 0;
        if (hipOccupancyMaxActiveBlocksPerMultiprocessor(&per_cu, (const void*)dit_fwd, NTHREADS, LDS_BYTES) != hipSuccess || per_cu < 1) fprintf(stderr, "kernel_launch: note: occupancy query reports %d workgroups per CU\n", per_cu);
        (void)hipGetLastError();
        ready = 1;
    }
    if (ready < 0) return;
    if (hipMemsetAsync((char*)d_ws + WS_CTL, 0, CTL_BYTES, stream) != hipSuccess) { fprintf(stderr, "kernel_launch: memset failed\n"); return; }
    Params prm{};
    for (int i = 0; i < 34; ++i) prm.in[i] = (const float*)d_in[i];
    prm.out = (float*)d_out; prm.ws = (unsigned char*)d_ws;
    hipLaunchKernelGGL(dit_fwd, dim3(GRID), dim3(NTHREADS), LDS_BYTES, stream, prm);
    const hipError_t le = hipPeekAtLastError();
    if (le != hipSuccess) fprintf(stderr, "kernel_launch: launch failed: %s\n", hipGetErrorName(le));
}
```

```cpp
#include <hip/hip_runtime.h>
#include <cstdio>
#include <cstdint>

#define GAS __attribute__((address_space(1)))
#define LAS __attribute__((address_space(3)))
typedef unsigned short bf16;
typedef short bf16x8 __attribute__((ext_vector_type(8)));
typedef short s16x4 __attribute__((ext_vector_type(4)));
typedef float f32x2 __attribute__((ext_vector_type(2)));
typedef float f32x4 __attribute__((ext_vector_type(4)));
typedef float f32x8 __attribute__((ext_vector_type(8)));
typedef float f32x16 __attribute__((ext_vector_type(16)));
typedef unsigned u32x2 __attribute__((ext_vector_type(2)));
typedef unsigned u32x4 __attribute__((ext_vector_type(4)));

constexpr int DM = 1024, NB = 16, SEQ = 4096, CTXL = 256, RB = SEQ + CTXL, NR = NB * RB, NLAYER = 4;
constexpr int INW = 2560, PW = 2304, FF = 2816, NEXP = 8;
constexpr int PC_DQ = 0, PC_DK = 512, PC_DV = 1024, PC_NQ = 1536, PC_NK = 1792, PC_NV = 2048;
constexpr int NPANEL = NR / 256, PPB = RB / 256;
constexpr int NR16 = NR / 16;
constexpr int GRID = 256, NWAVES = 8, NTHREADS = 512, NGW = GRID * NWAVES, RPW = NR / NGW;
static_assert(RPW * NGW == NR, "rows per wave");
constexpr int MOE_ROWS = 2 * NR + 4096;
constexpr int HCHUNK_PANELS = 256;

constexpr size_t al4k(size_t x) { return (x + 4095) & ~(size_t)4095; }
constexpr size_t WS_CTL = 0, CTL_BYTES = 1u << 20;
constexpr size_t WS_MOD = WS_CTL + CTL_BYTES;                          constexpr size_t SZ_MOD = (size_t)NLAYER * 17 * 6144 * 4;
constexpr size_t WS_ROPE = al4k(WS_MOD + SZ_MOD);                      constexpr size_t SZ_ROPE = 64 * 16 * 8;
constexpr size_t WS_LAM = al4k(WS_ROPE + SZ_ROPE);                     constexpr size_t SZ_LAM = 4096;
constexpr size_t WS_A16 = al4k(WS_LAM + SZ_LAM);                       constexpr size_t SZ_A16 = (size_t)NLAYER * 2 * 16 * 64 * 16;
constexpr size_t WS_S5W1 = al4k(WS_A16 + SZ_A16);                      constexpr size_t SZ_S5W1 = (size_t)NLAYER * 16 * 256 * 256 * 2;
constexpr size_t WS_S5W2 = al4k(WS_S5W1 + SZ_S5W1);                    constexpr size_t SZ_S5W2 = (size_t)NLAYER * 16 * 256 * 512 * 2;
constexpr size_t WS_WIN = al4k(WS_S5W2 + SZ_S5W2);                     constexpr size_t SZ_WIN = (size_t)NLAYER * INW * DM * 2;
constexpr size_t WS_WOUT = al4k(WS_WIN + SZ_WIN);                      constexpr size_t SZ_WOUT = (size_t)NLAYER * DM * DM * 2;
constexpr size_t WS_WGLU = al4k(WS_WOUT + SZ_WOUT);                    constexpr size_t SZ_WGLU = (size_t)NLAYER * 256 * 256 * 2;
constexpr size_t WS_W13D = al4k(WS_WGLU + SZ_WGLU);                    constexpr size_t SZ_W13 = (size_t)2 * FF * DM * 2;
constexpr size_t WS_W2D = al4k(WS_W13D + 2 * SZ_W13);                  constexpr size_t SZ_W2 = (size_t)DM * FF * 2;
constexpr size_t WS_W13M = al4k(WS_W2D + 2 * SZ_W2);
constexpr size_t WS_W2M = al4k(WS_W13M + 16 * SZ_W13);
constexpr size_t SZ_HX = (size_t)NR * DM * 2;
constexpr size_t WS_XR = al4k(WS_W2M + 16 * SZ_W2);
constexpr size_t WS_P = al4k(WS_XR + SZ_HX);                           constexpr size_t SZ_P = (size_t)NR * PW * 2;
constexpr size_t WS_H = WS_P;                                          constexpr size_t SZ_H = (size_t)HCHUNK_PANELS * 256 * FF * 2;
constexpr size_t SZ_A2 = (size_t)16 * NR16 * 512 * 2, SZ_GBUF = (size_t)NR * 256 * 2;
constexpr size_t WS_ZLOC = al4k(WS_P + SZ_P);                          constexpr size_t SZ_ZLOC = (size_t)16 * NR16 * 256 * 4;
constexpr size_t WS_TOKE = al4k(WS_ZLOC + SZ_ZLOC);                    constexpr size_t SZ_TOKE = (size_t)NR * 4;
constexpr size_t WS_TOKG = al4k(WS_TOKE + SZ_TOKE);                    constexpr size_t SZ_TOKG = (size_t)NR * 8;
constexpr size_t WS_WCNT = al4k(WS_TOKG + SZ_TOKG);                    constexpr size_t SZ_WCNT = (size_t)NGW * 16 * 4;
constexpr size_t WS_MBASE = al4k(WS_WCNT + SZ_WCNT);                   constexpr size_t SZ_MBASE = 4096;
constexpr size_t WS_RSRC = al4k(WS_MBASE + SZ_MBASE);                  constexpr size_t SZ_RSRC = (size_t)MOE_ROWS * 4;
constexpr size_t WS_RGATE = al4k(WS_RSRC + SZ_RSRC);                   constexpr size_t SZ_RGATE = (size_t)MOE_ROWS * 4;
constexpr size_t WS_END = al4k(WS_RGATE + SZ_RGATE);
constexpr size_t OUT_HX = 0, OUT_A2 = OUT_HX + SZ_HX, OUT_GBUF = OUT_A2 + SZ_A2;
static_assert(OUT_GBUF + SZ_GBUF <= (size_t)NB * SEQ * DM * 4 && OUT_A2 % 4096 == 0 && OUT_GBUF % 4096 == 0, "scratch tensors inside d_out");
static_assert(WS_ZLOC == WS_P + SZ_P && SZ_H <= SZ_P + SZ_ZLOC, "hidden chunk overlays P and Zloc (both dead during the FFN)");
static_assert(WS_END <= ((size_t)1 << 30), "workspace map must fit 1 GiB");
constexpr int CW_BAR = 4096;

constexpr int RING_BYTES = 131072;
constexpr int LDSCTL_OFF = RING_BYTES;
constexpr int MISC_OFF = LDSCTL_OFF + 320;
constexpr int LDS_BYTES = 147456;

__device__ __forceinline__ unsigned f2bf(float f) { unsigned u = __builtin_bit_cast(unsigned, f); return (u + 0x7fffu + ((u >> 16) & 1u)) >> 16; }
__device__ __forceinline__ unsigned pk2(float lo, float hi) { return f2bf(lo) | (f2bf(hi) << 16); }
__device__ __forceinline__ float bf2f(unsigned h) { return __builtin_bit_cast(float, h << 16); }
__device__ __forceinline__ unsigned cvt_pk_bf16(float lo, float hi) { unsigned r; asm volatile("v_cvt_pk_bf16_f32 %0, %1, %2" : "=v"(r) : "v"(lo), "v"(hi)); return r; }
template <int X> __device__ __forceinline__ float swz_xor(float v) { return __builtin_bit_cast(float, __builtin_amdgcn_ds_swizzle(__builtin_bit_cast(int, v), (X << 10) | 0x1f)); }
__device__ __forceinline__ float half_sum(float v) {
    v += swz_xor<1>(v); v += swz_xor<2>(v); v += swz_xor<4>(v); v += swz_xor<8>(v); v += swz_xor<16>(v); return v; }
__device__ __forceinline__ float wave_sum(float v) {
    v = half_sum(v);
    auto rr = __builtin_amdgcn_permlane32_swap(__float_as_uint(v), __float_as_uint(v), false, false);
    return __uint_as_float(rr[0]) + __uint_as_float(rr[1]);
}
__device__ __forceinline__ int bx_opaque() { int b = (int)blockIdx.x; asm volatile("" : "+s"(b)); return b; }
__device__ __forceinline__ int tid_opaque() { int t = (int)threadIdx.x; asm volatile("" : "+v"(t)); return t; }
#define LDS_WAIT() asm volatile("s_waitcnt lgkmcnt(0)" ::: "memory")
#define VM_WAIT() asm volatile("s_waitcnt vmcnt(0)" ::: "memory")
__device__ __forceinline__ float fast_exp(float x) { return __builtin_amdgcn_exp2f(x * 1.4426950408889634f); }
__device__ __forceinline__ float sigmoidf_(float x) { return __builtin_amdgcn_rcpf(1.f + fast_exp(-x)); }
__device__ __forceinline__ float siluf_(float x) { return x * sigmoidf_(x); }
__device__ __forceinline__ float gelu_tanh(float x) {
    const float u = 0.7978845608028654f * (x + 0.044715f * x * x * x);
    return x * sigmoidf_(2.f * u);
}

#define XB_TMO      128
#define XB_XCNT(j)  (256  + 64 * (j))
#define XB_XSUB(j)  (1280 + 64 * (j))
#define XB_XGEN(j)  (2304 + 64 * (j))
#define XB_TOP      3328
#define XB_TOPGEN   3392
#define XCD_BAR_WORDS 3456
#define XB_SPIN_CAP (1u << 18)

__device__ __forceinline__ unsigned xb_ld(unsigned* p)              { return __hip_atomic_load(p, __ATOMIC_RELAXED, __HIP_MEMORY_SCOPE_AGENT); }
__device__ __forceinline__ unsigned xb_add(unsigned* p, unsigned v) { return __hip_atomic_fetch_add(p, v, __ATOMIC_RELAXED, __HIP_MEMORY_SCOPE_AGENT); }
__device__ __forceinline__ unsigned xb_xcc_id() { return (unsigned)__builtin_amdgcn_s_getreg((3 << 11) | 20) & 0xFu; }
#define XB_SPIN(cond, bar) do { unsigned _sp = 0; while (cond) { __builtin_amdgcn_s_sleep(1); \
    if ((++_sp & 255u) == 0u) { if (xb_ld(&(bar)[XB_TMO])) break; if (_sp > XB_SPIN_CAP) { atomicAdd(&(bar)[XB_TMO], 1u); break; } } } } while (0)

struct XcdBarrier {
    unsigned* bar; unsigned x;
    volatile LAS unsigned* st;
};
__device__ __forceinline__ XcdBarrier xcd_barrier_post(unsigned* bar, volatile LAS unsigned* st) {
    XcdBarrier b; b.bar = bar; b.x = xb_xcc_id(); b.st = st;
    if (threadIdx.x == 0) (void)xb_add(&bar[XB_XCNT(b.x)], 1u);
    return b;
}
__device__ __forceinline__ void xcd_barrier_complete(unsigned* bar, unsigned x, unsigned& nloc, unsigned& nx) {
    const unsigned G = gridDim.x * gridDim.y * gridDim.z;
    unsigned sum, cnt, mine, sp = 0u;
    for (;;) {
        sum = 0u; cnt = 0u; mine = 0u;
#pragma unroll
        for (unsigned j = 0; j < 16; ++j) { const unsigned c = xb_ld(&bar[XB_XCNT(j)]); sum += c; cnt += (c > 0u) ? 1u : 0u; mine = (j == x) ? c : mine; }
        if (sum == G) break;
        __builtin_amdgcn_s_sleep(1);
        if ((++sp & 255u) == 0u) { if (xb_ld(&bar[XB_TMO])) break; if (sp > XB_SPIN_CAP) { atomicAdd(&bar[XB_TMO], 1u); break; } }
    }
    nloc = mine > 0u ? mine : 1u; nx = cnt > 0u ? cnt : 1u;
}
template <bool FIRST>
__device__ __forceinline__ void xcd_barrier(const XcdBarrier& b) {
    asm volatile("s_waitcnt vmcnt(0)" ::: "memory");
    __syncthreads();
    if (threadIdx.x == 0) {
        unsigned* bar = b.bar;
        __builtin_amdgcn_s_waitcnt(0);
        unsigned nloc = b.st[0], nx = b.st[1];
        if constexpr (FIRST) { if (nloc == 0u) { xcd_barrier_complete(bar, b.x, nloc, nx); b.st[0] = nloc; b.st[1] = nx; } }
        else { nloc = nloc ? nloc : 1u; nx = nx ? nx : 1u; }
        const unsigned old = xb_add(&bar[XB_XSUB(b.x)], 1u);
        const unsigned gen = old / nloc;
        if (old + 1u == (gen + 1u) * nloc) {
            __builtin_amdgcn_fence(__ATOMIC_RELEASE, "agent");
            asm volatile("s_waitcnt vmcnt(0)" ::: "memory");
            const unsigned og = xb_add(&bar[XB_TOP], 1u);
            const unsigned tg = og / nx;
            if (og + 1u == (tg + 1u) * nx) xb_add(&bar[XB_TOPGEN], 1u);
            else XB_SPIN(xb_ld(&bar[XB_TOPGEN]) == tg, bar);
            __builtin_amdgcn_fence(__ATOMIC_ACQUIRE, "agent");
            xb_add(&bar[XB_XGEN(b.x)], 1u);
            asm volatile("s_waitcnt vmcnt(0)" ::: "memory");
        } else {
            XB_SPIN(xb_ld(&bar[XB_XGEN(b.x)]) == gen, bar);
            __builtin_amdgcn_fence(__ATOMIC_ACQUIRE, "agent");
            asm volatile("s_waitcnt vmcnt(0)" ::: "memory");
        }
    }
    __syncthreads();
}

namespace pg8 {
__device__ __forceinline__ void glds16_s(const void* sbase, unsigned voff, unsigned lds_dst) {
    unsigned keep;
    asm volatile("s_mov_b32 %0, m0\n\ts_mov_b32 m0, %3\n\ts_nop 0\n\tglobal_load_lds_dwordx4 %1, %2\n\ts_mov_b32 m0, %0" : "=&s"(keep) : "v"(voff), "s"(sbase), "s"(lds_dst) : "memory");
}
constexpr int BM = 256, BK = 64, HALF = 128, HTB = HALF * BK * 2, STAGE_BYTES = 8 * HTB, NXCD = 8;
__host__ __device__ __forceinline__ int lds_byte(int r, int c) { const int st = (r >> 4) * 2 + (c >> 5), rr = r & 15, cc = c & 31, ob = rr * 64 + cc * 2; return st * 1024 + (ob ^ (((ob >> 9) & 1) << 5)); }
__host__ __device__ __forceinline__ void stage_rc(int b, int& R, int& C) { const int st = b / 1024, sb = b % 1024, swz = sb ^ (((sb >> 9) & 1) << 5); R = (st >> 1) * 16 + swz / 64; C = (st & 1) * 32 + (swz % 64) / 2; }
__host__ __device__ __forceinline__ int perm32(int rho) { const int n = rho >> 4, i = rho & 15; return 8 * (i >> 2) + 4 * n + (i & 3); }

struct GUnit { const char* A; const char* B; int pm, pn, aux; const int* rows; };

__device__ __forceinline__ bool tile_order(int i, int G, int c, int nM, int nN, int WGM, int& pm, int& pn) {
    const int nwg = nM * nN; const long L = (long)i * G + c; if (L >= nwg) return false;
    int wgid = (int)L; { const int q = nwg / NXCD, r = nwg % NXCD, xcd = wgid % NXCD, off = wgid / NXCD; wgid = (xcd < r ? xcd * (q + 1) : r * (q + 1) + (xcd - r) * q) + off; }
    const int nig = WGM * nN, gid = wgid / nig, fm = gid * WGM, gsz = (nM - fm) < WGM ? (nM - fm) : WGM;
    pm = fm + ((wgid % nig) % gsz); pn = (wgid % nig) / gsz; return true;
}

template <class Epi, class Sched, bool GATHER>
__device__ __forceinline__ void gemm_phase(LAS unsigned char* lds, const int K, const int lda, const int ldb, const Sched& S, const Epi& E) {
    const int tid = tid_opaque(), wid = __builtin_amdgcn_readfirstlane(tid >> 6), lane = tid & 63, wr = wid >> 2, wc = wid & 3, fr = lane & 15, fq = lane >> 4;
    int nt = K / BK; asm volatile("" : "+s"(nt));
    int sR[2], sC[2]; unsigned voffB[2];
#pragma unroll
    for (int i = 0; i < 2; ++i) { stage_rc(tid * 16 + i * 8192, sR[i], sC[i]); const int Rb = (sR[i] & ~31) + perm32(sR[i] & 31); voffB[i] = (unsigned)(Rb * ldb + sC[i]) * 2u; }
    const size_t kstep = (size_t)(BK * 2);
    const size_t hstepB = (size_t)HALF * ldb * 2;
    const unsigned ldsb = (unsigned)(uintptr_t)lds + (unsigned)wid * 1024u;
    const int aoff = lds_byte(wr * 64 + fr, fq * 8), boff = lds_byte(wc * 32 + fr, fq * 8);
#define PG8_SA(b, h) (((b) * 2 + (h)) * HTB)
#define PG8_SB(b, h) ((4 + (b) * 2 + (h)) * HTB)
#define PG8_STAGE(bufoff, gbase, voff) do { _Pragma("unroll") for (int _i = 0; _i < 2; ++_i) \
        glds16_s((const void*)(gbase), (voff)[_i], ldsb + (unsigned)((bufoff) + _i * 8192)); } while (0)
#define PG8_LDA(dst, b, h) do { _Pragma("unroll") for (int m = 0; m < 4; ++m) _Pragma("unroll") for (int k = 0; k < 2; ++k) dst[m][k] = *(const LAS bf16x8*)(lds + PG8_SA(b, h) + aoff + m * 2048 + k * 1024); } while (0)
#define PG8_LDB(dst, b, h) do { _Pragma("unroll") for (int n = 0; n < 2; ++n) _Pragma("unroll") for (int k = 0; k < 2; ++k) dst[n][k] = *(const LAS bf16x8*)(lds + PG8_SB(b, h) + boff + n * 2048 + k * 1024); } while (0)
#define PG8_MMA(ai, bj, At, Bt) do { __builtin_amdgcn_s_setprio(1); _Pragma("unroll") for (int m = 0; m < 4; ++m) _Pragma("unroll") for (int n = 0; n < 2; ++n) _Pragma("unroll") for (int k = 0; k < 2; ++k) \
        acc[ai][bj][m][n] = __builtin_amdgcn_mfma_f32_16x16x32_bf16(Bt[n][k], At[m][k], acc[ai][bj][m][n], 0, 0, 0); __builtin_amdgcn_s_setprio(0); } while (0)
#define PG8_WAIT_V(n) asm volatile("s_waitcnt vmcnt(" #n ")" ::: "memory")
#define PG8_WAIT_L(n) asm volatile("s_waitcnt lgkmcnt(" #n ")" ::: "memory")
#define PG8_BAR __builtin_amdgcn_s_barrier()
#define PG8_SCHED __builtin_amdgcn_sched_barrier(0)
#define PG8_AOFF(dst, u) do { _Pragma("unroll") for (int _h = 0; _h < 2; ++_h) _Pragma("unroll") for (int _i = 0; _i < 2; ++_i) { \
        if constexpr (GATHER) { int _r = (u).rows[_h * HALF + sR[_i]]; _r = _r < 0 ? 0 : _r; dst[_h][_i] = (unsigned)(_r * lda + sC[_i]) * 2u; } \
        else dst[_h][_i] = (unsigned)((_h * HALF + sR[_i]) * lda + sC[_i]) * 2u; } } while (0)
    GUnit cur, nxt; int ui = 0;
    if (!S.next(0, cur)) return;
    f32x4 acc[2][2][4][2];
#pragma unroll
    for (int a = 0; a < 2; ++a)
#pragma unroll
        for (int b = 0; b < 2; ++b)
#pragma unroll
            for (int m = 0; m < 4; ++m)
#pragma unroll
                for (int n = 0; n < 2; ++n) acc[a][b][m][n] = (f32x4){0.f, 0.f, 0.f, 0.f};
    bf16x8 At[4][2], B0[2][2], B1[2][2];
    unsigned oC[2][2], oN[2][2];
    PG8_AOFF(oC, cur);
    const char* cA = cur.A; const char* cB = cur.B;
    PG8_STAGE(PG8_SB(0, 0), cB, voffB); PG8_STAGE(PG8_SB(0, 1), cB + hstepB, voffB); PG8_STAGE(PG8_SA(0, 0), cA, oC[0]); PG8_STAGE(PG8_SA(0, 1), cA, oC[1]);
    if (wr == 1) PG8_BAR;
    PG8_WAIT_V(2); PG8_BAR;
    PG8_STAGE(PG8_SB(1, 0), cB + kstep, voffB); PG8_STAGE(PG8_SA(1, 0), cA + kstep, oC[0]); PG8_STAGE(PG8_SB(1, 1), cB + hstepB + kstep, voffB);
    PG8_WAIT_V(6); PG8_BAR;
    for (;;) {
        const bool has_next = S.next(ui + 1, nxt);
        const char* nA = has_next ? nxt.A : cA; const char* nB = has_next ? nxt.B : cB;
        if (has_next) { PG8_AOFF(oN, nxt); } else {
#pragma unroll
            for (int h = 0; h < 2; ++h)
#pragma unroll
                for (int i = 0; i < 2; ++i) oN[h][i] = oC[h][i]; }
        for (int t = 0; t < nt; t += 2) {
            const bool last = (t == nt - 2);
            const char* a1 = cA + (size_t)(t + 1) * kstep;
            const char* a2 = last ? nA : cA + (size_t)(t + 2) * kstep; const char* b2 = last ? nB : cB + (size_t)(t + 2) * kstep;
            const char* a3 = a2 + kstep; const char* b3 = b2 + kstep;
            unsigned o2[2][2];
#pragma unroll
            for (int h = 0; h < 2; ++h)
#pragma unroll
                for (int i = 0; i < 2; ++i) o2[h][i] = last ? oN[h][i] : oC[h][i];
            PG8_LDB(B0, 0, 0); PG8_LDB(B1, 0, 1); PG8_SCHED; PG8_LDA(At, 0, 0); PG8_STAGE(PG8_SA(1, 1), a1, oC[1]);
            PG8_WAIT_V(8); PG8_WAIT_L(0); PG8_BAR; PG8_MMA(0, 0, At, B0); PG8_MMA(0, 1, At, B1); PG8_BAR; PG8_SCHED;
            PG8_LDA(At, 0, 1); PG8_STAGE(PG8_SB(0, 0), b2, voffB); PG8_STAGE(PG8_SB(0, 1), b2 + hstepB, voffB); PG8_STAGE(PG8_SA(0, 0), a2, o2[0]);
            PG8_WAIT_V(8); PG8_WAIT_L(0); PG8_BAR; PG8_MMA(1, 0, At, B0); PG8_MMA(1, 1, At, B1); PG8_BAR; PG8_SCHED;
            PG8_LDB(B0, 1, 0); PG8_LDB(B1, 1, 1); PG8_SCHED; PG8_LDA(At, 1, 0); PG8_STAGE(PG8_SA(0, 1), a2, o2[1]);
            PG8_WAIT_V(8); PG8_WAIT_L(0); PG8_BAR; PG8_MMA(0, 0, At, B0); PG8_MMA(0, 1, At, B1); PG8_BAR; PG8_SCHED;
            PG8_LDA(At, 1, 1); PG8_STAGE(PG8_SB(1, 0), b3, voffB); PG8_STAGE(PG8_SB(1, 1), b3 + hstepB, voffB); PG8_STAGE(PG8_SA(1, 0), a3, o2[0]);
            PG8_WAIT_V(8); PG8_WAIT_L(0); PG8_BAR; PG8_MMA(1, 0, At, B0); PG8_MMA(1, 1, At, B1); PG8_BAR; PG8_SCHED;
        }
        if (wr == 0) PG8_BAR;
        E(acc, cur, wr, wc, fr, fq);
        if (!has_next) break;
#pragma unroll
        for (int a = 0; a < 2; ++a)
#pragma unroll
            for (int b = 0; b < 2; ++b)
#pragma unroll
                for (int m = 0; m < 4; ++m)
#pragma unroll
                    for (int n = 0; n < 2; ++n) acc[a][b][m][n] = (f32x4){0.f, 0.f, 0.f, 0.f};
        cur = nxt; cA = nA; cB = nB; ++ui;
#pragma unroll
        for (int h = 0; h < 2; ++h)
#pragma unroll
            for (int i = 0; i < 2; ++i) oC[h][i] = oN[h][i];
        if (wr == 1) PG8_BAR;
    }
    PG8_WAIT_V(0);
    PG8_BAR;
#undef PG8_SA
#undef PG8_SB
#undef PG8_STAGE
#undef PG8_LDA
#undef PG8_LDB
#undef PG8_MMA
#undef PG8_WAIT_V
#undef PG8_WAIT_L
#undef PG8_BAR
#undef PG8_SCHED
#undef PG8_AOFF
}
}
namespace att {
constexpr float QSCALE = 0.125f * 1.4426950408889634f;
constexpr float THR2 = 8.f * 1.4426950408889634f;
constexpr int SHM_V = 16384, SHM_K = 8192;
constexpr int OFF_V = 0, OFF_K = 2 * SHM_V, OFF_WS = OFF_K + 2 * SHM_K, OFF_RPB = OFF_WS + NWAVES * 64 * 4, ATT_LDS = OFF_RPB + 2048;
#define ATT_KSWZ(row, colB) ((row) * 128 + ((colB) ^ ((((row) >> 1) & 7) << 4)))
#define ATT_SBAR() __builtin_amdgcn_sched_barrier(0)
__device__ __forceinline__ int crow(int r, int hi) { return (r & 3) + 8 * (r >> 2) + 4 * hi; }

template <bool FIRST>
__device__ __forceinline__ void partialSM(f32x16& p0, f32x16& p1, float& mhat, f32x16& negm, float& alpha) {
#define ATT_MX3(a, b, c) __builtin_fmaxf(__builtin_fmaxf((a), (b)), (c))
    float a = ATT_MX3(p0[0], p0[1], p1[0]), b = ATT_MX3(p0[2], p0[3], p1[1]); a = ATT_MX3(a, p1[2], p1[3]);
#pragma unroll
    for (int r = 4; r < 16; r += 4) { a = ATT_MX3(a, p0[r], p0[r + 1]); b = ATT_MX3(b, p0[r + 2], p0[r + 3]); a = ATT_MX3(a, p1[r], p1[r + 1]); b = ATT_MX3(b, p1[r + 2], p1[r + 3]); }
#undef ATT_MX3
    float pmax = fmaxf(a, b);
    { auto rr = __builtin_amdgcn_permlane32_swap(__float_as_uint(pmax), __float_as_uint(pmax), false, false);
      pmax = fmaxf(__uint_as_float(rr[0]), __uint_as_float(rr[1])); }
    alpha = 1.f;
    if (FIRST || !__builtin_expect(__all(pmax <= THR2), 1)) { const float dl = FIRST ? pmax : fmaxf(pmax, 0.f); mhat += dl;
#pragma unroll
        for (int r = 0; r < 16; ++r) { p0[r] -= dl; p1[r] -= dl; }
#pragma unroll
        for (int r = 0; r < 16; ++r) negm[r] = -mhat;
        alpha = __builtin_amdgcn_exp2f(-dl); }
#pragma unroll
    for (int r = 0; r < 16; ++r) p0[r] = __builtin_amdgcn_exp2f(p0[r]);
}
__device__ __forceinline__ void finishSM(f32x16& p0, f32x16& p1, float alpha, float& l_reg, bf16x8& pa0, bf16x8& pa1, bf16x8& pa2, bf16x8& pa3) {
#pragma unroll
    for (int r = 0; r < 16; ++r) p1[r] = __builtin_amdgcn_exp2f(p1[r]);
    { f32x2 s2 = (f32x2){p0[0], p0[1]} + (f32x2){p1[0], p1[1]};
#pragma unroll
      for (int r = 2; r < 16; r += 2) { s2 += (f32x2){p0[r], p0[r + 1]}; s2 += (f32x2){p1[r], p1[r + 1]}; }
      float ps = s2[0] + s2[1];
      auto rr = __builtin_amdgcn_permlane32_swap(__float_as_uint(ps), __float_as_uint(ps), false, false);
      ps = __uint_as_float(rr[0]) + __uint_as_float(rr[1]);
      l_reg = l_reg * alpha + ps; }
#define ATT_PK4(P, BASE, OUT) do { u32x4 w = {cvt_pk_bf16(P[BASE + 0], P[BASE + 1]), cvt_pk_bf16(P[BASE + 2], P[BASE + 3]), cvt_pk_bf16(P[BASE + 4], P[BASE + 5]), cvt_pk_bf16(P[BASE + 6], P[BASE + 7])}; \
    OUT = __builtin_bit_cast(bf16x8, w); } while (0)
    ATT_PK4(p0, 0, pa0); ATT_PK4(p0, 8, pa1); ATT_PK4(p1, 0, pa2); ATT_PK4(p1, 8, pa3);
#undef ATT_PK4
}
__device__ __forceinline__ void qkt(f32x16& p0, f32x16& p1, const LAS unsigned char* Ks, const bf16x8* qr, const f32x16& negm, int r32, int hi) {
    p0 = negm; p1 = negm;
#pragma unroll
    for (int d0 = 0; d0 < 4; ++d0) { const int cb = (d0 * 16 + hi * 8) * 2;
        const bf16x8 b0 = *(const LAS bf16x8*)(Ks + ATT_KSWZ(r32, cb));
        const bf16x8 b1 = *(const LAS bf16x8*)(Ks + ATT_KSWZ(32 + r32, cb));
        p0 = __builtin_amdgcn_mfma_f32_32x32x16_bf16(b0, qr[d0], p0, 0, 0, 0);
        p1 = __builtin_amdgcn_mfma_f32_32x32x16_bf16(b1, qr[d0], p1, 0, 0, 0); }
}
__device__ __forceinline__ int v_st(int k, int c) { const int kk = k;     return ((kk >> 3) * 4 + (c >> 5)) * 512 + ((kk & 7) * 32 + (c & 31)) * 2; }
__device__ __forceinline__ int v_rd_base(int lane) { return ((lane & 3) << 3) | (((lane >> 2) & 3) << 6) | (((lane >> 4) & 1) << 5) | (((lane >> 5) & 1) << 8); }
constexpr int v_rd_off(int d0, int ks, int half) { return d0 * 512 + ks * 4096 + half * 2048; }
template <int OFF> __device__ __forceinline__ s16x4 tr_read(int vb) {
    s16x4 r; asm volatile("ds_read_b64_tr_b16 %0, %1 offset:%2" : "=&v"(r) : "v"(vb), "i"(OFF) : "memory"); return r;
}
template <int D0> __device__ __forceinline__ void pv_one(f32x16& od, int vb, bf16x8 pa0, bf16x8 pa1, bf16x8 pa2, bf16x8 pa3) {
    const s16x4 l0 = tr_read<v_rd_off(D0, 0, 0)>(vb), h0 = tr_read<v_rd_off(D0, 0, 1)>(vb), l1 = tr_read<v_rd_off(D0, 1, 0)>(vb), h1 = tr_read<v_rd_off(D0, 1, 1)>(vb);
    const s16x4 l2 = tr_read<v_rd_off(D0, 2, 0)>(vb), h2 = tr_read<v_rd_off(D0, 2, 1)>(vb), l3 = tr_read<v_rd_off(D0, 3, 0)>(vb), h3 = tr_read<v_rd_off(D0, 3, 1)>(vb);
    asm volatile("s_waitcnt lgkmcnt(0)" ::: "memory"); ATT_SBAR();
#define ATT_PKV(L, H) (bf16x8){L[0], L[1], L[2], L[3], H[0], H[1], H[2], H[3]}
    od = __builtin_amdgcn_mfma_f32_32x32x16_bf16(pa0, ATT_PKV(l0, h0), od, 0, 0, 0);
    od = __builtin_amdgcn_mfma_f32_32x32x16_bf16(pa1, ATT_PKV(l1, h1), od, 0, 0, 0);
    od = __builtin_amdgcn_mfma_f32_32x32x16_bf16(pa2, ATT_PKV(l2, h2), od, 0, 0, 0);
    od = __builtin_amdgcn_mfma_f32_32x32x16_bf16(pa3, ATT_PKV(l3, h3), od, 0, 0, 0);
#undef ATT_PKV
}
template <int DV> __device__ __forceinline__ void pv_all(f32x16* o, int vb, bf16x8 pa0, bf16x8 pa1, bf16x8 pa2, bf16x8 pa3) {
    pv_one<0>(o[0], vb, pa0, pa1, pa2, pa3); pv_one<1>(o[1], vb, pa0, pa1, pa2, pa3);
    if constexpr (DV == 128) { pv_one<2>(o[2], vb, pa0, pa1, pa2, pa3); pv_one<3>(o[3], vb, pa0, pa1, pa2, pa3); }
}
__device__ __forceinline__ void na_mask(f32x16& p0, f32x16& p1, int krow, int qrow, int cq, int hi, const LAS float* tbl) {
    const int start = min(max(qrow - 4, 0), 56); const bool rv = (krow >= start) && (krow < start + 8);
    const int ridx = min(max(krow - qrow + 7, 0), 14); const int cst = min(max(cq - 8, 0), 48);
    const LAS float* trow = tbl + ridx * 31 + (15 - cq);
#pragma unroll
    for (int r = 0; r < 16; ++r) { const int kc = crow(r, hi);
        const bool ok0 = rv && ((unsigned)(kc - cst) < 16u), ok1 = rv && ((unsigned)(kc + 32 - cst) < 16u);
        const float b0 = trow[ok0 ? kc : cq], b1 = trow[ok1 ? kc + 32 : cq];
        p0[r] = ok0 ? p0[r] + b0 : -1e30f; p1[r] = ok1 ? p1[r] + b1 : -1e30f; }
}

template <int DV, int MODE>
__device__ __forceinline__ void attn_body(const bf16* __restrict__ Qp, const bf16* __restrict__ Kp, const bf16* __restrict__ Vp, int baseA, int nA, int baseB, int NT,
                                          LAS unsigned char* lds, f32x16 (&o)[DV / 32], int qrow, int kmin) {
    const int tid = tid_opaque(), wid = __builtin_amdgcn_readfirstlane(tid >> 6), lane = tid & 63, r32 = lane & 31, hi = lane >> 5;
    LAS unsigned char* V_lds = lds + OFF_V; LAS unsigned char* K_lds = lds + OFF_K;
    LAS float* al_l = (LAS float*)(lds + OFF_WS) + wid * 64; LAS float* li_l = al_l + 32;
    const LAS float* tbl = (const LAS float*)(lds + OFF_RPB);
    const int cq = (wid & 1) * 32 + r32;
    float mhat = 0.f, l_reg = 0.f; f32x16 negm = f32x16{}; bf16x8 qr[4];
#pragma unroll
    for (int d = 0; d < DV / 32; ++d) o[d] = f32x16{};
    { const bf16* Qw = Qp + (size_t)(wid * 32 + r32) * PW + hi * 8;
#pragma unroll
      for (int d0 = 0; d0 < 4; ++d0) qr[d0] = *(const bf16x8*)(Qw + d0 * 16); }
    const int kr = tid >> 3, kc8 = (tid & 7) * 8, kst = ATT_KSWZ(kr, kc8 * 2);
    const int sr = (DV == 128) ? (tid >> 4) : (tid >> 3), sc = (DV == 128) ? (tid & 15) * 8 : (tid & 7) * 8;
    const int vst0 = v_st(sr, sc), vst1 = v_st(32 + sr, sc);
    const int vb0 = (int)(unsigned)(uintptr_t)V_lds + v_rd_base(lane);
    struct { bf16x8 vs0, vs1, ks; } sr_[2];
#define ATT_TROW(t) ((t) < nA ? baseA + 64 * (t) : baseB + 64 * ((t) - nA))
#define ATT_SLOAD(i, t) do { const int rb_ = ATT_TROW(t); sr_[i].vs0 = *(const bf16x8*)(Vp + (size_t)(rb_ + sr) * PW + sc); \
    if constexpr (DV == 128) sr_[i].vs1 = *(const bf16x8*)(Vp + (size_t)(rb_ + 32 + sr) * PW + sc); \
    sr_[i].ks = *(const bf16x8*)(Kp + (size_t)(rb_ + kr) * PW + kc8); } while (0)
#define ATT_SWRITE(b, i) do { *(LAS bf16x8*)(V_lds + (b) * SHM_V + vst0) = sr_[i].vs0; \
    if constexpr (DV == 128) *(LAS bf16x8*)(V_lds + (b) * SHM_V + vst1) = sr_[i].vs1; \
    *(LAS bf16x8*)(K_lds + (b) * SHM_K + kst) = sr_[i].ks; } while (0)
#define ATT_SWAIT() do { if constexpr (DV == 128) asm volatile("s_waitcnt vmcnt(3)" ::: "memory"); else asm volatile("s_waitcnt vmcnt(2)" ::: "memory"); } while (0)
#define ATT_RESC(a) do { if (__any((a) < 1.f)) { if (hi == 0) al_l[r32] = (a); asm volatile("s_waitcnt lgkmcnt(0)" ::: "memory"); \
    _Pragma("unroll") for (int r = 0; r < 16; ++r) { const float f_ = al_l[crow(r, hi)]; _Pragma("unroll") for (int d = 0; d < DV / 32; ++d) o[d][r] *= f_; } } } while (0)
#define ATT_MASK(P0, P1, t) do { if constexpr (MODE == 1) { if ((t) >= nA) na_mask(P0, P1, kmin + (t) - nA, qrow, cq, hi, tbl); } } while (0)
    f32x16 pA0, pA1, pB0, pB1; float alA, alB; bf16x8 pa0, pa1, pa2, pa3;
    constexpr int SE = 0, SO = 1;
    __syncthreads();
    ATT_SLOAD(SE, 0); asm volatile("s_waitcnt vmcnt(0)" ::: "memory"); ATT_SWRITE(0, SE); __syncthreads();
    qkt(pA0, pA1, K_lds, qr, negm, r32, hi); ATT_MASK(pA0, pA1, 0); partialSM<true>(pA0, pA1, mhat, negm, alA);
    ATT_SLOAD(SO, 1); if (2 < NT) ATT_SLOAD(SE, 2);
    ATT_SWAIT(); ATT_SWRITE(1, SO); __syncthreads();
    for (int j = 1; j + 1 < NT; j += 2) {
        ATT_SBAR(); qkt(pB0, pB1, K_lds + SHM_K, qr, negm, r32, hi); ATT_MASK(pB0, pB1, j);
        finishSM(pA0, pA1, alA, l_reg, pa0, pa1, pa2, pa3); ATT_SBAR();
        ATT_SLOAD(SO, j + 2); ATT_SBAR();
        pv_all<DV>(o, vb0, pa0, pa1, pa2, pa3); partialSM<false>(pB0, pB1, mhat, negm, alB);
        __syncthreads(); ATT_SWAIT(); ATT_SWRITE(0, SE);
        ATT_RESC(alB); __syncthreads();
        ATT_SBAR(); qkt(pA0, pA1, K_lds, qr, negm, r32, hi); ATT_MASK(pA0, pA1, j + 1);
        finishSM(pB0, pB1, alB, l_reg, pa0, pa1, pa2, pa3); ATT_SBAR();
        if (j + 3 < NT) ATT_SLOAD(SE, j + 3); ATT_SBAR();
        pv_all<DV>(o, vb0 + SHM_V, pa0, pa1, pa2, pa3); partialSM<false>(pA0, pA1, mhat, negm, alA);
        __syncthreads(); ATT_SWAIT(); ATT_SWRITE(1, SO);
        ATT_RESC(alA); __syncthreads();
    }
    ATT_SBAR(); qkt(pB0, pB1, K_lds + SHM_K, qr, negm, r32, hi); ATT_MASK(pB0, pB1, NT - 1);
    finishSM(pA0, pA1, alA, l_reg, pa0, pa1, pa2, pa3); ATT_SBAR();
    pv_all<DV>(o, vb0, pa0, pa1, pa2, pa3); partialSM<false>(pB0, pB1, mhat, negm, alB);
    __syncthreads(); ATT_RESC(alB);
    finishSM(pB0, pB1, alB, l_reg, pa0, pa1, pa2, pa3); ATT_SBAR();
    pv_all<DV>(o, vb0 + SHM_V, pa0, pa1, pa2, pa3);
    if (hi == 0) li_l[r32] = l_reg; asm volatile("s_waitcnt lgkmcnt(0)" ::: "memory");
#pragma unroll
    for (int r = 0; r < 16; ++r) { const float rl = __builtin_amdgcn_rcpf(li_l[crow(r, hi)]);
#pragma unroll
        for (int d = 0; d < DV / 32; ++d) o[d][r] *= rl; }
#undef ATT_TROW
#undef ATT_SLOAD
#undef ATT_SWRITE
#undef ATT_SWAIT
#undef ATT_RESC
#undef ATT_MASK
}
}
struct Params { const float* in[34]; float* out; unsigned char* ws; };
#define CAS __attribute__((address_space(4)))
struct KA { const CAS unsigned char* k;
    __device__ __forceinline__ const float* in(int i) const { return *(const float* const CAS*)(k + 8 * i); }
    __device__ __forceinline__ float* out() const { return *(float* const CAS*)(k + 8 * 34); }
    __device__ __forceinline__ unsigned char* ws() const { return *(unsigned char* const CAS*)(k + 8 * 35); } };
enum { I_X = 0, I_C, I_CTX, I_CCTX, I_WMOD, I_BMOD, I_GMIX, I_GFFN, I_WIN, I_WOUT, I_LAMRE, I_LAMIM, I_BRE, I_BIM, I_CRE, I_CIM, I_LOGSTEP, I_SSMD, I_WGLU, I_BGLU,
       I_LQ1, I_LK1, I_LQ2, I_LK2, I_SUBLN, I_RPB, I_FW1, I_FW3, I_FW2, I_ROUTER, I_MW1, I_MW3, I_MW2, I_GFINAL };

__device__ __forceinline__ size_t res_off(int r, bool& is_ctx) { const int b = r / RB, n = r - b * RB; is_ctx = n >= SEQ; return is_ctx ? ((size_t)b * CTXL + (n - SEQ)) * DM : ((size_t)b * SEQ + n) * DM; }

using pg8::GUnit;
#define EPI_ROWS_COLS const int row0 = wr * 64 + fr, col0 = wc * 32 + 8 * fq
__device__ __forceinline__ u32x4 pack8(f32x4 a, f32x4 b) { u32x4 w; w.x = cvt_pk_bf16(a[0], a[1]); w.y = cvt_pk_bf16(a[2], a[3]); w.z = cvt_pk_bf16(b[0], b[1]); w.w = cvt_pk_bf16(b[2], b[3]); return w; }

struct EpiInProj {
    bf16* P; bf16* A2; const float* rope;
    __device__ __forceinline__ void operator()(const f32x4 (&acc)[2][2][4][2], const GUnit& u, int wr, int wc, int fr, int fq) const {
        EPI_ROWS_COLS; const int pl = u.pm % PPB; const bool lat = pl < 16;
        if (u.pn == 0) {
#pragma unroll
            for (int ai = 0; ai < 2; ++ai)
#pragma unroll
                for (int m = 0; m < 4; ++m) { const int r = u.pm * 256 + ai * 128 + row0 + m * 16;
#pragma unroll
                    for (int bj = 0; bj < 2; ++bj) { const int c = bj * 128 + col0, g = c >> 4, h0 = c & 15;
                        *(u32x4*)(A2 + ((size_t)g * NR16 + (r >> 4)) * 512 + 256 + (r & 15) * 16 + h0) = pack8(acc[ai][bj][m][0], acc[ai][bj][m][1]); } }
        } else {
            const bool rope_on = lat && u.pn <= 4; const int pcol0 = u.pn * 256 - 256;
            const float qs = (u.pn <= 2 || u.pn == 7) ? att::QSCALE : 1.f;
#pragma unroll
            for (int ai = 0; ai < 2; ++ai)
#pragma unroll
                for (int m = 0; m < 4; ++m) { const int rl = ai * 128 + row0 + m * 16, r = u.pm * 256 + rl, t = pl * 256 + rl;
#pragma unroll
                    for (int bj = 0; bj < 2; ++bj) { const int c = bj * 128 + col0; f32x4 v0 = acc[ai][bj][m][0] * qs, v1 = acc[ai][bj][m][1] * qs;
                        if (rope_on) { const int i0 = (c & 63) >> 1, axis = i0 >> 4, k0 = i0 & 15, pos = axis ? (t & 63) : (t >> 6);
                            const f32x4 cs0 = *(const f32x4*)(rope + (pos * 16 + k0) * 2), cs1 = *(const f32x4*)(rope + (pos * 16 + k0) * 2 + 4);
                            f32x4 w0, w1;
                            w0[0] = v0[0] * cs0[0] - v0[1] * cs0[1]; w0[1] = v0[0] * cs0[1] + v0[1] * cs0[0];
                            w0[2] = v0[2] * cs0[2] - v0[3] * cs0[3]; w0[3] = v0[2] * cs0[3] + v0[3] * cs0[2];
                            w1[0] = v1[0] * cs1[0] - v1[1] * cs1[1]; w1[1] = v1[0] * cs1[1] + v1[1] * cs1[0];
                            w1[2] = v1[2] * cs1[2] - v1[3] * cs1[3]; w1[3] = v1[2] * cs1[3] + v1[3] * cs1[2];
                            v0 = w0; v1 = w1; }
                        *(u32x4*)(P + (size_t)r * PW + pcol0 + c) = pack8(v0, v1); } }
        }
    }
};
struct EpiZ {
    float* Z;
    __device__ __forceinline__ void operator()(const f32x4 (&acc)[2][2][4][2], const GUnit& u, int wr, int wc, int fr, int fq) const {
        EPI_ROWS_COLS;
#pragma unroll
        for (int ai = 0; ai < 2; ++ai)
#pragma unroll
            for (int m = 0; m < 4; ++m) { float* rp = Z + ((size_t)u.aux * NR16 + u.pm * 256 + ai * 128 + row0 + m * 16) * 256;
#pragma unroll
                for (int bj = 0; bj < 2; ++bj) { *(f32x4*)(rp + bj * 128 + col0) = acc[ai][bj][m][0]; *(f32x4*)(rp + bj * 128 + col0 + 4) = acc[ai][bj][m][1]; } }
    }
};
struct EpiY {
    bf16* G;
    __device__ __forceinline__ void operator()(const f32x4 (&acc)[2][2][4][2], const GUnit& u, int wr, int wc, int fr, int fq) const {
        EPI_ROWS_COLS;
#pragma unroll
        for (int ai = 0; ai < 2; ++ai)
#pragma unroll
            for (int m = 0; m < 4; ++m) { const int r16 = u.pm * 256 + ai * 128 + row0 + m * 16;
#pragma unroll
                for (int bj = 0; bj < 2; ++bj) { const int c = bj * 128 + col0, i = c >> 4, h0 = c & 15; f32x4 v0 = acc[ai][bj][m][0], v1 = acc[ai][bj][m][1];
#pragma unroll
                    for (int k = 0; k < 4; ++k) { v0[k] = gelu_tanh(v0[k]); v1[k] = gelu_tanh(v1[k]); }
                    *(u32x4*)(G + ((size_t)r16 * 16 + i) * 256 + u.aux * 16 + h0) = pack8(v0, v1); } }
    }
};
struct EpiGlu {
    const bf16* G; bf16* Y; const float* bglu;
    __device__ __forceinline__ void operator()(const f32x4 (&acc)[2][2][4][2], const GUnit& u, int wr, int wc, int fr, int fq) const {
        EPI_ROWS_COLS;
#pragma unroll
        for (int bj = 0; bj < 2; ++bj) { const int c = bj * 128 + col0; const f32x4 b0 = *(const f32x4*)(bglu + c), b1 = *(const f32x4*)(bglu + c + 4);
#pragma unroll
            for (int ai = 0; ai < 2; ++ai)
#pragma unroll
                for (int m = 0; m < 4; ++m) { const size_t r = (size_t)u.pm * 256 + ai * 128 + row0 + m * 16;
                    const u32x4 gw = *(const u32x4*)(G + r * 256 + c); f32x4 v0 = acc[ai][bj][m][0] + b0, v1 = acc[ai][bj][m][1] + b1;
                    v0[0] = bf2f(gw.x & 0xffffu) * sigmoidf_(v0[0]); v0[1] = bf2f(gw.x >> 16) * sigmoidf_(v0[1]); v0[2] = bf2f(gw.y & 0xffffu) * sigmoidf_(v0[2]); v0[3] = bf2f(gw.y >> 16) * sigmoidf_(v0[3]);
                    v1[0] = bf2f(gw.z & 0xffffu) * sigmoidf_(v1[0]); v1[1] = bf2f(gw.z >> 16) * sigmoidf_(v1[1]); v1[2] = bf2f(gw.w & 0xffffu) * sigmoidf_(v1[2]); v1[3] = bf2f(gw.w >> 16) * sigmoidf_(v1[3]);
                    *(u32x4*)(Y + r * DM + c) = pack8(v0, v1); } }
    }
};
template <bool F32SRC>
struct EpiRes {
    const float* srcL; const float* srcC; bf16* XR; const float* gate;
    __device__ __forceinline__ void operator()(const f32x4 (&acc)[2][2][4][2], const GUnit& u, int wr, int wc, int fr, int fq) const {
        EPI_ROWS_COLS; const int b = u.pm / PPB, pl = u.pm - b * PPB; const bool isc = pl >= 16;
        const float* src = isc ? srcC + (size_t)b * CTXL * DM : srcL + ((size_t)b * SEQ + pl * 256) * DM; bf16* dst = XR + (size_t)u.pm * 256 * DM; const float* gv = gate + (isc ? 16 : b) * 6144;
        if constexpr (F32SRC) {
#pragma unroll
            for (int bj = 0; bj < 2; ++bj) { const int c = u.pn * 256 + bj * 128 + col0; const f32x4 g0 = *(const f32x4*)(gv + c), g1 = *(const f32x4*)(gv + c + 4);
#pragma unroll
                for (int ai = 0; ai < 2; ++ai)
#pragma unroll
                    for (int m = 0; m < 4; ++m) { const size_t o = (size_t)(ai * 128 + row0 + m * 16) * DM + c; const f32x4 x0 = *(const f32x4*)(src + o), x1 = *(const f32x4*)(src + o + 4);
                        *(u32x4*)(dst + o) = pack8(x0 + g0 * acc[ai][bj][m][0], x1 + g1 * acc[ai][bj][m][1]); } }
        } else {
            u32x4 xw[2][2][4];
#pragma unroll
            for (int bj = 0; bj < 2; ++bj)
#pragma unroll
                for (int ai = 0; ai < 2; ++ai)
#pragma unroll
                    for (int m = 0; m < 4; ++m) xw[bj][ai][m] = *(const u32x4*)(dst + (size_t)(ai * 128 + row0 + m * 16) * DM + u.pn * 256 + bj * 128 + col0);
#pragma unroll
            for (int bj = 0; bj < 2; ++bj) { const int c = u.pn * 256 + bj * 128 + col0; const f32x4 g0 = *(const f32x4*)(gv + c), g1 = *(const f32x4*)(gv + c + 4);
#pragma unroll
                for (int ai = 0; ai < 2; ++ai)
#pragma unroll
                    for (int m = 0; m < 4; ++m) { const size_t o = (size_t)(ai * 128 + row0 + m * 16) * DM + c; const u32x4 w = xw[bj][ai][m];
                        const f32x4 x0 = {bf2f(w.x & 0xffffu), bf2f(w.x >> 16), bf2f(w.y & 0xffffu), bf2f(w.y >> 16)}, x1 = {bf2f(w.z & 0xffffu), bf2f(w.z >> 16), bf2f(w.w & 0xffffu), bf2f(w.w >> 16)};
                        *(u32x4*)(dst + o) = pack8(x0 + g0 * acc[ai][bj][m][0], x1 + g1 * acc[ai][bj][m][1]); } }
        }
    }
};
struct EpiSwi {
    bf16* H;
    __device__ __forceinline__ void operator()(const f32x4 (&acc)[2][2][4][2], const GUnit& u, int wr, int wc, int fr, int fq) const {
        EPI_ROWS_COLS; const int c = u.pn * 128 + col0;
#pragma unroll
        for (int ai = 0; ai < 2; ++ai)
#pragma unroll
            for (int m = 0; m < 4; ++m) { const size_t r = (size_t)u.aux * 256 + ai * 128 + row0 + m * 16; f32x4 v0, v1;
#pragma unroll
                for (int k = 0; k < 4; ++k) { v0[k] = siluf_(acc[ai][0][m][0][k]) * acc[ai][1][m][0][k]; v1[k] = siluf_(acc[ai][0][m][1][k]) * acc[ai][1][m][1][k]; }
                *(u32x4*)(H + r * FF + c) = pack8(v0, v1); }
    }
};
struct EpiMoeDown {
    bf16* XR; const float* gate; const int* rsrc; const float* rgate;
    __device__ __forceinline__ void operator()(const f32x4 (&acc)[2][2][4][2], const GUnit& u, int wr, int wc, int fr, int fq) const {
        EPI_ROWS_COLS;
#pragma unroll
        for (int ai = 0; ai < 2; ++ai)
#pragma unroll
            for (int m = 0; m < 4; ++m) { const int pos = u.aux + ai * 128 + row0 + m * 16; const int tok = rsrc[pos];
                if (tok >= 0) { const float rg = rgate[pos]; const int b = tok / RB; const bool isc = (tok - b * RB) >= SEQ; bf16* dst = XR + (size_t)tok * DM; const float* gv = gate + (isc ? 16 : b) * 6144;
#pragma unroll
                    for (int bj = 0; bj < 2; ++bj) { const int c = u.pn * 256 + bj * 128 + col0;
                        const f32x4 g0 = *(const f32x4*)(gv + c) * rg, g1 = *(const f32x4*)(gv + c + 4) * rg; const u32x4 w = *(const u32x4*)(dst + c);
                        const f32x4 x0 = {bf2f(w.x & 0xffffu), bf2f(w.x >> 16), bf2f(w.y & 0xffffu), bf2f(w.y >> 16)}, x1 = {bf2f(w.z & 0xffffu), bf2f(w.z >> 16), bf2f(w.w & 0xffffu), bf2f(w.w >> 16)};
                        *(u32x4*)(dst + c) = pack8(x0 + g0 * acc[ai][bj][m][0], x1 + g1 * acc[ai][bj][m][1]); } } }
    }
};

struct SchedRows {
    const char* A; const char* B; size_t a_tile, b_tile; int nM, nN, pm0, a_local, wgm, lat_only;
    __device__ __forceinline__ bool next(int i, GUnit& u) const { int pm, pn; if (!pg8::tile_order(i, GRID, bx_opaque(), nM, nN, wgm, pm, pn)) return false;
        u.pm = lat_only ? pm + (pm >> 4) : pm0 + pm; u.pn = pn; u.aux = pm; u.rows = nullptr; u.A = A + (size_t)(a_local ? pm : u.pm) * a_tile; u.B = B + (size_t)pn * b_tile; return true; }
};
struct SchedS5 {
    const char* A; const char* B; size_t b_group;
    __device__ __forceinline__ bool next(int i, GUnit& u) const { const int L = i * GRID + bx_opaque(); if (L >= 17 * 16) return false;
        const int g = L & 15, pm = L >> 4; u.pm = pm; u.pn = 0; u.aux = g; u.rows = nullptr;
        u.A = A + ((size_t)g * NR16 + (size_t)pm * 256) * 512 * 2; u.B = B + (size_t)g * b_group; return true; }
};
struct SchedMoe {
    const char* A; const char* B; const int* rsrc; const LAS int* mbase; int np, nN, p0, slot, down; size_t b_exp, b_tile; int wgm;
    __device__ __forceinline__ bool next(int i, GUnit& u) const { int pm, pn; if (!pg8::tile_order(i, GRID, bx_opaque(), np, nN, wgm, pm, pn)) return false;
        const int gp = p0 + pm; int e = 0;
#pragma unroll
        for (int k = 1; k < 8; ++k) e += (gp * 256 >= mbase[slot * 8 + k]) ? 1 : 0;
        e = __builtin_amdgcn_readfirstlane(e);
        u.pm = gp; u.pn = pn; u.B = B + (size_t)e * b_exp + (size_t)pn * b_tile;
        if (down) { u.aux = gp * 256; u.rows = nullptr; u.A = A + (size_t)pm * 256 * FF * 2; }
        else { u.aux = pm; u.rows = rsrc + (size_t)gp * 256; u.A = A; }
        return true; }
};
__device__ __forceinline__ void transpose_item(const float* __restrict__ W, int N, bf16* __restrict__ WT, int Kd, int dst_row0, int k0, int n0, LAS float* scr, int lane) {
    { const int kq = lane >> 3, n4 = (lane & 7) * 4; f32x4 v[8];
#pragma unroll
      for (int i = 0; i < 8; ++i) v[i] = *(const f32x4*)(W + (size_t)(k0 + kq + 8 * i) * N + n0 + n4);
#pragma unroll
      for (int i = 0; i < 8; ++i) { LAS float* d = scr + (kq + 8 * i) * 33 + n4; d[0] = v[i][0]; d[1] = v[i][1]; d[2] = v[i][2]; d[3] = v[i][3]; } }
    LDS_WAIT(); asm volatile("" ::: "memory");
    const int c = lane & 7;
#pragma unroll
    for (int j = 0; j < 4; ++j) { const int n = (lane >> 3) + 8 * j; const LAS float* s = scr + (8 * c) * 33 + n;
        u32x4 o; o.x = pk2(s[0 * 33], s[1 * 33]); o.y = pk2(s[2 * 33], s[3 * 33]); o.z = pk2(s[4 * 33], s[5 * 33]); o.w = pk2(s[6 * 33], s[7 * 33]);
        *(u32x4*)(WT + (size_t)(dst_row0 + n) * Kd + k0 + 8 * c) = o; }
    LDS_WAIT(); asm volatile("" ::: "memory");
}
__device__ __forceinline__ void prologue_weights(const KA& p, LAS unsigned char* lds, int wid, int lane) {
    LAS float* scr = (LAS float*)(lds + wid * 16384);
    const int gw = bx_opaque() * NWAVES + wid;
    constexpr int PER_LAYER = 1280 + 512 + 32, N_A = NLAYER * PER_LAYER, PER_F = 3 * 1408, N_ALL = N_A + 18 * PER_F;
    unsigned char* ws = p.ws();
    for (int it = gw; it < N_ALL; it += NGW) {
        if (it < N_A) { const int l = it / PER_LAYER; int r = it - l * PER_LAYER;
            if (r < 1280) { transpose_item(p.in(I_WIN) + (size_t)l * DM * INW, INW, (bf16*)(ws + WS_WIN) + (size_t)l * INW * DM, DM, 32 * (r % 80), 64 * (r / 80), 32 * (r % 80), scr, lane); continue; } r -= 1280;
            if (r < 512) { transpose_item(p.in(I_WOUT) + (size_t)l * DM * DM, DM, (bf16*)(ws + WS_WOUT) + (size_t)l * DM * DM, DM, 32 * (r % 32), 64 * (r / 32), 32 * (r % 32), scr, lane); continue; } r -= 512;
            transpose_item(p.in(I_WGLU) + (size_t)l * 65536, 256, (bf16*)(ws + WS_WGLU) + (size_t)l * 65536, 256, 32 * (r % 8), 64 * (r / 8), 32 * (r % 8), scr, lane);
        } else { const int r0 = it - N_A, f = r0 / PER_F, r = r0 - f * PER_F, which = r / 1408, q = r - which * 1408;
            const bool dense = f < 2; const int mi = dense ? f : f - 2;
            const size_t wo = (size_t)mi * DM * FF;
            if (which < 2) { const float* W = (which == 0 ? (dense ? p.in(I_FW1) : p.in(I_MW1)) : (dense ? p.in(I_FW3) : p.in(I_MW3))) + wo;
                bf16* WT = (bf16*)(ws + (dense ? WS_W13D : WS_W13M) + (size_t)mi * SZ_W13);
                const int kb = q / 88, nb = q % 88, n0 = 32 * nb;
                transpose_item(W, FF, WT, DM, (n0 >> 7) * 256 + which * 128 + (n0 & 127), 64 * kb, n0, scr, lane);
            } else { const float* W = (dense ? p.in(I_FW2) : p.in(I_MW2)) + wo; bf16* WT = (bf16*)(ws + (dense ? WS_W2D : WS_W2M) + (size_t)mi * SZ_W2);
                const int kb = q / 32, nb = q % 32; transpose_item(W, DM, WT, FF, 32 * nb, 64 * kb, 32 * nb, scr, lane); }
        }
    }
}
__device__ __forceinline__ void prologue_mod(const KA& p, LAS unsigned char* lds, int tid, int wid, int lane) {
    LAS float* sc = (LAS float*)lds; LAS float* red = (LAS float*)(lds + 17 * 1024 * 4);
    __syncthreads();
    for (int idx = tid; idx < 17 * 1024; idx += NTHREADS) { const int cond = idx >> 10, k = idx & 1023; const float v = cond < 16 ? p.in(I_C)[cond * 1024 + k] : p.in(I_CCTX)[k]; sc[idx] = v / (1.f + expf(-v)); }
    __syncthreads();
    float* MOD = (float*)(p.ws() + WS_MOD);
    for (int u = bx_opaque(); u < NLAYER * 96; u += GRID) { const int l = u / 96, cb = u % 96;
        float acc[17];
#pragma unroll
        for (int c = 0; c < 17; ++c) acc[c] = 0.f;
        const float* wp = p.in(I_WMOD) + ((size_t)l * 1024 + wid * 128) * 6144 + cb * 64 + lane;
        for (int k = 0; k < 128; k += 16) { float w[16];
#pragma unroll
            for (int q = 0; q < 16; ++q) w[q] = wp[(size_t)(k + q) * 6144];
#pragma unroll
            for (int q = 0; q < 16; q += 4)
#pragma unroll
                for (int c = 0; c < 17; ++c) { const f32x4 s = *(const LAS f32x4*)(sc + c * 1024 + wid * 128 + k + q); acc[c] += s[0] * w[q] + s[1] * w[q + 1] + s[2] * w[q + 2] + s[3] * w[q + 3]; } }
#pragma unroll
        for (int c = 0; c < 17; ++c) red[(wid * 17 + c) * 64 + lane] = acc[c];
        __syncthreads();
        for (int o = tid; o < 17 * 64; o += NTHREADS) { const int c = o >> 6, j = o & 63; float s = p.in(I_BMOD)[l * 6144 + cb * 64 + j];
#pragma unroll
            for (int w = 0; w < 8; ++w) s += red[(w * 17 + c) * 64 + j];
            MOD[((size_t)l * 17 + c) * 6144 + cb * 64 + j] = s; }
        __syncthreads();
    }
}
__device__ __forceinline__ void prologue_small_tables(const KA& p, int tid) {
    float* rope = (float*)(p.ws() + WS_ROPE); float* lamt = (float*)(p.ws() + WS_LAM);
    for (int i = tid; i < 1024; i += NTHREADS) { const int pos = i >> 4, k = i & 15; const float inv = exp2f(-(float)k * (13.287712379549449f / 16.f)); const float a = (float)pos * inv; rope[2 * i] = cosf(a); rope[2 * i + 1] = sinf(a); }
    if (tid < NLAYER) { const int l = tid; float d1 = 0.f, d2 = 0.f;
        for (int k = 0; k < 64; ++k) { d1 += p.in(I_LQ1)[l * 64 + k] * p.in(I_LK1)[l * 64 + k]; d2 += p.in(I_LQ2)[l * 64 + k] * p.in(I_LK2)[l * 64 + k]; }
        const float li = 0.8f - 0.6f * expf(-0.3f * (float)l); lamt[2 * l] = expf(d1) - expf(d2) + li; lamt[2 * l + 1] = li; }
}
__device__ __forceinline__ f32x2 cpow_turns(float lre_dt, double rev, int k) {
    const float mag = expf((float)k * lre_dt); double tk = rev * (double)k; tk -= __builtin_floor(tk + 0.5); const float ang = (float)(tk * 6.283185307179586);
    return (f32x2){mag * cosf(ang), mag * sinf(ang)};
}
__device__ __forceinline__ void prologue_s5(const KA& p, LAS unsigned char* lds, int tid, int l, int g) {
    LAS f32x2* apow = (LAS f32x2*)lds;
    LAS f32x2* bb = (LAS f32x2*)(lds + 17408);
    LAS f32x2* cc = (LAS f32x2*)(lds + 33792);
    LAS float* KT = (LAS float*)(lds + 50176);
    __syncthreads();
    if (tid < 128) { const int dir = tid >> 6, pp = tid & 63, gi = (l * 2 + dir) * 16 + g, idx = gi * 64 + pp;
        const float lre = p.in(I_LAMRE)[idx], lim = p.in(I_LAMIM)[idx], dt = expf(p.in(I_LOGSTEP)[gi]);
        const double rev = (double)lim * (double)dt * 0.15915494309189535; const float lre_dt = lre * dt;
        for (int k = 0; k <= 16; ++k) apow[(dir * 17 + k) * 64 + pp] = cpow_turns(lre_dt, rev, k);
        const f32x2 a1 = cpow_turns(lre_dt, rev, 1), a16 = cpow_turns(lre_dt, rev, 16), a544 = cpow_turns(lre_dt, rev, 544);
        ((f32x4*)(p.ws() + WS_A16))[idx] = (f32x4){a16.x, a16.y, a544.x, a544.y};
        const float nre = a1.x - 1.f, nim = a1.y, den = lre * lre + lim * lim, fre = (nre * lre + nim * lim) / den, fim = (nim * lre - nre * lim) / den;
        for (int h = 0; h < 16; ++h) { const float br = p.in(I_BRE)[(size_t)idx * 16 + h], bi = p.in(I_BIM)[(size_t)idx * 16 + h]; bb[(dir * 64 + pp) * 16 + h] = (f32x2){fre * br - fim * bi, fre * bi + fim * br}; } }
    for (int e = tid; e < 2048; e += NTHREADS) { const int dir = e >> 10, h = (e >> 6) & 15, pp = e & 63; const size_t ci = ((size_t)((l * 2 + dir) * 16 + g) * 16 + h) * 64 + pp;
        cc[e] = (f32x2){p.in(I_CRE)[ci], p.in(I_CIM)[ci]}; }
    __syncthreads();
    bf16* W1 = (bf16*)(p.ws() + WS_S5W1) + (size_t)(l * 16 + g) * 65536; bf16* W2 = (bf16*)(p.ws() + WS_S5W2) + (size_t)(l * 16 + g) * 131072;
    for (int it = 0; it < 128; ++it) { const int e = it * NTHREADS + tid, n = e >> 8, k = e & 255;
        { const int dir = n >> 7, part = (n >> 6) & 1, pp = n & 63, j = k >> 4, hh = k & 15, pw = dir == 0 ? 15 - j : j;
          const f32x2 a = apow[(dir * 17 + pw) * 64 + pp], b = bb[(dir * 64 + pp) * 16 + hh];
          W1[e] = (bf16)f2bf(part ? (a.x * b.y + a.y * b.x) : (a.x * b.x - a.y * b.y)); }
        { const int i = n >> 4, h = n & 15, dir = k >> 7, part = (k >> 6) & 1, pp = k & 63, pw = dir == 0 ? i + 1 : 16 - i;
          const f32x2 a = apow[(dir * 17 + pw) * 64 + pp], c = cc[(dir * 16 + h) * 64 + pp];
          W2[(size_t)n * 512 + k] = (bf16)f2bf(part ? -(c.x * a.y + c.y * a.x) : (c.x * a.x - c.y * a.y)); } }
    { const int dir = tid >> 8, h = (tid >> 4) & 15, hh = tid & 15;
      for (int lag = 0; lag < 16; ++lag) { float s = 0.f;
          for (int pp = 0; pp < 64; ++pp) { const f32x2 c = cc[(dir * 16 + h) * 64 + pp], a = apow[(dir * 17 + lag) * 64 + pp], b = bb[(dir * 64 + pp) * 16 + hh];
              const float cax = c.x * a.x - c.y * a.y, cay = c.x * a.y + c.y * a.x; s += cax * b.x - cay * b.y; }
          KT[(dir * 16 + lag) * 256 + h * 16 + hh] = s; } }
    __syncthreads();
    for (int it = 0; it < 128; ++it) { const int e = it * NTHREADS + tid, n = e >> 8, kk = e & 255, i = n >> 4, h = n & 15, j = kk >> 4, hh = kk & 15;
        float v = 0.f; if (j <= i) v += KT[(i - j) * 256 + h * 16 + hh]; if (j >= i) v += KT[(16 + j - i) * 256 + h * 16 + hh];
        if (i == j && h == hh) v += p.in(I_SSMD)[l * 256 + g * 16 + h];
        W2[(size_t)n * 512 + 256 + kk] = (bf16)f2bf(v); }
    __syncthreads();
}

template <bool ROUTER, bool F32SRC>
__device__ __forceinline__ void norm_phase(const KA& p, LAS unsigned char* lds, int tid, int wid, int lane, const float* srcL, const float* srcC, const float* gvec, const float* shiftv, const float* scalev,
                                           const float* router, bool skip_ctx) {
    bf16* HX = (bf16*)((unsigned char*)p.out() + OUT_HX); const bf16* XR = (const bf16*)(p.ws() + WS_XR);
    const int gw = bx_opaque() * NWAVES + wid;
    LAS int* wcnt = (LAS int*)lds + wid * 16;
    f32x4 wr0[ROUTER ? 16 : 1], wr1[ROUTER ? 16 : 1];
    if constexpr (ROUTER) {
        __syncthreads(); if (lane < 16) wcnt[lane] = 0;
        int* rsrc = (int*)(p.ws() + WS_RSRC); for (int i = bx_opaque() * NTHREADS + tid; i < MOE_ROWS; i += GRID * NTHREADS) rsrc[i] = -1;
#pragma unroll
        for (int j = 0; j < 4; ++j)
#pragma unroll
            for (int k = 0; k < 4; ++k) { const int c = 4 * lane + 256 * j + k; wr0[j * 4 + k] = *(const f32x4*)(router + (size_t)c * 8); wr1[j * 4 + k] = *(const f32x4*)(router + (size_t)c * 8 + 4); }
    }
    f32x4 Av[4], Bv[4]; int cur_cond = -1;
    constexpr int NB_ROWS = F32SRC ? 4 : (ROUTER ? 3 : 9);
    for (int rr0 = 0; rr0 < RPW; rr0 += NB_ROWS) {
        f32x4 rawf[F32SRC ? NB_ROWS : 1][4]; u32x2 rawh[F32SRC ? 1 : NB_ROWS][4];
#pragma unroll
        for (int d = 0; d < NB_ROWS; ++d) if (rr0 + d < RPW) { const int r = gw * RPW + rr0 + d;
            if constexpr (F32SRC) { bool isc; const size_t ro = res_off(r, isc); const float* xr = (isc ? srcC : srcL) + ro;
#pragma unroll
                for (int j = 0; j < 4; ++j) rawf[d][j] = *(const f32x4*)(xr + 4 * lane + 256 * j); }
            else {
#pragma unroll
                for (int j = 0; j < 4; ++j) rawh[d][j] = *(const u32x2*)(XR + (size_t)r * DM + 4 * lane + 256 * j); } }
#pragma unroll
        for (int d = 0; d < NB_ROWS; ++d) if (rr0 + d < RPW) { const int r = gw * RPW + rr0 + d; const int bq = r / RB; const bool isc = (r - bq * RB) >= SEQ; const int cond = isc ? 16 : bq;
        if (cond != cur_cond) { cur_cond = cond;
#pragma unroll
            for (int j = 0; j < 4; ++j) { const int c = 4 * lane + 256 * j; const f32x4 g = *(const f32x4*)(gvec + c), s = *(const f32x4*)(scalev + (size_t)cond * 6144 + c); Av[j] = g * (s + 1.f); Bv[j] = *(const f32x4*)(shiftv + (size_t)cond * 6144 + c); } }
        f32x4 v[4]; float ss = 0.f;
#pragma unroll
        for (int j = 0; j < 4; ++j) {
            if constexpr (F32SRC) v[j] = rawf[d][j];
            else { const u32x2 w = rawh[d][j]; v[j] = (f32x4){bf2f(w.x & 0xffffu), bf2f(w.x >> 16), bf2f(w.y & 0xffffu), bf2f(w.y >> 16)}; }
            ss += (v[j][0] * v[j][0] + v[j][1] * v[j][1]) + (v[j][2] * v[j][2] + v[j][3] * v[j][3]); }
        const float rinv = 1.f / sqrtf(wave_sum(ss) * (1.f / DM) + 1e-6f);
#pragma unroll
        for (int j = 0; j < 4; ++j) { v[j] = v[j] * rinv * Av[j] + Bv[j]; *(u32x2*)(HX + (size_t)r * DM + 4 * lane + 256 * j) = (u32x2){pk2(v[j][0], v[j][1]), pk2(v[j][2], v[j][3])}; }
        if constexpr (ROUTER) {
            int* toke = (int*)(p.ws() + WS_TOKE); f32x2* tokg = (f32x2*)(p.ws() + WS_TOKG);
            if (isc && skip_ctx) { if (lane == 0) toke[r] = 0xFFFF; }
            else { f32x4 l0 = {0.f, 0.f, 0.f, 0.f}, l1 = {0.f, 0.f, 0.f, 0.f};
#pragma unroll
                for (int j = 0; j < 4; ++j)
#pragma unroll
                    for (int k = 0; k < 4; ++k) { l0 += wr0[j * 4 + k] * v[j][k]; l1 += wr1[j * 4 + k] * v[j][k]; }
                float lg[8];
#pragma unroll
                for (int e = 0; e < 4; ++e) { lg[e] = wave_sum(l0[e]); lg[4 + e] = wave_sum(l1[e]); }
                int e0 = 0; float v0 = lg[0];
#pragma unroll
                for (int e = 1; e < 8; ++e) if (lg[e] > v0) { v0 = lg[e]; e0 = e; }
                int e1 = -1; float v1 = -3.0e38f;
#pragma unroll
                for (int e = 0; e < 8; ++e) if (e != e0 && lg[e] > v1) { v1 = lg[e]; e1 = e; }
                const float g0 = 1.f / (1.f + expf(v1 - v0));
                if (lane == 0) { toke[r] = e0 | (e1 << 8); tokg[r] = (f32x2){g0, 1.f - g0}; wcnt[e0] += 1; wcnt[8 + e1] += 1; } }
        }
        }
    }
    if constexpr (ROUTER) { LDS_WAIT(); if (lane < 16) ((int*)(p.ws() + WS_WCNT))[gw * 16 + lane] = wcnt[lane]; }
}
__device__ __forceinline__ void route2_phase(const KA& p, LAS unsigned char* lds, LAS int* mbase_lds, int tid, int wid, int lane) {
    LAS int* segsum = (LAS int*)lds;
    LAS int* wpre = segsum + 512;
    LAS int* tot = wpre + 128;
    LAS int* wstart = tot + 16;
    const int* wcnt = (const int*)(p.ws() + WS_WCNT);
    __syncthreads();
    { const int seg = tid >> 4, bin = tid & 15, myseg = bx_opaque() >> 3, wg0 = (bx_opaque() & 7) * 8; int s = 0;
      for (int k = 0; k < 64; ++k) { const int c = wcnt[(seg * 64 + k) * 16 + bin]; if (seg == myseg && k >= wg0 && k < wg0 + 8) wpre[(k - wg0) * 16 + bin] = s; s += c; }
      segsum[seg * 16 + bin] = s; }
    __syncthreads();
    if (tid < 16) { int s = 0; for (int k = 0; k < 32; ++k) s += segsum[k * 16 + tid]; tot[tid] = s; }
    __syncthreads();
    if (tid == 0) { int b = 0; for (int k = 0; k < 16; ++k) { mbase_lds[k] = b; b += (tot[k] + 255) & ~255; } mbase_lds[16] = b; }
    __syncthreads();
    if (bx_opaque() == 0 && tid < 17) ((int*)(p.ws() + WS_MBASE))[tid] = mbase_lds[tid];
    if (tid < 128) { const int w = tid >> 4, bin = tid & 15, myseg = bx_opaque() >> 3; int s = mbase_lds[bin] + wpre[w * 16 + bin]; for (int k = 0; k < myseg; ++k) s += segsum[k * 16 + bin]; wstart[w * 16 + bin] = s; }
    __syncthreads();
    { const int gw = bx_opaque() * NWAVES + wid; const int* toke = (const int*)(p.ws() + WS_TOKE); const f32x2* tokg = (const f32x2*)(p.ws() + WS_TOKG);
      int* rsrc = (int*)(p.ws() + WS_RSRC); float* rgate = (float*)(p.ws() + WS_RGATE);
      const bool act = lane < RPW; const int r = gw * RPW + (act ? lane : 0); const int te = act ? toke[r] : 0xFFFF; const f32x2 g = act ? tokg[r] : (f32x2){0.f, 0.f};
      const bool valid = te != 0xFFFF; const int e0 = te & 255, e1 = (te >> 8) & 255; int p0 = 0, p1 = 0;
      const unsigned long long ltm = (1ull << lane) - 1ull;
#pragma unroll
      for (int bin = 0; bin < 8; ++bin) { const unsigned long long m0 = __ballot(valid && e0 == bin), m1 = __ballot(valid && e1 == bin);
          if (e0 == bin) p0 = wstart[wid * 16 + bin] + __popcll(m0 & ltm);
          if (e1 == bin) p1 = wstart[wid * 16 + 8 + bin] + __popcll(m1 & ltm); }
      if (valid) { rsrc[p0] = r; rgate[p0] = g.x; rsrc[p1] = r; rgate[p1] = g.y; } }
    __syncthreads();
}
__device__ __forceinline__ void carry_phase(const KA& p, LAS unsigned char* lds, int tid, int wid, int lane, int l) {
    LAS f32x2* segend = (LAS f32x2*)lds;
    const float* Z = (const float*)(p.ws() + WS_ZLOC); bf16* A2 = (bf16*)((unsigned char*)p.out() + OUT_A2);
    for (int u = bx_opaque(); u < NB * 16 * 2; u += GRID) { const int dir = u & 1, g = (u >> 1) & 15, b = u >> 5;
        const f32x4 at = ((const f32x4*)(p.ws() + WS_A16))[((l * 2 + dir) * 16 + g) * 64 + lane];
        const float ar = at[0], ai = at[1];
        const size_t zrow0 = (size_t)g * NR16 + (size_t)b * 272;
        float lr[34], li[34];
#pragma unroll
        for (int k = 0; k < 34; ++k) { const int q = wid * 34 + k, cp = dir == 0 ? (q < 16 ? 256 + q : q - 16) : 271 - q; const float* zp = Z + (zrow0 + cp) * 256 + dir * 128 + lane; lr[k] = zp[0]; li[k] = zp[64]; }
        float zr = 0.f, zi = 0.f;
#pragma unroll
        for (int k = 0; k < 34; ++k) { const float nr = ar * zr - ai * zi + lr[k], ni = ar * zi + ai * zr + li[k]; zr = nr; zi = ni; }
        __syncthreads();
        segend[wid * 64 + lane] = (f32x2){zr, zi};
        __syncthreads();
        float cr = 0.f, ci = 0.f;
        for (int w = 0; w < wid; ++w) { const f32x2 s = segend[w * 64 + lane]; const float nr = at[2] * cr - at[3] * ci + s.x, ni = at[2] * ci + at[3] * cr + s.y; cr = nr; ci = ni; }
        zr = cr; zi = ci;
#pragma unroll
        for (int k = 0; k < 34; ++k) { const int q = wid * 34 + k, cp = dir == 0 ? (q < 16 ? 256 + q : q - 16) : 271 - q;
            bf16* ap = A2 + (zrow0 + cp) * 512 + dir * 128 + lane; ap[0] = (bf16)f2bf(zr); ap[64] = (bf16)f2bf(zi);
            const float nr = ar * zr - ai * zi + lr[k], ni = ar * zi + ai * zr + li[k]; zr = nr; zi = ni; }
    }
    __syncthreads();
}
__device__ __forceinline__ void final_phase(const KA& p, int wid, int lane) {
    const int gw = bx_opaque() * NWAVES + wid; f32x4 g[4]; const bf16* XR = (const bf16*)(p.ws() + WS_XR);
#pragma unroll
    for (int j = 0; j < 4; ++j) g[j] = *(const f32x4*)(p.in(I_GFINAL) + 4 * lane + 256 * j);
    for (int rl0 = gw * 32; rl0 < gw * 32 + 32; rl0 += 8) { u32x2 raw[8][4];
#pragma unroll
        for (int d = 0; d < 8; ++d) { const int rl = rl0 + d, b = rl >> 12, n = rl & 4095; const bf16* xr = XR + ((size_t)b * RB + n) * DM;
#pragma unroll
            for (int j = 0; j < 4; ++j) raw[d][j] = *(const u32x2*)(xr + 4 * lane + 256 * j); }
#pragma unroll
        for (int d = 0; d < 8; ++d) { float* orow = p.out() + (size_t)(rl0 + d) * DM; f32x4 v[4]; float ss = 0.f;
#pragma unroll
            for (int j = 0; j < 4; ++j) { const u32x2 w = raw[d][j]; v[j] = (f32x4){bf2f(w.x & 0xffffu), bf2f(w.x >> 16), bf2f(w.y & 0xffffu), bf2f(w.y >> 16)};
                ss += (v[j][0] * v[j][0] + v[j][1] * v[j][1]) + (v[j][2] * v[j][2] + v[j][3] * v[j][3]); }
            const float rinv = 1.f / sqrtf(wave_sum(ss) * (1.f / DM) + 1e-6f);
#pragma unroll
            for (int j = 0; j < 4; ++j) *(f32x4*)(orow + 4 * lane + 256 * j) = v[j] * rinv * g[j]; } }
}

constexpr int DIFF_STASH_OFF = 57344;
__device__ __forceinline__ void diff_unit(const bf16* P, bf16* Y, int rows0, int h, int kbase, int NT, const float* lamp, const float* gsub, LAS unsigned char* lds) {
    const int tid = tid_opaque(), lane = tid & 63, wid = __builtin_amdgcn_readfirstlane(tid >> 6), r32 = lane & 31, hi = lane >> 5;
    LAS bf16* st = (LAS bf16*)(lds + DIFF_STASH_OFF) + wid * 4096 + r32;
    {
        f32x16 o[4];
        att::attn_body<128, 0>(P + (size_t)rows0 * PW + PC_DQ + h * 128, P + PC_DK + h * 128, P + PC_DV + h * 128, kbase, NT, 0, NT, lds, o, 0, 0);
#pragma unroll
        for (int r = 0; r < 16; ++r)
#pragma unroll
            for (int d = 0; d < 4; ++d) st[att::crow(r, hi) * 128 + d * 32] = (bf16)f2bf(o[d][r]);
    }
    asm volatile("s_waitcnt lgkmcnt(0)" ::: "memory"); __builtin_amdgcn_sched_barrier(0);
    {
        f32x16 o[4];
        att::attn_body<128, 0>(P + (size_t)rows0 * PW + PC_DQ + h * 128 + 64, P + PC_DK + h * 128 + 64, P + PC_DV + h * 128, kbase, NT, 0, NT, lds, o, 0, 0);
        const float lam = lamp[0], lam_init = lamp[1];
        float ss[16];
#pragma unroll
        for (int r = 0; r < 16; ++r) { ss[r] = 0.f;
#pragma unroll
            for (int d = 0; d < 4; ++d) { const float o1 = bf2f((unsigned)st[att::crow(r, hi) * 128 + d * 32]); const float v = o1 - lam * o[d][r]; o[d][r] = v; ss[r] += v * v; } }
#pragma unroll
        for (int r = 0; r < 16; ++r) {
            ss[r] = half_sum(ss[r]);
            ss[r] = (1.f / sqrtf(ss[r] * (1.f / 128.f) + 1e-5f)) * (1.f - lam_init); }
        float gs[4];
#pragma unroll
        for (int d = 0; d < 4; ++d) gs[d] = gsub[d * 32 + r32];
#pragma unroll
        for (int r = 0; r < 16; ++r)
#pragma unroll
            for (int d = 0; d < 4; ++d) st[att::crow(r, hi) * 128 + d * 32] = (bf16)f2bf(o[d][r] * ss[r] * gs[d]);
        asm volatile("s_waitcnt lgkmcnt(0)" ::: "memory");
        { const LAS bf16* sw = (const LAS bf16*)(lds + DIFF_STASH_OFF) + wid * 4096; bf16* yo = Y + (size_t)(rows0 + wid * 32) * DM + 256 + h * 128;
#pragma unroll
          for (int i = 0; i < 8; ++i) { const int row = i * 4 + (lane >> 4), ch = lane & 15; *(u32x4*)(yo + (size_t)row * DM + ch * 8) = *(const LAS u32x4*)(sw + row * 128 + ch * 8); } }
        asm volatile("s_waitcnt lgkmcnt(0)" ::: "memory");
    }
}
__device__ __forceinline__ void na_unit(const bf16* P, bf16* Y, const float* rpb_h, int b, int h, int qb, LAS unsigned char* lds) {
    const int tid = tid_opaque(), lane = tid & 63, wid = __builtin_amdgcn_readfirstlane(tid >> 6), r32 = lane & 31, hi = lane >> 5; const int rows0 = b * RB + qb * 256, r0 = qb * 4;
    const int kmin = min(min(max(r0 - 4, 0), 56), 52);
    __syncthreads();
    { LAS float* tbl = (LAS float*)(lds + att::OFF_RPB); if (tid < 465) tbl[tid] = rpb_h[tid] * 1.4426950408889634f; }
    f32x16 o[2];
    att::attn_body<64, 1>(P + (size_t)rows0 * PW + PC_NQ + h * 64, P + PC_NK + h * 64, P + PC_NV + h * 64, b * RB + SEQ, 4, b * RB + kmin * 64, 16, lds, o, r0 + (wid >> 1), kmin);
    { LAS bf16* sw = (LAS bf16*)(lds + DIFF_STASH_OFF) + wid * 4096;
#pragma unroll
      for (int r = 0; r < 16; ++r)
#pragma unroll
          for (int d = 0; d < 2; ++d) sw[att::crow(r, hi) * 64 + d * 32 + r32] = (bf16)f2bf(o[d][r]);
      asm volatile("s_waitcnt lgkmcnt(0)" ::: "memory");
      bf16* yo = Y + (size_t)(rows0 + wid * 32) * DM + 768 + h * 64;
#pragma unroll
      for (int i = 0; i < 4; ++i) { const int row = i * 8 + (lane >> 3), ch = lane & 7; *(u32x4*)(yo + (size_t)row * DM + ch * 8) = *(const LAS u32x4*)(sw + row * 64 + ch * 8); }
      asm volatile("s_waitcnt lgkmcnt(0)" ::: "memory"); }
}
__device__ __forceinline__ void na_ctx_unit(const bf16* P, bf16* Y, int b, int h, LAS unsigned char* lds) {
    const int tid = tid_opaque(), lane = tid & 63, wid = __builtin_amdgcn_readfirstlane(tid >> 6), r32 = lane & 31, hi = lane >> 5; const int rows0 = b * RB + SEQ;
    f32x16 o[2];
    att::attn_body<64, 0>(P + (size_t)rows0 * PW + PC_NQ + h * 64, P + PC_NK + h * 64, P + PC_NV + h * 64, rows0, 4, 0, 4, lds, o, 0, 0);
    { LAS bf16* sw = (LAS bf16*)(lds + DIFF_STASH_OFF) + wid * 4096;
#pragma unroll
      for (int r = 0; r < 16; ++r)
#pragma unroll
          for (int d = 0; d < 2; ++d) sw[att::crow(r, hi) * 64 + d * 32 + r32] = (bf16)f2bf(o[d][r]);
      asm volatile("s_waitcnt lgkmcnt(0)" ::: "memory");
      bf16* yo = Y + (size_t)(rows0 + wid * 32) * DM + 768 + h * 64;
#pragma unroll
      for (int i = 0; i < 4; ++i) { const int row = i * 8 + (lane >> 3), ch = lane & 7; *(u32x4*)(yo + (size_t)row * DM + ch * 8) = *(const LAS u32x4*)(sw + row * 64 + ch * 8); }
      asm volatile("s_waitcnt lgkmcnt(0)" ::: "memory"); }
}
#ifndef WGM_IN
#define WGM_IN 4
#endif
#ifndef WGM_OUT
#define WGM_OUT 4
#endif
#ifndef WGM_UP
#define WGM_UP 4
#endif
#ifndef WGM_DOWN
#define WGM_DOWN 4
#endif
__global__ void __launch_bounds__(NTHREADS, 2) dit_fwd(Params p_unused) {
    (void)p_unused;
    extern __shared__ __attribute__((aligned(16))) unsigned char lds_raw[];
    LAS unsigned char* lds = (LAS unsigned char*)lds_raw;
    volatile LAS unsigned* MISC = (volatile LAS unsigned*)(lds + MISC_OFF);
    LAS int* mbase = (LAS int*)(lds + MISC_OFF + 128);
#define PH_ARGS KA p; p.k = (const CAS unsigned char*)__builtin_amdgcn_kernarg_segment_ptr(); asm volatile("" : "+s"(p.k)); unsigned char* const ws = p.ws(); (void)ws
#define PH_IDS PH_ARGS; const int tid = tid_opaque(), lane = tid & 63, wid = __builtin_amdgcn_readfirstlane(tid >> 6); (void)lane; (void)wid
#define BX (bx_opaque())
#define VCU ((BX & 7) * (GRID / 8) + (BX >> 3))
    for (int u = (int)threadIdx.x; u < (LDS_BYTES - LDSCTL_OFF) / 4; u += NTHREADS) ((LAS unsigned*)(lds + LDSCTL_OFF))[u] = 0u;
    __syncthreads();
    { PH_ARGS; (void)xcd_barrier_post((unsigned*)(ws + WS_CTL) + CW_BAR, MISC + 8); }
#define GRID_BAR_T(FIRST) do { PH_ARGS; XcdBarrier b_; b_.bar = (unsigned*)(ws + WS_CTL) + CW_BAR; b_.x = xb_xcc_id(); b_.st = (volatile LAS unsigned*)(lds + MISC_OFF) + 8; xcd_barrier<FIRST>(b_); } while (0)
#define GRID_BAR() GRID_BAR_T(false)

#define MOD ((float*)(ws + WS_MOD))
#define OUTB ((unsigned char*)p.out())
#define XR ((bf16*)(ws + WS_XR))
#define HX ((bf16*)(OUTB + OUT_HX))
#define P ((bf16*)(ws + WS_P))
#define H ((bf16*)(ws + WS_H))
#define A2 ((bf16*)(OUTB + OUT_A2))
#define ZL ((float*)(ws + WS_ZLOC))
#define GB ((bf16*)(OUTB + OUT_GBUF))
#define MODL (MOD + (size_t)l * 17 * 6144)

    { PH_IDS; prologue_weights(p, lds, wid, lane);
      prologue_mod(p, lds, tid, wid, lane);
      if (BX >= 128 && BX < 192) prologue_s5(p, lds, tid, (BX - 128) >> 4, (BX - 128) & 15);
      if (BX == 255) prologue_small_tables(p, tid); }
    GRID_BAR_T(true);

    for (int l = 0; l < NLAYER; ++l) {
        const int last = (l == NLAYER - 1) ? 1 : 0;
        { PH_IDS; if (l == 0) norm_phase<false, true>(p, lds, tid, wid, lane, p.in(I_X), p.in(I_CTX), p.in(I_GMIX), MODL, MODL + 1024, nullptr, false);
          else norm_phase<false, false>(p, lds, tid, wid, lane, nullptr, nullptr, p.in(I_GMIX) + l * DM, MODL, MODL + 1024, nullptr, false); }
        GRID_BAR();
        { PH_ARGS; SchedRows S{(const char*)HX, (const char*)(ws + WS_WIN) + (size_t)l * INW * DM * 2, (size_t)256 * DM * 2, (size_t)256 * DM * 2, NPANEL, INW / 256, 0, 0, WGM_IN, 0};
          EpiInProj E{P, A2, (const float*)(ws + WS_ROPE)};
          pg8::gemm_phase<EpiInProj, SchedRows, false>(lds, DM, DM, DM, S, E); }
        GRID_BAR();
        { PH_ARGS; SchedS5 S{(const char*)A2 + 512, (const char*)(ws + WS_S5W1) + (size_t)l * 16 * 65536 * 2, (size_t)65536 * 2}; EpiZ E{ZL};
          pg8::gemm_phase<EpiZ, SchedS5, false>(lds, 256, 512, 256, S, E); }
        GRID_BAR();
        { PH_IDS; carry_phase(p, lds, tid, wid, lane, l); }
        GRID_BAR();
        { PH_ARGS; SchedS5 S{(const char*)A2, (const char*)(ws + WS_S5W2) + (size_t)l * 16 * 131072 * 2, (size_t)131072 * 2}; EpiY E{GB};
          pg8::gemm_phase<EpiY, SchedS5, false>(lds, 512, 512, 512, S, E); }
        { PH_ARGS; const float* lamp = (const float*)(ws + WS_LAM) + 2 * l; const float* gsub = p.in(I_SUBLN) + l * 128; const int vcu = VCU;
          for (int it = 0; it < 4; ++it) { const int bh = (vcu >> 4) + 16 * it, b = bh >> 2, h = bh & 3, qb = vcu & 15;
              diff_unit(P, HX, b * RB + qb * 256, h, b * RB, RB / 64, lamp, gsub, lds); }
          if (vcu < 64 && !last) { const int b = vcu >> 2, h = vcu & 3; diff_unit(P, HX, b * RB + SEQ, h, b * RB + SEQ, CTXL / 64, lamp, gsub, lds); }
          for (int it = 0; it < 4; ++it) { const int bh = (vcu >> 4) + 16 * it, b = bh >> 2, h = bh & 3, qb = vcu & 15;
              na_unit(P, HX, p.in(I_RPB) + (size_t)(l * 4 + h) * 465, b, h, qb, lds); }
          if (vcu >= 64 && vcu < 128 && !last) { const int b = (vcu - 64) >> 2, h = vcu & 3; na_ctx_unit(P, HX, b, h, lds); }
          __syncthreads(); }
        GRID_BAR();
        { PH_ARGS; SchedRows S{(const char*)GB, (const char*)(ws + WS_WGLU) + (size_t)l * 65536 * 2, (size_t)256 * 256 * 2, (size_t)256 * 256 * 2, last ? NB * 16 : NPANEL, 1, 0, 0, 4, last};
          EpiGlu E{GB, HX, p.in(I_BGLU) + l * 256};
          pg8::gemm_phase<EpiGlu, SchedRows, false>(lds, 256, 256, 256, S, E); }
        GRID_BAR();
        { PH_ARGS; SchedRows S{(const char*)HX, (const char*)(ws + WS_WOUT) + (size_t)l * DM * DM * 2, (size_t)256 * DM * 2, (size_t)256 * DM * 2, last ? NB * 16 : NPANEL, 4, 0, 0, WGM_OUT, last};
          if (l == 0) { EpiRes<true> E{p.in(I_X), p.in(I_CTX), XR, MODL + 2 * 1024}; pg8::gemm_phase<EpiRes<true>, SchedRows, false>(lds, DM, DM, DM, S, E); }
          else { EpiRes<false> E{nullptr, nullptr, XR, MODL + 2 * 1024}; pg8::gemm_phase<EpiRes<false>, SchedRows, false>(lds, DM, DM, DM, S, E); } }
        GRID_BAR();
        { PH_IDS; if (l & 1) norm_phase<true, false>(p, lds, tid, wid, lane, nullptr, nullptr, p.in(I_GFFN) + l * DM, MODL + 3 * 1024, MODL + 4 * 1024, p.in(I_ROUTER) + (size_t)(l >> 1) * DM * 8, l == NLAYER - 1);
          else norm_phase<false, false>(p, lds, tid, wid, lane, nullptr, nullptr, p.in(I_GFFN) + l * DM, MODL + 3 * 1024, MODL + 4 * 1024, nullptr, false); }
        GRID_BAR();
        if (!(l & 1)) {
            const int fi = l >> 1;
            for (int c = 0; c < 2; ++c) { const int pm0 = c * HCHUNK_PANELS, np = (NPANEL - pm0) < HCHUNK_PANELS ? (NPANEL - pm0) : HCHUNK_PANELS;
                { PH_ARGS; SchedRows S{(const char*)HX, (const char*)(ws + WS_W13D) + (size_t)fi * SZ_W13, (size_t)256 * DM * 2, (size_t)256 * DM * 2, np, 22, pm0, 0, WGM_UP, 0}; EpiSwi E{H};
                  pg8::gemm_phase<EpiSwi, SchedRows, false>(lds, DM, DM, DM, S, E); }
                GRID_BAR();
                { PH_ARGS; SchedRows S{(const char*)H, (const char*)(ws + WS_W2D) + (size_t)fi * SZ_W2, (size_t)256 * FF * 2, (size_t)256 * FF * 2, np, 4, pm0, 1, WGM_DOWN, 0};
                  EpiRes<false> E{nullptr, nullptr, XR, MODL + 5 * 1024};
                  pg8::gemm_phase<EpiRes<false>, SchedRows, false>(lds, FF, FF, FF, S, E); }
                GRID_BAR(); }
        } else {
            const int mi = l >> 1;
            { PH_IDS; route2_phase(p, lds, mbase, tid, wid, lane); }
            GRID_BAR();
            for (int s = 0; s < 2; ++s) { const int P0 = __builtin_amdgcn_readfirstlane(mbase[8 * s] >> 8), P1 = __builtin_amdgcn_readfirstlane(mbase[8 * s + 8] >> 8);
                for (int c = 0; c < 2; ++c) { const int p0 = P0 + c * HCHUNK_PANELS; if (p0 >= P1) break; const int np = (P1 - p0) < HCHUNK_PANELS ? (P1 - p0) : HCHUNK_PANELS;
                    { PH_ARGS; SchedMoe S{(const char*)HX, (const char*)(ws + WS_W13M) + (size_t)mi * 8 * SZ_W13, (const int*)(ws + WS_RSRC), mbase, np, 22, p0, s, 0, SZ_W13, (size_t)256 * DM * 2, WGM_UP}; EpiSwi E{H};
                      pg8::gemm_phase<EpiSwi, SchedMoe, true>(lds, DM, DM, DM, S, E); }
                    GRID_BAR();
                    { PH_ARGS; SchedMoe S{(const char*)H, (const char*)(ws + WS_W2M) + (size_t)mi * 8 * SZ_W2, (const int*)(ws + WS_RSRC), mbase, np, 4, p0, s, 1, SZ_W2, (size_t)256 * FF * 2, WGM_DOWN};
                      EpiMoeDown E{XR, MODL + 5 * 1024, (const int*)(ws + WS_RSRC), (const float*)(ws + WS_RGATE)};
                      pg8::gemm_phase<EpiMoeDown, SchedMoe, false>(lds, FF, FF, FF, S, E); }
                    GRID_BAR(); } }
        }
    }
    { PH_IDS; final_phase(p, wid, lane); }
#undef GRID_BAR
#undef GRID_BAR_T
#undef BX
#undef VCU
#undef MOD
#undef XR
#undef OUTB
#undef HX
#undef P
#undef H
#undef A2
#undef ZL
#undef GB
#undef MODL
}

extern "C" void kernel_launch(void* const* d_in, const int* in_sizes, int n_in, void* d_out, int out_size, void* d_ws, size_t ws_size, hipStream_t stream) {
    static int ready = 0;
    if (ready == 0) {
        if (n_in != 34 || in_sizes[0] != NB * SEQ * DM || out_size != NB * SEQ * DM || ws_size < WS_END) {
            fprintf(stderr, "kernel_launch: shape/workspace mismatch (n_in %d, x %d, out %d, ws %zu, need %zu); nothing launched\n", n_in, n_in > 0 ? in_sizes[0] : -1, out_size, ws_size, (size_t)WS_END); ready = -1; return; }
        if (hipFuncSetAttribute((const void*)dit_fwd, hipFuncAttributeMaxDynamicSharedMemorySize, LDS_BYTES) != hipSuccess) { fprintf(stderr, "kernel_launch: hipFuncSetAttribute failed\n"); ready = -1; return; }
        int per_cu = 0;
        if (hipOccupancyMaxActiveBlocksPerMultiprocessor(&per_cu, (const void*)dit_fwd, NTHREADS, LDS_BYTES) != hipSuccess || per_cu < 1) fprintf(stderr, "kernel_launch: note: occupancy query reports %d workgroups per CU\n", per_cu);
        (void)hipGetLastError();
        ready = 1;
    }
    if (ready < 0) return;
    if (hipMemsetAsync((char*)d_ws + WS_CTL, 0, CTL_BYTES, stream) != hipSuccess) { fprintf(stderr, "kernel_launch: memset failed\n"); return; }
    Params prm{};
    for (int i = 0; i < 34; ++i) prm.in[i] = (const float*)d_in[i];
    prm.out = (float*)d_out; prm.ws = (unsigned char*)d_ws;
    hipLaunchKernelGGL(dit_fwd, dim3(GRID), dim3(NTHREADS), LDS_BYTES, stream, prm);
    const hipError_t le = hipPeekAtLastError();
    if (le != hipSuccess) fprintf(stderr, "kernel_launch: launch failed: %s\n", hipGetErrorName(le));
}
```

```cpp
#include <hip/hip_runtime.h>
#include <cstdio>
#include <cstdint>

#define GAS __attribute__((address_space(1)))
#define LAS __attribute__((address_space(3)))
typedef unsigned short bf16;
typedef short bf16x8 __attribute__((ext_vector_type(8)));
typedef short s16x4 __attribute__((ext_vector_type(4)));
typedef float f32x2 __attribute__((ext_vector_type(2)));
typedef float f32x4 __attribute__((ext_vector_type(4)));
typedef float f32x8 __attribute__((ext_vector_type(8)));
typedef float f32x16 __attribute__((ext_vector_type(16)));
typedef unsigned u32x2 __attribute__((ext_vector_type(2)));
typedef unsigned u32x4 __attribute__((ext_vector_type(4)));

constexpr int DM = 1024, NB = 16, SEQ = 4096, CTXL = 256, RB = SEQ + CTXL, NR = NB * RB, NLAYER = 4;
constexpr int INW = 2560, PW = 2304, FF = 2816, NEXP = 8;
constexpr int PC_DQ = 0, PC_DK = 512, PC_DV = 1024, PC_NQ = 1536, PC_NK = 1792, PC_NV = 2048;
constexpr int NPANEL = NR / 256, PPB = RB / 256;
constexpr int NR16 = NR / 16;
constexpr int GRID = 256, NWAVES = 8, NTHREADS = 512, NGW = GRID * NWAVES, RPW = NR / NGW;
static_assert(RPW * NGW == NR, "rows per wave");
constexpr int MOE_ROWS = 2 * NR + 4096;
constexpr int HCHUNK_PANELS = 256;

constexpr size_t al4k(size_t x) { return (x + 4095) & ~(size_t)4095; }
constexpr size_t WS_CTL = 0, CTL_BYTES = 1u << 20;
constexpr size_t WS_MOD = WS_CTL + CTL_BYTES;                          constexpr size_t SZ_MOD = (size_t)NLAYER * 17 * 6144 * 4;
constexpr size_t WS_ROPE = al4k(WS_MOD + SZ_MOD);                      constexpr size_t SZ_ROPE = 64 * 16 * 8;
constexpr size_t WS_LAM = al4k(WS_ROPE + SZ_ROPE);                     constexpr size_t SZ_LAM = 4096;
constexpr size_t WS_A16 = al4k(WS_LAM + SZ_LAM);                       constexpr size_t SZ_A16 = (size_t)NLAYER * 2 * 16 * 64 * 16;
constexpr size_t WS_S5W1 = al4k(WS_A16 + SZ_A16);                      constexpr size_t SZ_S5W1 = (size_t)NLAYER * 16 * 256 * 256 * 2;
constexpr size_t WS_S5W2 = al4k(WS_S5W1 + SZ_S5W1);                    constexpr size_t SZ_S5W2 = (size_t)NLAYER * 16 * 256 * 512 * 2;
constexpr size_t WS_WIN = al4k(WS_S5W2 + SZ_S5W2);                     constexpr size_t SZ_WIN = (size_t)NLAYER * INW * DM * 2;
constexpr size_t WS_WOUT = al4k(WS_WIN + SZ_WIN);                      constexpr size_t SZ_WOUT = (size_t)NLAYER * DM * DM * 2;
constexpr size_t WS_WGLU = al4k(WS_WOUT + SZ_WOUT);                    constexpr size_t SZ_WGLU = (size_t)NLAYER * 256 * 256 * 2;
constexpr size_t WS_W13D = al4k(WS_WGLU + SZ_WGLU);                    constexpr size_t SZ_W13 = (size_t)2 * FF * DM * 2;
constexpr size_t WS_W2D = al4k(WS_W13D + 2 * SZ_W13);                  constexpr size_t SZ_W2 = (size_t)DM * FF * 2;
constexpr size_t WS_W13M = al4k(WS_W2D + 2 * SZ_W2);
constexpr size_t WS_W2M = al4k(WS_W13M + 16 * SZ_W13);
constexpr size_t SZ_HX = (size_t)NR * DM * 2;
constexpr size_t WS_XR = al4k(WS_W2M + 16 * SZ_W2);
constexpr size_t WS_P = al4k(WS_XR + SZ_HX);                           constexpr size_t SZ_P = (size_t)NR * PW * 2;
constexpr size_t WS_H = WS_P;                                          constexpr size_t SZ_H = (size_t)HCHUNK_PANELS * 256 * FF * 2;
constexpr size_t SZ_A2 = (size_t)16 * NR16 * 512 * 2, SZ_GBUF = (size_t)NR * 256 * 2;
constexpr size_t WS_ZLOC = al4k(WS_P + SZ_P);                          constexpr size_t SZ_ZLOC = (size_t)16 * NR16 * 256 * 4;
constexpr size_t WS_TOKE = al4k(WS_ZLOC + SZ_ZLOC);                    constexpr size_t SZ_TOKE = (size_t)NR * 4;
constexpr size_t WS_TOKG = al4k(WS_TOKE + SZ_TOKE);                    constexpr size_t SZ_TOKG = (size_t)NR * 8;
constexpr size_t WS_WCNT = al4k(WS_TOKG + SZ_TOKG);                    constexpr size_t SZ_WCNT = (size_t)NGW * 16 * 4;
constexpr size_t WS_MBASE = al4k(WS_WCNT + SZ_WCNT);                   constexpr size_t SZ_MBASE = 4096;
constexpr size_t WS_RSRC = al4k(WS_MBASE + SZ_MBASE);                  constexpr size_t SZ_RSRC = (size_t)MOE_ROWS * 4;
constexpr size_t WS_RGATE = al4k(WS_RSRC + SZ_RSRC);                   constexpr size_t SZ_RGATE = (size_t)MOE_ROWS * 4;
constexpr size_t WS_END = al4k(WS_RGATE + SZ_RGATE);
constexpr size_t OUT_HX = 0, OUT_A2 = OUT_HX + SZ_HX, OUT_GBUF = OUT_A2 + SZ_A2;
static_assert(OUT_GBUF + SZ_GBUF <= (size_t)NB * SEQ * DM * 4 && OUT_A2 % 4096 == 0 && OUT_GBUF % 4096 == 0, "scratch tensors inside d_out");
static_assert(WS_ZLOC == WS_P + SZ_P && SZ_H <= SZ_P + SZ_ZLOC, "hidden chunk overlays P and Zloc (both dead during the FFN)");
static_assert(WS_END <= ((size_t)1 << 30), "workspace map must fit 1 GiB");
constexpr int CW_BAR = 4096;

constexpr int RING_BYTES = 131072;
constexpr int LDSCTL_OFF = RING_BYTES;
constexpr int MISC_OFF = LDSCTL_OFF + 320;
constexpr int LDS_BYTES = 147456;

__device__ __forceinline__ unsigned f2bf(float f) { unsigned u = __builtin_bit_cast(unsigned, f); return (u + 0x7fffu + ((u >> 16) & 1u)) >> 16; }
__device__ __forceinline__ unsigned pk2(float lo, float hi) { return f2bf(lo) | (f2bf(hi) << 16); }
__device__ __forceinline__ float bf2f(unsigned h) { return __builtin_bit_cast(float, h << 16); }
__device__ __forceinline__ unsigned cvt_pk_bf16(float lo, float hi) { unsigned r; asm volatile("v_cvt_pk_bf16_f32 %0, %1, %2" : "=v"(r) : "v"(lo), "v"(hi)); return r; }
template <int X> __device__ __forceinline__ float swz_xor(float v) { return __builtin_bit_cast(float, __builtin_amdgcn_ds_swizzle(__builtin_bit_cast(int, v), (X << 10) | 0x1f)); }
__device__ __forceinline__ float half_sum(float v) {
    v += swz_xor<1>(v); v += swz_xor<2>(v); v += swz_xor<4>(v); v += swz_xor<8>(v); v += swz_xor<16>(v); return v; }
__device__ __forceinline__ float wave_sum(float v) {
    v = half_sum(v);
    auto rr = __builtin_amdgcn_permlane32_swap(__float_as_uint(v), __float_as_uint(v), false, false);
    return __uint_as_float(rr[0]) + __uint_as_float(rr[1]);
}
__device__ __forceinline__ int bx_opaque() { int b = (int)blockIdx.x; asm volatile("" : "+s"(b)); return b; }
extern __shared__ __attribute__((aligned(16))) unsigned char lds_raw[];
constexpr int WTAB_OFF = MISC_OFF + 256;
__device__ __forceinline__ int hw_wave_slot() { return (int)(__builtin_amdgcn_s_getreg((5 << 11) | 4) & 0x3fu); }
__device__ __forceinline__ int tid_opaque() {
    const int w = __builtin_amdgcn_readfirstlane(((volatile LAS int*)((LAS unsigned char*)lds_raw + WTAB_OFF))[hw_wave_slot()]);
    unsigned z = 0u; asm volatile("" : "+s"(z));
    int t = w * 64 + (int)__builtin_amdgcn_mbcnt_hi(~0u, __builtin_amdgcn_mbcnt_lo(~0u, z)); asm volatile("" : "+v"(t)); return t; }
#define LDS_WAIT() asm volatile("s_waitcnt lgkmcnt(0)" ::: "memory")
#define VM_WAIT() asm volatile("s_waitcnt vmcnt(0)" ::: "memory")
__device__ __forceinline__ float fast_exp(float x) { return __builtin_amdgcn_exp2f(x * 1.4426950408889634f); }
__device__ __forceinline__ float sigmoidf_(float x) { return __builtin_amdgcn_rcpf(1.f + fast_exp(-x)); }
__device__ __forceinline__ float siluf_(float x) { return x * sigmoidf_(x); }
__device__ __forceinline__ float gelu_tanh(float x) {
    const float u = 0.7978845608028654f * (x + 0.044715f * x * x * x);
    return x * sigmoidf_(2.f * u);
}

#define XB_TMO      128
#define XB_XCNT(j)  (256  + 64 * (j))
#define XB_XSUB(j)  (1280 + 64 * (j))
#define XB_XGEN(j)  (2304 + 64 * (j))
#define XB_TOP      3328
#define XB_TOPGEN   3392
#define XCD_BAR_WORDS 3456
#define XB_SPIN_CAP (1u << 18)

__device__ __forceinline__ unsigned xb_ld(unsigned* p)              { return __hip_atomic_load(p, __ATOMIC_RELAXED, __HIP_MEMORY_SCOPE_AGENT); }
__device__ __forceinline__ unsigned xb_add(unsigned* p, unsigned v) { return __hip_atomic_fetch_add(p, v, __ATOMIC_RELAXED, __HIP_MEMORY_SCOPE_AGENT); }
__device__ __forceinline__ unsigned xb_xcc_id() { return (unsigned)__builtin_amdgcn_s_getreg((3 << 11) | 20) & 0xFu; }
#define XB_SPIN(cond, bar) do { unsigned _sp = 0; while (cond) { __builtin_amdgcn_s_sleep(1); \
    if ((++_sp & 255u) == 0u) { if (xb_ld(&(bar)[XB_TMO])) break; if (_sp > XB_SPIN_CAP) { atomicAdd(&(bar)[XB_TMO], 1u); break; } } } } while (0)

struct XcdBarrier {
    unsigned* bar; unsigned x;
    volatile LAS unsigned* st;
};
__device__ __forceinline__ XcdBarrier xcd_barrier_post(unsigned* bar, volatile LAS unsigned* st) {
    XcdBarrier b; b.bar = bar; b.x = xb_xcc_id(); b.st = st;
    if (threadIdx.x == 0) (void)xb_add(&bar[XB_XCNT(b.x)], 1u);
    return b;
}
__device__ __forceinline__ void xcd_barrier_complete(unsigned* bar, unsigned x, unsigned& nloc, unsigned& nx) {
    const unsigned G = gridDim.x * gridDim.y * gridDim.z;
    unsigned sum, cnt, mine, sp = 0u;
    for (;;) {
        sum = 0u; cnt = 0u; mine = 0u;
#pragma unroll
        for (unsigned j = 0; j < 16; ++j) { const unsigned c = xb_ld(&bar[XB_XCNT(j)]); sum += c; cnt += (c > 0u) ? 1u : 0u; mine = (j == x) ? c : mine; }
        if (sum == G) break;
        __builtin_amdgcn_s_sleep(1);
        if ((++sp & 255u) == 0u) { if (xb_ld(&bar[XB_TMO])) break; if (sp > XB_SPIN_CAP) { atomicAdd(&bar[XB_TMO], 1u); break; } }
    }
    nloc = mine > 0u ? mine : 1u; nx = cnt > 0u ? cnt : 1u;
}
template <bool FIRST>
__device__ __forceinline__ void xcd_barrier(const XcdBarrier& b) {
    asm volatile("s_waitcnt vmcnt(0)" ::: "memory");
    __syncthreads();
    if (threadIdx.x == 0) {
        unsigned* bar = b.bar;
        __builtin_amdgcn_s_waitcnt(0);
        unsigned nloc = b.st[0], nx = b.st[1];
        if constexpr (FIRST) { if (nloc == 0u) { xcd_barrier_complete(bar, b.x, nloc, nx); b.st[0] = nloc; b.st[1] = nx; } }
        else { nloc = nloc ? nloc : 1u; nx = nx ? nx : 1u; }
        const unsigned old = xb_add(&bar[XB_XSUB(b.x)], 1u);
        const unsigned gen = old / nloc;
        if (old + 1u == (gen + 1u) * nloc) {
            __builtin_amdgcn_fence(__ATOMIC_RELEASE, "agent");
            asm volatile("s_waitcnt vmcnt(0)" ::: "memory");
            const unsigned og = xb_add(&bar[XB_TOP], 1u);
            const unsigned tg = og / nx;
            if (og + 1u == (tg + 1u) * nx) xb_add(&bar[XB_TOPGEN], 1u);
            else XB_SPIN(xb_ld(&bar[XB_TOPGEN]) == tg, bar);
            __builtin_amdgcn_fence(__ATOMIC_ACQUIRE, "agent");
            xb_add(&bar[XB_XGEN(b.x)], 1u);
            asm volatile("s_waitcnt vmcnt(0)" ::: "memory");
        } else {
            XB_SPIN(xb_ld(&bar[XB_XGEN(b.x)]) == gen, bar);
            __builtin_amdgcn_fence(__ATOMIC_ACQUIRE, "agent");
            asm volatile("s_waitcnt vmcnt(0)" ::: "memory");
        }
    }
    __syncthreads();
}

namespace pg8 {
__device__ __forceinline__ void glds16_s(const void* sbase, unsigned voff, unsigned lds_dst) {
    unsigned keep;
    asm volatile("s_mov_b32 %0, m0\n\ts_mov_b32 m0, %3\n\ts_nop 0\n\tglobal_load_lds_dwordx4 %1, %2\n\ts_mov_b32 m0, %0" : "=&s"(keep) : "v"(voff), "s"(sbase), "s"(lds_dst) : "memory");
}
constexpr int BM = 256, BK = 64, HALF = 128, HTB = HALF * BK * 2, STAGE_BYTES = 8 * HTB, NXCD = 8;
__host__ __device__ __forceinline__ int lds_byte(int r, int c) { const int st = (r >> 4) * 2 + (c >> 5), rr = r & 15, cc = c & 31, ob = rr * 64 + cc * 2; return st * 1024 + (ob ^ (((ob >> 9) & 1) << 5)); }
__host__ __device__ __forceinline__ void stage_rc(int b, int& R, int& C) { const int st = b / 1024, sb = b % 1024, swz = sb ^ (((sb >> 9) & 1) << 5); R = (st >> 1) * 16 + swz / 64; C = (st & 1) * 32 + (swz % 64) / 2; }
__host__ __device__ __forceinline__ int perm32(int rho) { const int n = rho >> 4, i = rho & 15; return 8 * (i >> 2) + 4 * n + (i & 3); }

struct GUnit { const char* A; const char* B; int pm, pn, aux; const int* rows; };

__device__ __forceinline__ bool tile_order(int i, int G, int c, int nM, int nN, int WGM, int& pm, int& pn) {
    const int nwg = nM * nN; const long L = (long)i * G + c; if (L >= nwg) return false;
    int wgid = (int)L; { const int q = nwg / NXCD, r = nwg % NXCD, xcd = wgid % NXCD, off = wgid / NXCD; wgid = (xcd < r ? xcd * (q + 1) : r * (q + 1) + (xcd - r) * q) + off; }
    const int nig = WGM * nN, gid = wgid / nig, fm = gid * WGM, gsz = (nM - fm) < WGM ? (nM - fm) : WGM;
    pm = fm + ((wgid % nig) % gsz); pn = (wgid % nig) / gsz; return true;
}

template <class Epi, class Sched, bool GATHER>
__device__ __forceinline__ void gemm_phase(LAS unsigned char* lds, const int K, const int lda, const int ldb, const Sched& S, const Epi& E) {
    const int tid = tid_opaque(), wid = __builtin_amdgcn_readfirstlane(tid >> 6), lane = tid & 63, wr = wid >> 2, wc = wid & 3, fr = lane & 15, fq = lane >> 4;
    int nt = K / BK; asm volatile("" : "+s"(nt));
    int sR[2], sC[2]; unsigned voffB[2];
#pragma unroll
    for (int i = 0; i < 2; ++i) { stage_rc(tid * 16 + i * 8192, sR[i], sC[i]); const int Rb = (sR[i] & ~31) + perm32(sR[i] & 31); voffB[i] = (unsigned)(Rb * ldb + sC[i]) * 2u; }
    const size_t kstep = (size_t)(BK * 2);
    const size_t hstepB = (size_t)HALF * ldb * 2;
    const unsigned ldsb = (unsigned)(uintptr_t)lds + (unsigned)wid * 1024u;
    const int aoff = lds_byte(wr * 64 + fr, fq * 8), boff = lds_byte(wc * 32 + fr, fq * 8);
#define PG8_SA(b, h) (((b) * 2 + (h)) * HTB)
#define PG8_SB(b, h) ((4 + (b) * 2 + (h)) * HTB)
#define PG8_STAGE(bufoff, gbase, voff) do { _Pragma("unroll") for (int _i = 0; _i < 2; ++_i) \
        glds16_s((const void*)(gbase), (voff)[_i], ldsb + (unsigned)((bufoff) + _i * 8192)); } while (0)
#define PG8_LDA(dst, b, h) do { _Pragma("unroll") for (int m = 0; m < 4; ++m) _Pragma("unroll") for (int k = 0; k < 2; ++k) dst[m][k] = *(const LAS bf16x8*)(lds + PG8_SA(b, h) + aoff + m * 2048 + k * 1024); } while (0)
#define PG8_LDB(dst, b, h) do { _Pragma("unroll") for (int n = 0; n < 2; ++n) _Pragma("unroll") for (int k = 0; k < 2; ++k) dst[n][k] = *(const LAS bf16x8*)(lds + PG8_SB(b, h) + boff + n * 2048 + k * 1024); } while (0)
#define PG8_MMA(ai, bj, At, Bt) do { __builtin_amdgcn_s_setprio(1); _Pragma("unroll") for (int m = 0; m < 4; ++m) _Pragma("unroll") for (int n = 0; n < 2; ++n) _Pragma("unroll") for (int k = 0; k < 2; ++k) \
        acc[ai][bj][m][n] = __builtin_amdgcn_mfma_f32_16x16x32_bf16(Bt[n][k], At[m][k], acc[ai][bj][m][n], 0, 0, 0); __builtin_amdgcn_s_setprio(0); } while (0)
#define PG8_WAIT_V(n) asm volatile("s_waitcnt vmcnt(" #n ")" ::: "memory")
#define PG8_WAIT_L(n) asm volatile("s_waitcnt lgkmcnt(" #n ")" ::: "memory")
#define PG8_BAR __builtin_amdgcn_s_barrier()
#define PG8_SCHED __builtin_amdgcn_sched_barrier(0)
#define PG8_AOFF(dst, u) do { _Pragma("unroll") for (int _h = 0; _h < 2; ++_h) _Pragma("unroll") for (int _i = 0; _i < 2; ++_i) { \
        if constexpr (GATHER) { int _r = (u).rows[_h * HALF + sR[_i]]; _r = _r < 0 ? 0 : _r; dst[_h][_i] = (unsigned)(_r * lda + sC[_i]) * 2u; } \
        else dst[_h][_i] = (unsigned)((_h * HALF + sR[_i]) * lda + sC[_i]) * 2u; } } while (0)
    GUnit cur, nxt; int ui = 0;
    if (!S.next(0, cur)) return;
    f32x4 acc[2][2][4][2];
#pragma unroll
    for (int a = 0; a < 2; ++a)
#pragma unroll
        for (int b = 0; b < 2; ++b)
#pragma unroll
            for (int m = 0; m < 4; ++m)
#pragma unroll
                for (int n = 0; n < 2; ++n) acc[a][b][m][n] = (f32x4){0.f, 0.f, 0.f, 0.f};
    bf16x8 At[4][2], B0[2][2], B1[2][2];
    unsigned oC[2][2], oN[2][2];
    PG8_AOFF(oC, cur);
    const char* cA = cur.A; const char* cB = cur.B;
    PG8_STAGE(PG8_SB(0, 0), cB, voffB); PG8_STAGE(PG8_SB(0, 1), cB + hstepB, voffB); PG8_STAGE(PG8_SA(0, 0), cA, oC[0]); PG8_STAGE(PG8_SA(0, 1), cA, oC[1]);
    if (wr == 1) PG8_BAR;
    PG8_WAIT_V(2); PG8_BAR;
    PG8_STAGE(PG8_SB(1, 0), cB + kstep, voffB); PG8_STAGE(PG8_SA(1, 0), cA + kstep, oC[0]); PG8_STAGE(PG8_SB(1, 1), cB + hstepB + kstep, voffB);
    PG8_WAIT_V(6); PG8_BAR;
    for (;;) {
        const bool has_next = S.next(ui + 1, nxt);
        const char* nA = has_next ? nxt.A : cA; const char* nB = has_next ? nxt.B : cB;
        if (has_next) { PG8_AOFF(oN, nxt); } else {
#pragma unroll
            for (int h = 0; h < 2; ++h)
#pragma unroll
                for (int i = 0; i < 2; ++i) oN[h][i] = oC[h][i]; }
        for (int t = 0; t < nt; t += 2) {
            const bool last = (t == nt - 2);
            const char* a1 = cA + (size_t)(t + 1) * kstep;
            const char* a2 = last ? nA : cA + (size_t)(t + 2) * kstep; const char* b2 = last ? nB : cB + (size_t)(t + 2) * kstep;
            const char* a3 = a2 + kstep; const char* b3 = b2 + kstep;
            unsigned o2[2][2];
#pragma unroll
            for (int h = 0; h < 2; ++h)
#pragma unroll
                for (int i = 0; i < 2; ++i) o2[h][i] = last ? oN[h][i] : oC[h][i];
            PG8_LDB(B0, 0, 0); PG8_LDB(B1, 0, 1); PG8_SCHED; PG8_LDA(At, 0, 0); PG8_STAGE(PG8_SA(1, 1), a1, oC[1]);
            PG8_WAIT_V(8); PG8_WAIT_L(0); PG8_BAR; PG8_MMA(0, 0, At, B0); PG8_MMA(0, 1, At, B1); PG8_BAR; PG8_SCHED;
            PG8_LDA(At, 0, 1); PG8_STAGE(PG8_SB(0, 0), b2, voffB); PG8_STAGE(PG8_SB(0, 1), b2 + hstepB, voffB); PG8_STAGE(PG8_SA(0, 0), a2, o2[0]);
            PG8_WAIT_V(8); PG8_WAIT_L(0); PG8_BAR; PG8_MMA(1, 0, At, B0); PG8_MMA(1, 1, At, B1); PG8_BAR; PG8_SCHED;
            PG8_LDB(B0, 1, 0); PG8_LDB(B1, 1, 1); PG8_SCHED; PG8_LDA(At, 1, 0); PG8_STAGE(PG8_SA(0, 1), a2, o2[1]);
            PG8_WAIT_V(8); PG8_WAIT_L(0); PG8_BAR; PG8_MMA(0, 0, At, B0); PG8_MMA(0, 1, At, B1); PG8_BAR; PG8_SCHED;
            PG8_LDA(At, 1, 1); PG8_STAGE(PG8_SB(1, 0), b3, voffB); PG8_STAGE(PG8_SB(1, 1), b3 + hstepB, voffB); PG8_STAGE(PG8_SA(1, 0), a3, o2[0]);
            PG8_WAIT_V(8); PG8_WAIT_L(0); PG8_BAR; PG8_MMA(1, 0, At, B0); PG8_MMA(1, 1, At, B1); PG8_BAR; PG8_SCHED;
        }
        if (wr == 0) PG8_BAR;
        E(acc, cur, wr, wc, fr, fq);
        if (!has_next) break;
#pragma unroll
        for (int a = 0; a < 2; ++a)
#pragma unroll
            for (int b = 0; b < 2; ++b)
#pragma unroll
                for (int m = 0; m < 4; ++m)
#pragma unroll
                    for (int n = 0; n < 2; ++n) acc[a][b][m][n] = (f32x4){0.f, 0.f, 0.f, 0.f};
        cur = nxt; cA = nA; cB = nB; ++ui;
#pragma unroll
        for (int h = 0; h < 2; ++h)
#pragma unroll
            for (int i = 0; i < 2; ++i) oC[h][i] = oN[h][i];
        if (wr == 1) PG8_BAR;
    }
    PG8_WAIT_V(0);
    PG8_BAR;
#undef PG8_SA
#undef PG8_SB
#undef PG8_STAGE
#undef PG8_LDA
#undef PG8_LDB
#undef PG8_MMA
#undef PG8_WAIT_V
#undef PG8_WAIT_L
#undef PG8_BAR
#undef PG8_SCHED
#undef PG8_AOFF
}
}
namespace att {
constexpr float QSCALE = 0.125f * 1.4426950408889634f;
constexpr float THR2 = 8.f * 1.4426950408889634f;
constexpr int SHM_V = 16384, SHM_K = 8192;
constexpr int OFF_V = 0, OFF_K = 2 * SHM_V, OFF_WS = OFF_K + 2 * SHM_K, OFF_RPB = OFF_WS + NWAVES * 64 * 4, RPB_PITCH = 128, ATT_LDS = OFF_RPB + 15 * RPB_PITCH * 4;
#define ATT_KSWZ(row, colB) ((row) * 128 + ((colB) ^ ((((row) >> 1) & 7) << 4)))
#define ATT_SBAR() __builtin_amdgcn_sched_barrier(0)
__device__ __forceinline__ int crow(int r, int hi) { return (r & 3) + 8 * (r >> 2) + 4 * hi; }

template <bool FIRST>
__device__ __forceinline__ void partialSM(f32x16& p0, f32x16& p1, float& mhat, f32x16& negm, float& alpha) {
#define ATT_MX3(a, b, c) __builtin_fmaxf(__builtin_fmaxf((a), (b)), (c))
    float a = ATT_MX3(p0[0], p0[1], p1[0]), b = ATT_MX3(p0[2], p0[3], p1[1]); a = ATT_MX3(a, p1[2], p1[3]);
#pragma unroll
    for (int r = 4; r < 16; r += 4) { a = ATT_MX3(a, p0[r], p0[r + 1]); b = ATT_MX3(b, p0[r + 2], p0[r + 3]); a = ATT_MX3(a, p1[r], p1[r + 1]); b = ATT_MX3(b, p1[r + 2], p1[r + 3]); }
#undef ATT_MX3
    float pmax = fmaxf(a, b);
    { auto rr = __builtin_amdgcn_permlane32_swap(__float_as_uint(pmax), __float_as_uint(pmax), false, false);
      pmax = fmaxf(__uint_as_float(rr[0]), __uint_as_float(rr[1])); }
    alpha = 1.f;
    if (FIRST || !__builtin_expect(__all(pmax <= THR2), 1)) { const float dl = FIRST ? pmax : fmaxf(pmax, 0.f); mhat += dl;
#pragma unroll
        for (int r = 0; r < 16; ++r) { p0[r] -= dl; p1[r] -= dl; }
#pragma unroll
        for (int r = 0; r < 16; ++r) negm[r] = -mhat;
        alpha = __builtin_amdgcn_exp2f(-dl); }
#pragma unroll
    for (int r = 0; r < 16; ++r) p0[r] = __builtin_amdgcn_exp2f(p0[r]);
}
__device__ __forceinline__ void finishSM(f32x16& p0, f32x16& p1, float alpha, float& l_reg, bf16x8& pa0, bf16x8& pa1, bf16x8& pa2, bf16x8& pa3) {
#pragma unroll
    for (int r = 0; r < 16; ++r) p1[r] = __builtin_amdgcn_exp2f(p1[r]);
    { f32x2 s2 = (f32x2){p0[0], p0[1]} + (f32x2){p1[0], p1[1]};
#pragma unroll
      for (int r = 2; r < 16; r += 2) { s2 += (f32x2){p0[r], p0[r + 1]}; s2 += (f32x2){p1[r], p1[r + 1]}; }
      float ps = s2[0] + s2[1];
      auto rr = __builtin_amdgcn_permlane32_swap(__float_as_uint(ps), __float_as_uint(ps), false, false);
      ps = __uint_as_float(rr[0]) + __uint_as_float(rr[1]);
      l_reg = l_reg * alpha + ps; }
#define ATT_PK4(P, BASE, OUT) do { u32x4 w = {cvt_pk_bf16(P[BASE + 0], P[BASE + 1]), cvt_pk_bf16(P[BASE + 2], P[BASE + 3]), cvt_pk_bf16(P[BASE + 4], P[BASE + 5]), cvt_pk_bf16(P[BASE + 6], P[BASE + 7])}; \
    OUT = __builtin_bit_cast(bf16x8, w); } while (0)
    ATT_PK4(p0, 0, pa0); ATT_PK4(p0, 8, pa1); ATT_PK4(p1, 0, pa2); ATT_PK4(p1, 8, pa3);
#undef ATT_PK4
}
__device__ __forceinline__ void qkt(f32x16& p0, f32x16& p1, const LAS unsigned char* Ks, const bf16x8* qr, const f32x16& negm, int r32, int hi) {
    p0 = negm; p1 = negm;
#pragma unroll
    for (int d0 = 0; d0 < 4; ++d0) { const int cb = (d0 * 16 + hi * 8) * 2;
        const bf16x8 b0 = *(const LAS bf16x8*)(Ks + ATT_KSWZ(r32, cb));
        const bf16x8 b1 = *(const LAS bf16x8*)(Ks + ATT_KSWZ(32 + r32, cb));
        p0 = __builtin_amdgcn_mfma_f32_32x32x16_bf16(b0, qr[d0], p0, 0, 0, 0);
        p1 = __builtin_amdgcn_mfma_f32_32x32x16_bf16(b1, qr[d0], p1, 0, 0, 0); }
}
__device__ __forceinline__ int v_st(int k, int c) { const int kk = k;     return ((kk >> 3) * 4 + (c >> 5)) * 512 + ((kk & 7) * 32 + (c & 31)) * 2; }
__device__ __forceinline__ int v_rd_base(int lane) { return ((lane & 3) << 3) | (((lane >> 2) & 3) << 6) | (((lane >> 4) & 1) << 5) | (((lane >> 5) & 1) << 8); }
constexpr int v_rd_off(int d0, int ks, int half) { return d0 * 512 + ks * 4096 + half * 2048; }
template <int OFF> __device__ __forceinline__ s16x4 tr_read(int vb) {
    s16x4 r; asm volatile("ds_read_b64_tr_b16 %0, %1 offset:%2" : "=&v"(r) : "v"(vb), "i"(OFF) : "memory"); return r;
}
template <int D0> __device__ __forceinline__ void pv_one(f32x16& od, int vb, bf16x8 pa0, bf16x8 pa1, bf16x8 pa2, bf16x8 pa3) {
    const s16x4 l0 = tr_read<v_rd_off(D0, 0, 0)>(vb), h0 = tr_read<v_rd_off(D0, 0, 1)>(vb), l1 = tr_read<v_rd_off(D0, 1, 0)>(vb), h1 = tr_read<v_rd_off(D0, 1, 1)>(vb);
    const s16x4 l2 = tr_read<v_rd_off(D0, 2, 0)>(vb), h2 = tr_read<v_rd_off(D0, 2, 1)>(vb), l3 = tr_read<v_rd_off(D0, 3, 0)>(vb), h3 = tr_read<v_rd_off(D0, 3, 1)>(vb);
    asm volatile("s_waitcnt lgkmcnt(0)" ::: "memory"); ATT_SBAR();
#define ATT_PKV(L, H) (bf16x8){L[0], L[1], L[2], L[3], H[0], H[1], H[2], H[3]}
    od = __builtin_amdgcn_mfma_f32_32x32x16_bf16(pa0, ATT_PKV(l0, h0), od, 0, 0, 0);
    od = __builtin_amdgcn_mfma_f32_32x32x16_bf16(pa1, ATT_PKV(l1, h1), od, 0, 0, 0);
    od = __builtin_amdgcn_mfma_f32_32x32x16_bf16(pa2, ATT_PKV(l2, h2), od, 0, 0, 0);
    od = __builtin_amdgcn_mfma_f32_32x32x16_bf16(pa3, ATT_PKV(l3, h3), od, 0, 0, 0);
#undef ATT_PKV
}
template <int DV> __device__ __forceinline__ void pv_all(f32x16* o, int vb, bf16x8 pa0, bf16x8 pa1, bf16x8 pa2, bf16x8 pa3) {
    pv_one<0>(o[0], vb, pa0, pa1, pa2, pa3); pv_one<1>(o[1], vb, pa0, pa1, pa2, pa3);
    if constexpr (DV == 128) { pv_one<2>(o[2], vb, pa0, pa1, pa2, pa3); pv_one<3>(o[3], vb, pa0, pa1, pa2, pa3); }
}
__device__ __forceinline__ unsigned na_colmask(int cq, int hi) {
    const int cst = min(max(cq - 8, 0), 48); unsigned m = 0u;
#pragma unroll
    for (int r = 0; r < 16; ++r) { const int kc = crow(r, hi); if (!((unsigned)(kc - cst) < 16u)) m |= 1u << r; if (!((unsigned)(kc + 32 - cst) < 16u)) m |= 1u << (16 + r); }
    return m;
}
__device__ __forceinline__ void na_mask(f32x16& p0, f32x16& p1, int krow, int qrow, int cq, int hi, unsigned cmi, const LAS float* tbl) {
    const int start = min(max(qrow - 4, 0), 56);
    if ((krow >= start) && (krow < start + 8)) {
        const LAS float* tb = tbl + (krow - qrow + 7) * RPB_PITCH + (63 - cq + 4 * hi);
#pragma unroll
        for (int r = 0; r < 16; ++r) { const int cr = (r & 3) + 8 * (r >> 2);
            const float pen0 = __uint_as_float((unsigned)__builtin_amdgcn_sbfe(cmi, r, 1) & 0xF149F2CAu), pen1 = __uint_as_float((unsigned)__builtin_amdgcn_sbfe(cmi, 16 + r, 1) & 0xF149F2CAu);
            p0[r] = (p0[r] + tb[cr]) + pen0; p1[r] = (p1[r] + tb[cr + 32]) + pen1; }
    } else {
#pragma unroll
        for (int r = 0; r < 16; ++r) { p0[r] = -1e30f; p1[r] = -1e30f; }
    }
}

template <int DV, int MODE>
__device__ __forceinline__ void attn_body(const bf16* __restrict__ Qp, const bf16* __restrict__ Kp, const bf16* __restrict__ Vp, int baseA, int nA, int baseB, int NT,
                                          LAS unsigned char* lds, f32x16 (&o)[DV / 32], int qrow, int kmin) {
    const int tid = tid_opaque(), wid = __builtin_amdgcn_readfirstlane(tid >> 6), lane = tid & 63, r32 = lane & 31, hi = lane >> 5;
    LAS unsigned char* V_lds = lds + OFF_V; LAS unsigned char* K_lds = lds + OFF_K;
    LAS float* al_l = (LAS float*)(lds + OFF_WS) + wid * 64; LAS float* li_l = al_l + 32;
    const LAS float* tbl = (const LAS float*)(lds + OFF_RPB);
    const int cq = (wid & 1) * 32 + r32; const unsigned cmi = (MODE == 1) ? na_colmask(cq, hi) : 0u;
    float mhat = 0.f, l_reg = 0.f; f32x16 negm = f32x16{}; bf16x8 qr[4];
#pragma unroll
    for (int d = 0; d < DV / 32; ++d) o[d] = f32x16{};
    { const bf16* Qw = Qp + (size_t)(wid * 32 + r32) * PW + hi * 8;
#pragma unroll
      for (int d0 = 0; d0 < 4; ++d0) qr[d0] = *(const bf16x8*)(Qw + d0 * 16); }
    const int kr = tid >> 3, kc8 = (tid & 7) * 8, kst = ATT_KSWZ(kr, kc8 * 2);
    const int sr = (DV == 128) ? (tid >> 4) : (tid >> 3), sc = (DV == 128) ? (tid & 15) * 8 : (tid & 7) * 8;
    const int vst0 = v_st(sr, sc), vst1 = v_st(32 + sr, sc);
    const int vb0 = (int)(unsigned)(uintptr_t)V_lds + v_rd_base(lane);
    struct { bf16x8 vs0, vs1, ks; } sr_[2];
#define ATT_TROW(t) ((t) < nA ? baseA + 64 * (t) : baseB + 64 * ((t) - nA))
#define ATT_SLOAD(i, t) do { const int rb_ = ATT_TROW(t); sr_[i].vs0 = *(const bf16x8*)(Vp + (size_t)(rb_ + sr) * PW + sc); \
    if constexpr (DV == 128) sr_[i].vs1 = *(const bf16x8*)(Vp + (size_t)(rb_ + 32 + sr) * PW + sc); \
    sr_[i].ks = *(const bf16x8*)(Kp + (size_t)(rb_ + kr) * PW + kc8); } while (0)
#define ATT_SWRITE(b, i) do { *(LAS bf16x8*)(V_lds + (b) * SHM_V + vst0) = sr_[i].vs0; \
    if constexpr (DV == 128) *(LAS bf16x8*)(V_lds + (b) * SHM_V + vst1) = sr_[i].vs1; \
    *(LAS bf16x8*)(K_lds + (b) * SHM_K + kst) = sr_[i].ks; } while (0)
#define ATT_SWAIT() do { if constexpr (DV == 128) asm volatile("s_waitcnt vmcnt(3)" ::: "memory"); else asm volatile("s_waitcnt vmcnt(2)" ::: "memory"); } while (0)
#define ATT_RESC(a) do { if (__any((a) < 1.f)) { if (hi == 0) al_l[r32] = (a); asm volatile("s_waitcnt lgkmcnt(0)" ::: "memory"); \
    _Pragma("unroll") for (int r = 0; r < 16; ++r) { const float f_ = al_l[crow(r, hi)]; _Pragma("unroll") for (int d = 0; d < DV / 32; ++d) o[d][r] *= f_; } } } while (0)
#define ATT_MASK(P0, P1, t) do { if constexpr (MODE == 1) { if ((t) >= nA) na_mask(P0, P1, kmin + (t) - nA, qrow, cq, hi, cmi, tbl); } } while (0)
    f32x16 pA0, pA1, pB0, pB1; float alA, alB; bf16x8 pa0, pa1, pa2, pa3;
    constexpr int SE = 0, SO = 1;
    __syncthreads();
    ATT_SLOAD(SE, 0); asm volatile("s_waitcnt vmcnt(0)" ::: "memory"); ATT_SWRITE(0, SE); __syncthreads();
    qkt(pA0, pA1, K_lds, qr, negm, r32, hi); ATT_MASK(pA0, pA1, 0); partialSM<true>(pA0, pA1, mhat, negm, alA);
    ATT_SLOAD(SO, 1); if (2 < NT) ATT_SLOAD(SE, 2);
    ATT_SWAIT(); ATT_SWRITE(1, SO); __syncthreads();
    for (int j = 1; j + 1 < NT; j += 2) {
        ATT_SBAR(); qkt(pB0, pB1, K_lds + SHM_K, qr, negm, r32, hi); ATT_MASK(pB0, pB1, j);
        finishSM(pA0, pA1, alA, l_reg, pa0, pa1, pa2, pa3); ATT_SBAR();
        ATT_SLOAD(SO, j + 2); ATT_SBAR();
        pv_all<DV>(o, vb0, pa0, pa1, pa2, pa3); partialSM<false>(pB0, pB1, mhat, negm, alB);
        __syncthreads(); ATT_SWAIT(); ATT_SWRITE(0, SE);
        ATT_RESC(alB); __syncthreads();
        ATT_SBAR(); qkt(pA0, pA1, K_lds, qr, negm, r32, hi); ATT_MASK(pA0, pA1, j + 1);
        finishSM(pB0, pB1, alB, l_reg, pa0, pa1, pa2, pa3); ATT_SBAR();
        if (j + 3 < NT) ATT_SLOAD(SE, j + 3); ATT_SBAR();
        pv_all<DV>(o, vb0 + SHM_V, pa0, pa1, pa2, pa3); partialSM<false>(pA0, pA1, mhat, negm, alA);
        __syncthreads(); ATT_SWAIT(); ATT_SWRITE(1, SO);
        ATT_RESC(alA); __syncthreads();
    }
    ATT_SBAR(); qkt(pB0, pB1, K_lds + SHM_K, qr, negm, r32, hi); ATT_MASK(pB0, pB1, NT - 1);
    finishSM(pA0, pA1, alA, l_reg, pa0, pa1, pa2, pa3); ATT_SBAR();
    pv_all<DV>(o, vb0, pa0, pa1, pa2, pa3); partialSM<false>(pB0, pB1, mhat, negm, alB);
    __syncthreads(); ATT_RESC(alB);
    finishSM(pB0, pB1, alB, l_reg, pa0, pa1, pa2, pa3); ATT_SBAR();
    pv_all<DV>(o, vb0 + SHM_V, pa0, pa1, pa2, pa3);
    if (hi == 0) li_l[r32] = l_reg; asm volatile("s_waitcnt lgkmcnt(0)" ::: "memory");
#pragma unroll
    for (int r = 0; r < 16; ++r) { const float rl = __builtin_amdgcn_rcpf(li_l[crow(r, hi)]);
#pragma unroll
        for (int d = 0; d < DV / 32; ++d) o[d][r] *= rl; }
#undef ATT_TROW
#undef ATT_SLOAD
#undef ATT_SWRITE
#undef ATT_SWAIT
#undef ATT_RESC
#undef ATT_MASK
}
}
struct Params { const float* in[34]; float* out; unsigned char* ws; };
#define CAS __attribute__((address_space(4)))
struct KA { const CAS unsigned char* k;
    __device__ __forceinline__ const float* in(int i) const { return *(const float* const CAS*)(k + 8 * i); }
    __device__ __forceinline__ float* out() const { return *(float* const CAS*)(k + 8 * 34); }
    __device__ __forceinline__ unsigned char* ws() const { return *(unsigned char* const CAS*)(k + 8 * 35); } };
enum { I_X = 0, I_C, I_CTX, I_CCTX, I_WMOD, I_BMOD, I_GMIX, I_GFFN, I_WIN, I_WOUT, I_LAMRE, I_LAMIM, I_BRE, I_BIM, I_CRE, I_CIM, I_LOGSTEP, I_SSMD, I_WGLU, I_BGLU,
       I_LQ1, I_LK1, I_LQ2, I_LK2, I_SUBLN, I_RPB, I_FW1, I_FW3, I_FW2, I_ROUTER, I_MW1, I_MW3, I_MW2, I_GFINAL };

__device__ __forceinline__ size_t res_off(int r, bool& is_ctx) { const int b = r / RB, n = r - b * RB; is_ctx = n >= SEQ; return is_ctx ? ((size_t)b * CTXL + (n - SEQ)) * DM : ((size_t)b * SEQ + n) * DM; }

using pg8::GUnit;
#define EPI_ROWS_COLS const int row0 = wr * 64 + fr, col0 = wc * 32 + 8 * fq
__device__ __forceinline__ u32x4 pack8(f32x4 a, f32x4 b) { u32x4 w; w.x = cvt_pk_bf16(a[0], a[1]); w.y = cvt_pk_bf16(a[2], a[3]); w.z = cvt_pk_bf16(b[0], b[1]); w.w = cvt_pk_bf16(b[2], b[3]); return w; }

struct EpiInProj {
    bf16* P; bf16* A2; const float* rope;
    __device__ __forceinline__ void operator()(const f32x4 (&acc)[2][2][4][2], const GUnit& u, int wr, int wc, int fr, int fq) const {
        EPI_ROWS_COLS; const int pl = u.pm % PPB; const bool lat = pl < 16;
        if (u.pn == 0) {
#pragma unroll
            for (int ai = 0; ai < 2; ++ai)
#pragma unroll
                for (int m = 0; m < 4; ++m) { const int r = u.pm * 256 + ai * 128 + row0 + m * 16;
#pragma unroll
                    for (int bj = 0; bj < 2; ++bj) { const int c = bj * 128 + col0, g = c >> 4, h0 = c & 15;
                        *(u32x4*)(A2 + ((size_t)g * NR16 + (r >> 4)) * 512 + 256 + (r & 15) * 16 + h0) = pack8(acc[ai][bj][m][0], acc[ai][bj][m][1]); } }
        } else {
            const bool rope_on = lat && u.pn <= 4; const int pcol0 = u.pn * 256 - 256;
            const float qs = (u.pn <= 2 || u.pn == 7) ? att::QSCALE : 1.f;
#pragma unroll
            for (int ai = 0; ai < 2; ++ai)
#pragma unroll
                for (int m = 0; m < 4; ++m) { const int rl = ai * 128 + row0 + m * 16, r = u.pm * 256 + rl, t = pl * 256 + rl;
#pragma unroll
                    for (int bj = 0; bj < 2; ++bj) { const int c = bj * 128 + col0; f32x4 v0 = acc[ai][bj][m][0] * qs, v1 = acc[ai][bj][m][1] * qs;
                        if (rope_on) { const int i0 = (c & 63) >> 1, axis = i0 >> 4, k0 = i0 & 15, pos = axis ? (t & 63) : (t >> 6);
                            const f32x4 cs0 = *(const f32x4*)(rope + (pos * 16 + k0) * 2), cs1 = *(const f32x4*)(rope + (pos * 16 + k0) * 2 + 4);
                            f32x4 w0, w1;
                            w0[0] = v0[0] * cs0[0] - v0[1] * cs0[1]; w0[1] = v0[0] * cs0[1] + v0[1] * cs0[0];
                            w0[2] = v0[2] * cs0[2] - v0[3] * cs0[3]; w0[3] = v0[2] * cs0[3] + v0[3] * cs0[2];
                            w1[0] = v1[0] * cs1[0] - v1[1] * cs1[1]; w1[1] = v1[0] * cs1[1] + v1[1] * cs1[0];
                            w1[2] = v1[2] * cs1[2] - v1[3] * cs1[3]; w1[3] = v1[2] * cs1[3] + v1[3] * cs1[2];
                            v0 = w0; v1 = w1; }
                        *(u32x4*)(P + (size_t)r * PW + pcol0 + c) = pack8(v0, v1); } }
        }
    }
};
struct EpiZ {
    float* Z;
    __device__ __forceinline__ void operator()(const f32x4 (&acc)[2][2][4][2], const GUnit& u, int wr, int wc, int fr, int fq) const {
        EPI_ROWS_COLS;
#pragma unroll
        for (int ai = 0; ai < 2; ++ai)
#pragma unroll
            for (int m = 0; m < 4; ++m) { float* rp = Z + ((size_t)u.aux * NR16 + u.pm * 256 + ai * 128 + row0 + m * 16) * 256;
#pragma unroll
                for (int bj = 0; bj < 2; ++bj) { *(f32x4*)(rp + bj * 128 + col0) = acc[ai][bj][m][0]; *(f32x4*)(rp + bj * 128 + col0 + 4) = acc[ai][bj][m][1]; } }
    }
};
struct EpiY {
    bf16* G;
    __device__ __forceinline__ void operator()(const f32x4 (&acc)[2][2][4][2], const GUnit& u, int wr, int wc, int fr, int fq) const {
        EPI_ROWS_COLS;
#pragma unroll
        for (int ai = 0; ai < 2; ++ai)
#pragma unroll
            for (int m = 0; m < 4; ++m) { const int r16 = u.pm * 256 + ai * 128 + row0 + m * 16;
#pragma unroll
                for (int bj = 0; bj < 2; ++bj) { const int c = bj * 128 + col0, i = c >> 4, h0 = c & 15; f32x4 v0 = acc[ai][bj][m][0], v1 = acc[ai][bj][m][1];
#pragma unroll
                    for (int k = 0; k < 4; ++k) { v0[k] = gelu_tanh(v0[k]); v1[k] = gelu_tanh(v1[k]); }
                    *(u32x4*)(G + ((size_t)r16 * 16 + i) * 256 + u.aux * 16 + h0) = pack8(v0, v1); } }
    }
};
struct EpiGlu {
    const bf16* G; bf16* Y; const float* bglu;
    __device__ __forceinline__ void operator()(const f32x4 (&acc)[2][2][4][2], const GUnit& u, int wr, int wc, int fr, int fq) const {
        EPI_ROWS_COLS;
#pragma unroll
        for (int bj = 0; bj < 2; ++bj) { const int c = bj * 128 + col0; const f32x4 b0 = *(const f32x4*)(bglu + c), b1 = *(const f32x4*)(bglu + c + 4);
#pragma unroll
            for (int ai = 0; ai < 2; ++ai)
#pragma unroll
                for (int m = 0; m < 4; ++m) { const size_t r = (size_t)u.pm * 256 + ai * 128 + row0 + m * 16;
                    const u32x4 gw = *(const u32x4*)(G + r * 256 + c); f32x4 v0 = acc[ai][bj][m][0] + b0, v1 = acc[ai][bj][m][1] + b1;
                    v0[0] = bf2f(gw.x & 0xffffu) * sigmoidf_(v0[0]); v0[1] = bf2f(gw.x >> 16) * sigmoidf_(v0[1]); v0[2] = bf2f(gw.y & 0xffffu) * sigmoidf_(v0[2]); v0[3] = bf2f(gw.y >> 16) * sigmoidf_(v0[3]);
                    v1[0] = bf2f(gw.z & 0xffffu) * sigmoidf_(v1[0]); v1[1] = bf2f(gw.z >> 16) * sigmoidf_(v1[1]); v1[2] = bf2f(gw.w & 0xffffu) * sigmoidf_(v1[2]); v1[3] = bf2f(gw.w >> 16) * sigmoidf_(v1[3]);
                    *(u32x4*)(Y + r * DM + c) = pack8(v0, v1); } }
    }
};
template <bool F32SRC>
struct EpiRes {
    const float* srcL; const float* srcC; bf16* XR; const float* gate;
    __device__ __forceinline__ void operator()(const f32x4 (&acc)[2][2][4][2], const GUnit& u, int wr, int wc, int fr, int fq) const {
        EPI_ROWS_COLS; const int b = u.pm / PPB, pl = u.pm - b * PPB; const bool isc = pl >= 16;
        const float* src = isc ? srcC + (size_t)b * CTXL * DM : srcL + ((size_t)b * SEQ + pl * 256) * DM; bf16* dst = XR + (size_t)u.pm * 256 * DM; const float* gv = gate + (isc ? 16 : b) * 6144;
        if constexpr (F32SRC) {
#pragma unroll
            for (int bj = 0; bj < 2; ++bj) { const int c = u.pn * 256 + bj * 128 + col0; const f32x4 g0 = *(const f32x4*)(gv + c), g1 = *(const f32x4*)(gv + c + 4);
#pragma unroll
                for (int ai = 0; ai < 2; ++ai)
#pragma unroll
                    for (int m = 0; m < 4; ++m) { const size_t o = (size_t)(ai * 128 + row0 + m * 16) * DM + c; const f32x4 x0 = *(const f32x4*)(src + o), x1 = *(const f32x4*)(src + o + 4);
                        *(u32x4*)(dst + o) = pack8(x0 + g0 * acc[ai][bj][m][0], x1 + g1 * acc[ai][bj][m][1]); } }
        } else {
            u32x4 xw[2][2][4];
#pragma unroll
            for (int bj = 0; bj < 2; ++bj)
#pragma unroll
                for (int ai = 0; ai < 2; ++ai)
#pragma unroll
                    for (int m = 0; m < 4; ++m) xw[bj][ai][m] = *(const u32x4*)(dst + (size_t)(ai * 128 + row0 + m * 16) * DM + u.pn * 256 + bj * 128 + col0);
#pragma unroll
            for (int bj = 0; bj < 2; ++bj) { const int c = u.pn * 256 + bj * 128 + col0; const f32x4 g0 = *(const f32x4*)(gv + c), g1 = *(const f32x4*)(gv + c + 4);
#pragma unroll
                for (int ai = 0; ai < 2; ++ai)
#pragma unroll
                    for (int m = 0; m < 4; ++m) { const size_t o = (size_t)(ai * 128 + row0 + m * 16) * DM + c; const u32x4 w = xw[bj][ai][m];
                        const f32x4 x0 = {bf2f(w.x & 0xffffu), bf2f(w.x >> 16), bf2f(w.y & 0xffffu), bf2f(w.y >> 16)}, x1 = {bf2f(w.z & 0xffffu), bf2f(w.z >> 16), bf2f(w.w & 0xffffu), bf2f(w.w >> 16)};
                        *(u32x4*)(dst + o) = pack8(x0 + g0 * acc[ai][bj][m][0], x1 + g1 * acc[ai][bj][m][1]); } }
        }
    }
};
struct EpiSwi {
    bf16* H;
    __device__ __forceinline__ void operator()(const f32x4 (&acc)[2][2][4][2], const GUnit& u, int wr, int wc, int fr, int fq) const {
        EPI_ROWS_COLS; const int c = u.pn * 128 + col0;
#pragma unroll
        for (int ai = 0; ai < 2; ++ai)
#pragma unroll
            for (int m = 0; m < 4; ++m) { const size_t r = (size_t)u.aux * 256 + ai * 128 + row0 + m * 16; f32x4 v0, v1;
#pragma unroll
                for (int k = 0; k < 4; ++k) { v0[k] = siluf_(acc[ai][0][m][0][k]) * acc[ai][1][m][0][k]; v1[k] = siluf_(acc[ai][0][m][1][k]) * acc[ai][1][m][1][k]; }
                *(u32x4*)(H + r * FF + c) = pack8(v0, v1); }
    }
};
struct EpiMoeDown {
    bf16* XR; const float* gate; const int* rsrc; const float* rgate;
    __device__ __forceinline__ void operator()(const f32x4 (&acc)[2][2][4][2], const GUnit& u, int wr, int wc, int fr, int fq) const {
        EPI_ROWS_COLS;
#pragma unroll
        for (int ai = 0; ai < 2; ++ai)
#pragma unroll
            for (int m = 0; m < 4; ++m) { const int pos = u.aux + ai * 128 + row0 + m * 16; const int tok = rsrc[pos];
                if (tok >= 0) { const float rg = rgate[pos]; const int b = tok / RB; const bool isc = (tok - b * RB) >= SEQ; bf16* dst = XR + (size_t)tok * DM; const float* gv = gate + (isc ? 16 : b) * 6144;
#pragma unroll
                    for (int bj = 0; bj < 2; ++bj) { const int c = u.pn * 256 + bj * 128 + col0;
                        const f32x4 g0 = *(const f32x4*)(gv + c) * rg, g1 = *(const f32x4*)(gv + c + 4) * rg; const u32x4 w = *(const u32x4*)(dst + c);
                        const f32x4 x0 = {bf2f(w.x & 0xffffu), bf2f(w.x >> 16), bf2f(w.y & 0xffffu), bf2f(w.y >> 16)}, x1 = {bf2f(w.z & 0xffffu), bf2f(w.z >> 16), bf2f(w.w & 0xffffu), bf2f(w.w >> 16)};
                        *(u32x4*)(dst + c) = pack8(x0 + g0 * acc[ai][bj][m][0], x1 + g1 * acc[ai][bj][m][1]); } } }
    }
};

struct SchedRows {
    const char* A; const char* B; size_t a_tile, b_tile; int nM, nN, pm0, a_local, wgm, lat_only;
    __device__ __forceinline__ bool next(int i, GUnit& u) const { int pm, pn; if (!pg8::tile_order(i, GRID, bx_opaque(), nM, nN, wgm, pm, pn)) return false;
        u.pm = lat_only ? pm + (pm >> 4) : pm0 + pm; u.pn = pn; u.aux = pm; u.rows = nullptr; u.A = A + (size_t)(a_local ? pm : u.pm) * a_tile; u.B = B + (size_t)pn * b_tile; return true; }
};
struct SchedS5 {
    const char* A; const char* B; size_t b_group;
    __device__ __forceinline__ bool next(int i, GUnit& u) const { const int L = i * GRID + bx_opaque(); if (L >= 17 * 16) return false;
        const int g = L & 15, pm = L >> 4; u.pm = pm; u.pn = 0; u.aux = g; u.rows = nullptr;
        u.A = A + ((size_t)g * NR16 + (size_t)pm * 256) * 512 * 2; u.B = B + (size_t)g * b_group; return true; }
};
struct SchedMoe {
    const char* A; const char* B; const int* rsrc; const LAS int* mbase; int np, nN, p0, slot, down; size_t b_exp, b_tile; int wgm;
    __device__ __forceinline__ bool next(int i, GUnit& u) const { int pm, pn; if (!pg8::tile_order(i, GRID, bx_opaque(), np, nN, wgm, pm, pn)) return false;
        const int gp = p0 + pm; int e = 0;
#pragma unroll
        for (int k = 1; k < 8; ++k) e += (gp * 256 >= mbase[slot * 8 + k]) ? 1 : 0;
        e = __builtin_amdgcn_readfirstlane(e);
        u.pm = gp; u.pn = pn; u.B = B + (size_t)e * b_exp + (size_t)pn * b_tile;
        if (down) { u.aux = gp * 256; u.rows = nullptr; u.A = A + (size_t)pm * 256 * FF * 2; }
        else { u.aux = pm; u.rows = rsrc + (size_t)gp * 256; u.A = A; }
        return true; }
};
__device__ __forceinline__ void transpose_item(const float* __restrict__ W, int N, bf16* __restrict__ WT, int Kd, int dst_row0, int k0, int n0, LAS float* scr, int lane) {
    { const int kq = lane >> 3, n4 = (lane & 7) * 4; f32x4 v[8];
#pragma unroll
      for (int i = 0; i < 8; ++i) v[i] = *(const f32x4*)(W + (size_t)(k0 + kq + 8 * i) * N + n0 + n4);
#pragma unroll
      for (int i = 0; i < 8; ++i) { LAS float* d = scr + (kq + 8 * i) * 33 + n4; d[0] = v[i][0]; d[1] = v[i][1]; d[2] = v[i][2]; d[3] = v[i][3]; } }
    LDS_WAIT(); asm volatile("" ::: "memory");
    const int c = lane & 7;
#pragma unroll
    for (int j = 0; j < 4; ++j) { const int n = (lane >> 3) + 8 * j; const LAS float* s = scr + (8 * c) * 33 + n;
        u32x4 o; o.x = pk2(s[0 * 33], s[1 * 33]); o.y = pk2(s[2 * 33], s[3 * 33]); o.z = pk2(s[4 * 33], s[5 * 33]); o.w = pk2(s[6 * 33], s[7 * 33]);
        *(u32x4*)(WT + (size_t)(dst_row0 + n) * Kd + k0 + 8 * c) = o; }
    LDS_WAIT(); asm volatile("" ::: "memory");
}
__device__ __forceinline__ void prologue_weights(const KA& p, LAS unsigned char* lds, int wid, int lane) {
    LAS float* scr = (LAS float*)(lds + wid * 16384);
    const int gw = bx_opaque() * NWAVES + wid;
    constexpr int PER_LAYER = 1280 + 512 + 32, N_A = NLAYER * PER_LAYER, PER_F = 3 * 1408, N_ALL = N_A + 18 * PER_F;
    unsigned char* ws = p.ws();
    for (int it = gw; it < N_ALL; it += NGW) {
        if (it < N_A) { const int l = it / PER_LAYER; int r = it - l * PER_LAYER;
            if (r < 1280) { transpose_item(p.in(I_WIN) + (size_t)l * DM * INW, INW, (bf16*)(ws + WS_WIN) + (size_t)l * INW * DM, DM, 32 * (r % 80), 64 * (r / 80), 32 * (r % 80), scr, lane); continue; } r -= 1280;
            if (r < 512) { transpose_item(p.in(I_WOUT) + (size_t)l * DM * DM, DM, (bf16*)(ws + WS_WOUT) + (size_t)l * DM * DM, DM, 32 * (r % 32), 64 * (r / 32), 32 * (r % 32), scr, lane); continue; } r -= 512;
            transpose_item(p.in(I_WGLU) + (size_t)l * 65536, 256, (bf16*)(ws + WS_WGLU) + (size_t)l * 65536, 256, 32 * (r % 8), 64 * (r / 8), 32 * (r % 8), scr, lane);
        } else { const int r0 = it - N_A, f = r0 / PER_F, r = r0 - f * PER_F, which = r / 1408, q = r - which * 1408;
            const bool dense = f < 2; const int mi = dense ? f : f - 2;
            const size_t wo = (size_t)mi * DM * FF;
            if (which < 2) { const float* W = (which == 0 ? (dense ? p.in(I_FW1) : p.in(I_MW1)) : (dense ? p.in(I_FW3) : p.in(I_MW3))) + wo;
                bf16* WT = (bf16*)(ws + (dense ? WS_W13D : WS_W13M) + (size_t)mi * SZ_W13);
                const int kb = q / 88, nb = q % 88, n0 = 32 * nb;
                transpose_item(W, FF, WT, DM, (n0 >> 7) * 256 + which * 128 + (n0 & 127), 64 * kb, n0, scr, lane);
            } else { const float* W = (dense ? p.in(I_FW2) : p.in(I_MW2)) + wo; bf16* WT = (bf16*)(ws + (dense ? WS_W2D : WS_W2M) + (size_t)mi * SZ_W2);
                const int kb = q / 32, nb = q % 32; transpose_item(W, DM, WT, FF, 32 * nb, 64 * kb, 32 * nb, scr, lane); }
        }
    }
}
__device__ __forceinline__ void prologue_mod(const KA& p, LAS unsigned char* lds, int tid, int wid, int lane) {
    LAS float* sc = (LAS float*)lds; LAS float* red = (LAS float*)(lds + 17 * 1024 * 4);
    __syncthreads();
    for (int idx = tid; idx < 17 * 1024; idx += NTHREADS) { const int cond = idx >> 10, k = idx & 1023; const float v = cond < 16 ? p.in(I_C)[cond * 1024 + k] : p.in(I_CCTX)[k]; sc[idx] = v / (1.f + expf(-v)); }
    __syncthreads();
    float* MOD = (float*)(p.ws() + WS_MOD);
    for (int u = bx_opaque(); u < NLAYER * 96; u += GRID) { const int l = u / 96, cb = u % 96;
        float acc[17];
#pragma unroll
        for (int c = 0; c < 17; ++c) acc[c] = 0.f;
        const float* wp = p.in(I_WMOD) + ((size_t)l * 1024 + wid * 128) * 6144 + cb * 64 + lane;
        for (int k = 0; k < 128; k += 16) { float w[16];
#pragma unroll
            for (int q = 0; q < 16; ++q) w[q] = wp[(size_t)(k + q) * 6144];
#pragma unroll
            for (int q = 0; q < 16; q += 4)
#pragma unroll
                for (int c = 0; c < 17; ++c) { const f32x4 s = *(const LAS f32x4*)(sc + c * 1024 + wid * 128 + k + q); acc[c] += s[0] * w[q] + s[1] * w[q + 1] + s[2] * w[q + 2] + s[3] * w[q + 3]; } }
#pragma unroll
        for (int c = 0; c < 17; ++c) red[(wid * 17 + c) * 64 + lane] = acc[c];
        __syncthreads();
        for (int o = tid; o < 17 * 64; o += NTHREADS) { const int c = o >> 6, j = o & 63; float s = p.in(I_BMOD)[l * 6144 + cb * 64 + j];
#pragma unroll
            for (int w = 0; w < 8; ++w) s += red[(w * 17 + c) * 64 + j];
            MOD[((size_t)l * 17 + c) * 6144 + cb * 64 + j] = s; }
        __syncthreads();
    }
}
__device__ __forceinline__ void prologue_small_tables(const KA& p, int tid) {
    float* rope = (float*)(p.ws() + WS_ROPE); float* lamt = (float*)(p.ws() + WS_LAM);
    for (int i = tid; i < 1024; i += NTHREADS) { const int pos = i >> 4, k = i & 15; const float inv = exp2f(-(float)k * (13.287712379549449f / 16.f)); const float a = (float)pos * inv; rope[2 * i] = cosf(a); rope[2 * i + 1] = sinf(a); }
    if (tid < NLAYER) { const int l = tid; float d1 = 0.f, d2 = 0.f;
        for (int k = 0; k < 64; ++k) { d1 += p.in(I_LQ1)[l * 64 + k] * p.in(I_LK1)[l * 64 + k]; d2 += p.in(I_LQ2)[l * 64 + k] * p.in(I_LK2)[l * 64 + k]; }
        const float li = 0.8f - 0.6f * expf(-0.3f * (float)l); lamt[2 * l] = expf(d1) - expf(d2) + li; lamt[2 * l + 1] = li; }
}
__device__ __forceinline__ f32x2 cpow_turns(float lre_dt, double rev, int k) {
    const float mag = expf((float)k * lre_dt); double tk = rev * (double)k; tk -= __builtin_floor(tk + 0.5); const float ang = (float)(tk * 6.283185307179586);
    return (f32x2){mag * cosf(ang), mag * sinf(ang)};
}
__device__ __forceinline__ void prologue_s5(const KA& p, LAS unsigned char* lds, int tid, int l, int g) {
    LAS f32x2* apow = (LAS f32x2*)lds;
    LAS f32x2* bb = (LAS f32x2*)(lds + 17408);
    LAS f32x2* cc = (LAS f32x2*)(lds + 33792);
    LAS float* KT = (LAS float*)(lds + 50176);
    __syncthreads();
    if (tid < 128) { const int dir = tid >> 6, pp = tid & 63, gi = (l * 2 + dir) * 16 + g, idx = gi * 64 + pp;
        const float lre = p.in(I_LAMRE)[idx], lim = p.in(I_LAMIM)[idx], dt = expf(p.in(I_LOGSTEP)[gi]);
        const double rev = (double)lim * (double)dt * 0.15915494309189535; const float lre_dt = lre * dt;
        for (int k = 0; k <= 16; ++k) apow[(dir * 17 + k) * 64 + pp] = cpow_turns(lre_dt, rev, k);
        const f32x2 a1 = cpow_turns(lre_dt, rev, 1), a16 = cpow_turns(lre_dt, rev, 16), a544 = cpow_turns(lre_dt, rev, 544);
        ((f32x4*)(p.ws() + WS_A16))[idx] = (f32x4){a16.x, a16.y, a544.x, a544.y};
        const float nre = a1.x - 1.f, nim = a1.y, den = lre * lre + lim * lim, fre = (nre * lre + nim * lim) / den, fim = (nim * lre - nre * lim) / den;
        for (int h = 0; h < 16; ++h) { const float br = p.in(I_BRE)[(size_t)idx * 16 + h], bi = p.in(I_BIM)[(size_t)idx * 16 + h]; bb[(dir * 64 + pp) * 16 + h] = (f32x2){fre * br - fim * bi, fre * bi + fim * br}; } }
    for (int e = tid; e < 2048; e += NTHREADS) { const int dir = e >> 10, h = (e >> 6) & 15, pp = e & 63; const size_t ci = ((size_t)((l * 2 + dir) * 16 + g) * 16 + h) * 64 + pp;
        cc[e] = (f32x2){p.in(I_CRE)[ci], p.in(I_CIM)[ci]}; }
    __syncthreads();
    bf16* W1 = (bf16*)(p.ws() + WS_S5W1) + (size_t)(l * 16 + g) * 65536; bf16* W2 = (bf16*)(p.ws() + WS_S5W2) + (size_t)(l * 16 + g) * 131072;
    for (int it = 0; it < 128; ++it) { const int e = it * NTHREADS + tid, n = e >> 8, k = e & 255;
        { const int dir = n >> 7, part = (n >> 6) & 1, pp = n & 63, j = k >> 4, hh = k & 15, pw = dir == 0 ? 15 - j : j;
          const f32x2 a = apow[(dir * 17 + pw) * 64 + pp], b = bb[(dir * 64 + pp) * 16 + hh];
          W1[e] = (bf16)f2bf(part ? (a.x * b.y + a.y * b.x) : (a.x * b.x - a.y * b.y)); }
        { const int i = n >> 4, h = n & 15, dir = k >> 7, part = (k >> 6) & 1, pp = k & 63, pw = dir == 0 ? i + 1 : 16 - i;
          const f32x2 a = apow[(dir * 17 + pw) * 64 + pp], c = cc[(dir * 16 + h) * 64 + pp];
          W2[(size_t)n * 512 + k] = (bf16)f2bf(part ? -(c.x * a.y + c.y * a.x) : (c.x * a.x - c.y * a.y)); } }
    { const int dir = tid >> 8, h = (tid >> 4) & 15, hh = tid & 15;
      for (int lag = 0; lag < 16; ++lag) { float s = 0.f;
          for (int pp = 0; pp < 64; ++pp) { const f32x2 c = cc[(dir * 16 + h) * 64 + pp], a = apow[(dir * 17 + lag) * 64 + pp], b = bb[(dir * 64 + pp) * 16 + hh];
              const float cax = c.x * a.x - c.y * a.y, cay = c.x * a.y + c.y * a.x; s += cax * b.x - cay * b.y; }
          KT[(dir * 16 + lag) * 256 + h * 16 + hh] = s; } }
    __syncthreads();
    for (int it = 0; it < 128; ++it) { const int e = it * NTHREADS + tid, n = e >> 8, kk = e & 255, i = n >> 4, h = n & 15, j = kk >> 4, hh = kk & 15;
        float v = 0.f; if (j <= i) v += KT[(i - j) * 256 + h * 16 + hh]; if (j >= i) v += KT[(16 + j - i) * 256 + h * 16 + hh];
        if (i == j && h == hh) v += p.in(I_SSMD)[l * 256 + g * 16 + h];
        W2[(size_t)n * 512 + 256 + kk] = (bf16)f2bf(v); }
    __syncthreads();
}

template <bool ROUTER, bool F32SRC>
__device__ __forceinline__ void norm_phase(const KA& p, LAS unsigned char* lds, int tid, int wid, int lane, const float* srcL, const float* srcC, const float* gvec, const float* shiftv, const float* scalev,
                                           const float* router, bool skip_ctx) {
    bf16* HX = (bf16*)((unsigned char*)p.out() + OUT_HX); const bf16* XR = (const bf16*)(p.ws() + WS_XR);
    const int gw = bx_opaque() * NWAVES + wid;
    LAS int* wcnt = (LAS int*)lds + wid * 16;
    f32x4 wr0[ROUTER ? 16 : 1], wr1[ROUTER ? 16 : 1];
    if constexpr (ROUTER) {
        __syncthreads(); if (lane < 16) wcnt[lane] = 0;
        int* rsrc = (int*)(p.ws() + WS_RSRC); for (int i = bx_opaque() * NTHREADS + tid; i < MOE_ROWS; i += GRID * NTHREADS) rsrc[i] = -1;
#pragma unroll
        for (int j = 0; j < 4; ++j)
#pragma unroll
            for (int k = 0; k < 4; ++k) { const int c = 4 * lane + 256 * j + k; wr0[j * 4 + k] = *(const f32x4*)(router + (size_t)c * 8); wr1[j * 4 + k] = *(const f32x4*)(router + (size_t)c * 8 + 4); }
    }
    f32x4 Av[4], Bv[4]; int cur_cond = -1;
    constexpr int NB_ROWS = F32SRC ? 4 : (ROUTER ? 3 : 9);
    for (int rr0 = 0; rr0 < RPW; rr0 += NB_ROWS) {
        f32x4 rawf[F32SRC ? NB_ROWS : 1][4]; u32x2 rawh[F32SRC ? 1 : NB_ROWS][4];
#pragma unroll
        for (int d = 0; d < NB_ROWS; ++d) if (rr0 + d < RPW) { const int r = gw * RPW + rr0 + d;
            if constexpr (F32SRC) { bool isc; const size_t ro = res_off(r, isc); const float* xr = (isc ? srcC : srcL) + ro;
#pragma unroll
                for (int j = 0; j < 4; ++j) rawf[d][j] = *(const f32x4*)(xr + 4 * lane + 256 * j); }
            else {
#pragma unroll
                for (int j = 0; j < 4; ++j) rawh[d][j] = *(const u32x2*)(XR + (size_t)r * DM + 4 * lane + 256 * j); } }
#pragma unroll
        for (int d = 0; d < NB_ROWS; ++d) if (rr0 + d < RPW) { const int r = gw * RPW + rr0 + d; const int bq = r / RB; const bool isc = (r - bq * RB) >= SEQ; const int cond = isc ? 16 : bq;
        if (cond != cur_cond) { cur_cond = cond;
#pragma unroll
            for (int j = 0; j < 4; ++j) { const int c = 4 * lane + 256 * j; const f32x4 g = *(const f32x4*)(gvec + c), s = *(const f32x4*)(scalev + (size_t)cond * 6144 + c); Av[j] = g * (s + 1.f); Bv[j] = *(const f32x4*)(shiftv + (size_t)cond * 6144 + c); } }
        f32x4 v[4]; float ss = 0.f;
#pragma unroll
        for (int j = 0; j < 4; ++j) {
            if constexpr (F32SRC) v[j] = rawf[d][j];
            else { const u32x2 w = rawh[d][j]; v[j] = (f32x4){bf2f(w.x & 0xffffu), bf2f(w.x >> 16), bf2f(w.y & 0xffffu), bf2f(w.y >> 16)}; }
            ss += (v[j][0] * v[j][0] + v[j][1] * v[j][1]) + (v[j][2] * v[j][2] + v[j][3] * v[j][3]); }
        const float rinv = 1.f / sqrtf(wave_sum(ss) * (1.f / DM) + 1e-6f);
#pragma unroll
        for (int j = 0; j < 4; ++j) { v[j] = v[j] * rinv * Av[j] + Bv[j]; *(u32x2*)(HX + (size_t)r * DM + 4 * lane + 256 * j) = (u32x2){pk2(v[j][0], v[j][1]), pk2(v[j][2], v[j][3])}; }
        if constexpr (ROUTER) {
            int* toke = (int*)(p.ws() + WS_TOKE); f32x2* tokg = (f32x2*)(p.ws() + WS_TOKG);
            if (isc && skip_ctx) { if (lane == 0) toke[r] = 0xFFFF; }
            else { f32x4 l0 = {0.f, 0.f, 0.f, 0.f}, l1 = {0.f, 0.f, 0.f, 0.f};
#pragma unroll
                for (int j = 0; j < 4; ++j)
#pragma unroll
                    for (int k = 0; k < 4; ++k) { l0 += wr0[j * 4 + k] * v[j][k]; l1 += wr1[j * 4 + k] * v[j][k]; }
                float lg[8];
#pragma unroll
                for (int e = 0; e < 4; ++e) { lg[e] = wave_sum(l0[e]); lg[4 + e] = wave_sum(l1[e]); }
                int e0 = 0; float v0 = lg[0];
#pragma unroll
                for (int e = 1; e < 8; ++e) if (lg[e] > v0) { v0 = lg[e]; e0 = e; }
                int e1 = -1; float v1 = -3.0e38f;
#pragma unroll
                for (int e = 0; e < 8; ++e) if (e != e0 && lg[e] > v1) { v1 = lg[e]; e1 = e; }
                const float g0 = 1.f / (1.f + expf(v1 - v0));
                if (lane == 0) { toke[r] = e0 | (e1 << 8); tokg[r] = (f32x2){g0, 1.f - g0}; wcnt[e0] += 1; wcnt[8 + e1] += 1; } }
        }
        }
    }
    if constexpr (ROUTER) { LDS_WAIT(); if (lane < 16) ((int*)(p.ws() + WS_WCNT))[gw * 16 + lane] = wcnt[lane]; }
}
__device__ __forceinline__ void route2_phase(const KA& p, LAS unsigned char* lds, LAS int* mbase_lds, int tid, int wid, int lane) {
    LAS int* segsum = (LAS int*)lds;
    LAS int* wpre = segsum + 512;
    LAS int* tot = wpre + 128;
    LAS int* wstart = tot + 16;
    const int* wcnt = (const int*)(p.ws() + WS_WCNT);
    __syncthreads();
    { const int seg = tid >> 4, bin = tid & 15, myseg = bx_opaque() >> 3, wg0 = (bx_opaque() & 7) * 8; int s = 0;
      for (int k = 0; k < 64; ++k) { const int c = wcnt[(seg * 64 + k) * 16 + bin]; if (seg == myseg && k >= wg0 && k < wg0 + 8) wpre[(k - wg0) * 16 + bin] = s; s += c; }
      segsum[seg * 16 + bin] = s; }
    __syncthreads();
    if (tid < 16) { int s = 0; for (int k = 0; k < 32; ++k) s += segsum[k * 16 + tid]; tot[tid] = s; }
    __syncthreads();
    if (tid == 0) { int b = 0; for (int k = 0; k < 16; ++k) { mbase_lds[k] = b; b += (tot[k] + 255) & ~255; } mbase_lds[16] = b; }
    __syncthreads();
    if (bx_opaque() == 0 && tid < 17) ((int*)(p.ws() + WS_MBASE))[tid] = mbase_lds[tid];
    if (tid < 128) { const int w = tid >> 4, bin = tid & 15, myseg = bx_opaque() >> 3; int s = mbase_lds[bin] + wpre[w * 16 + bin]; for (int k = 0; k < myseg; ++k) s += segsum[k * 16 + bin]; wstart[w * 16 + bin] = s; }
    __syncthreads();
    { const int gw = bx_opaque() * NWAVES + wid; const int* toke = (const int*)(p.ws() + WS_TOKE); const f32x2* tokg = (const f32x2*)(p.ws() + WS_TOKG);
      int* rsrc = (int*)(p.ws() + WS_RSRC); float* rgate = (float*)(p.ws() + WS_RGATE);
      const bool act = lane < RPW; const int r = gw * RPW + (act ? lane : 0); const int te = act ? toke[r] : 0xFFFF; const f32x2 g = act ? tokg[r] : (f32x2){0.f, 0.f};
      const bool valid = te != 0xFFFF; const int e0 = te & 255, e1 = (te >> 8) & 255; int p0 = 0, p1 = 0;
      const unsigned long long ltm = (1ull << lane) - 1ull;
#pragma unroll
      for (int bin = 0; bin < 8; ++bin) { const unsigned long long m0 = __ballot(valid && e0 == bin), m1 = __ballot(valid && e1 == bin);
          if (e0 == bin) p0 = wstart[wid * 16 + bin] + __popcll(m0 & ltm);
          if (e1 == bin) p1 = wstart[wid * 16 + 8 + bin] + __popcll(m1 & ltm); }
      if (valid) { rsrc[p0] = r; rgate[p0] = g.x; rsrc[p1] = r; rgate[p1] = g.y; } }
    __syncthreads();
}
__device__ __forceinline__ void carry_phase(const KA& p, LAS unsigned char* lds, int tid, int wid, int lane, int l) {
    LAS f32x2* segend = (LAS f32x2*)lds;
    const float* Z = (const float*)(p.ws() + WS_ZLOC); bf16* A2 = (bf16*)((unsigned char*)p.out() + OUT_A2);
    for (int u = bx_opaque(); u < NB * 16 * 2; u += GRID) { const int dir = u & 1, g = (u >> 1) & 15, b = u >> 5;
        const f32x4 at = ((const f32x4*)(p.ws() + WS_A16))[((l * 2 + dir) * 16 + g) * 64 + lane];
        const float ar = at[0], ai = at[1];
        const size_t zrow0 = (size_t)g * NR16 + (size_t)b * 272;
        float lr[34], li[34];
#pragma unroll
        for (int k = 0; k < 34; ++k) { const int q = wid * 34 + k, cp = dir == 0 ? (q < 16 ? 256 + q : q - 16) : 271 - q; const float* zp = Z + (zrow0 + cp) * 256 + dir * 128 + lane; lr[k] = zp[0]; li[k] = zp[64]; }
        float zr = 0.f, zi = 0.f;
#pragma unroll
        for (int k = 0; k < 34; ++k) { const float nr = ar * zr - ai * zi + lr[k], ni = ar * zi + ai * zr + li[k]; zr = nr; zi = ni; }
        __syncthreads();
        segend[wid * 64 + lane] = (f32x2){zr, zi};
        __syncthreads();
        float cr = 0.f, ci = 0.f;
        for (int w = 0; w < wid; ++w) { const f32x2 s = segend[w * 64 + lane]; const float nr = at[2] * cr - at[3] * ci + s.x, ni = at[2] * ci + at[3] * cr + s.y; cr = nr; ci = ni; }
        zr = cr; zi = ci;
#pragma unroll
        for (int k = 0; k < 34; ++k) { const int q = wid * 34 + k, cp = dir == 0 ? (q < 16 ? 256 + q : q - 16) : 271 - q;
            bf16* ap = A2 + (zrow0 + cp) * 512 + dir * 128 + lane; ap[0] = (bf16)f2bf(zr); ap[64] = (bf16)f2bf(zi);
            const float nr = ar * zr - ai * zi + lr[k], ni = ar * zi + ai * zr + li[k]; zr = nr; zi = ni; }
    }
    __syncthreads();
}
__device__ __forceinline__ void final_phase(const KA& p, int wid, int lane) {
    const int gw = bx_opaque() * NWAVES + wid; f32x4 g[4]; const bf16* XR = (const bf16*)(p.ws() + WS_XR);
#pragma unroll
    for (int j = 0; j < 4; ++j) g[j] = *(const f32x4*)(p.in(I_GFINAL) + 4 * lane + 256 * j);
    for (int rl0 = gw * 32; rl0 < gw * 32 + 32; rl0 += 8) { u32x2 raw[8][4];
#pragma unroll
        for (int d = 0; d < 8; ++d) { const int rl = rl0 + d, b = rl >> 12, n = rl & 4095; const bf16* xr = XR + ((size_t)b * RB + n) * DM;
#pragma unroll
            for (int j = 0; j < 4; ++j) raw[d][j] = *(const u32x2*)(xr + 4 * lane + 256 * j); }
#pragma unroll
        for (int d = 0; d < 8; ++d) { float* orow = p.out() + (size_t)(rl0 + d) * DM; f32x4 v[4]; float ss = 0.f;
#pragma unroll
            for (int j = 0; j < 4; ++j) { const u32x2 w = raw[d][j]; v[j] = (f32x4){bf2f(w.x & 0xffffu), bf2f(w.x >> 16), bf2f(w.y & 0xffffu), bf2f(w.y >> 16)};
                ss += (v[j][0] * v[j][0] + v[j][1] * v[j][1]) + (v[j][2] * v[j][2] + v[j][3] * v[j][3]); }
            const float rinv = 1.f / sqrtf(wave_sum(ss) * (1.f / DM) + 1e-6f);
#pragma unroll
            for (int j = 0; j < 4; ++j) *(f32x4*)(orow + 4 * lane + 256 * j) = v[j] * rinv * g[j]; } }
}

constexpr int DIFF_STASH_OFF = 61440;
static_assert(DIFF_STASH_OFF >= att::ATT_LDS && DIFF_STASH_OFF + 65536 <= RING_BYTES, "per-wave output stage inside the ring");
__device__ __forceinline__ void diff_unit(const bf16* P, bf16* Y, int rows0, int h, int kbase, int NT, const float* lamp, const float* gsub, LAS unsigned char* lds) {
    const int tid = tid_opaque(), lane = tid & 63, wid = __builtin_amdgcn_readfirstlane(tid >> 6), r32 = lane & 31, hi = lane >> 5;
    LAS bf16* st = (LAS bf16*)(lds + DIFF_STASH_OFF) + wid * 4096 + r32;
    {
        f32x16 o[4];
        att::attn_body<128, 0>(P + (size_t)rows0 * PW + PC_DQ + h * 128, P + PC_DK + h * 128, P + PC_DV + h * 128, kbase, NT, 0, NT, lds, o, 0, 0);
#pragma unroll
        for (int r = 0; r < 16; ++r)
#pragma unroll
            for (int d = 0; d < 4; ++d) st[att::crow(r, hi) * 128 + d * 32] = (bf16)f2bf(o[d][r]);
    }
    asm volatile("s_waitcnt lgkmcnt(0)" ::: "memory"); __builtin_amdgcn_sched_barrier(0);
    {
        f32x16 o[4];
        att::attn_body<128, 0>(P + (size_t)rows0 * PW + PC_DQ + h * 128 + 64, P + PC_DK + h * 128 + 64, P + PC_DV + h * 128, kbase, NT, 0, NT, lds, o, 0, 0);
        const float lam = lamp[0], lam_init = lamp[1];
        float ss[16];
#pragma unroll
        for (int r = 0; r < 16; ++r) { ss[r] = 0.f;
#pragma unroll
            for (int d = 0; d < 4; ++d) { const float o1 = bf2f((unsigned)st[att::crow(r, hi) * 128 + d * 32]); const float v = o1 - lam * o[d][r]; o[d][r] = v; ss[r] += v * v; } }
#pragma unroll
        for (int r = 0; r < 16; ++r) {
            ss[r] = half_sum(ss[r]);
            ss[r] = (1.f / sqrtf(ss[r] * (1.f / 128.f) + 1e-5f)) * (1.f - lam_init); }
        float gs[4];
#pragma unroll
        for (int d = 0; d < 4; ++d) gs[d] = gsub[d * 32 + r32];
#pragma unroll
        for (int r = 0; r < 16; ++r)
#pragma unroll
            for (int d = 0; d < 4; ++d) st[att::crow(r, hi) * 128 + d * 32] = (bf16)f2bf(o[d][r] * ss[r] * gs[d]);
        asm volatile("s_waitcnt lgkmcnt(0)" ::: "memory");
        { const LAS bf16* sw = (const LAS bf16*)(lds + DIFF_STASH_OFF) + wid * 4096; bf16* yo = Y + (size_t)(rows0 + wid * 32) * DM + 256 + h * 128;
#pragma unroll
          for (int i = 0; i < 8; ++i) { const int row = i * 4 + (lane >> 4), ch = lane & 15; *(u32x4*)(yo + (size_t)row * DM + ch * 8) = *(const LAS u32x4*)(sw + row * 128 + ch * 8); } }
        asm volatile("s_waitcnt lgkmcnt(0)" ::: "memory");
    }
}
__device__ __forceinline__ void na_unit(const bf16* P, bf16* Y, const float* rpb_h, int b, int h, int qb, LAS unsigned char* lds) {
    const int tid = tid_opaque(), lane = tid & 63, wid = __builtin_amdgcn_readfirstlane(tid >> 6), r32 = lane & 31, hi = lane >> 5; const int rows0 = b * RB + qb * 256, r0 = qb * 4;
    const int kmin = min(min(max(r0 - 4, 0), 56), 52);
    __syncthreads();
    { LAS float* tbl = (LAS float*)(lds + att::OFF_RPB);
      for (int i = tid; i < 15 * att::RPB_PITCH; i += NTHREADS) { const int ri = i >> 7, cj = (i & 127) - 48; tbl[i] = ((unsigned)cj < 31u) ? rpb_h[ri * 31 + cj] * 1.4426950408889634f : 0.f; } }
    f32x16 o[2];
    att::attn_body<64, 1>(P + (size_t)rows0 * PW + PC_NQ + h * 64, P + PC_NK + h * 64, P + PC_NV + h * 64, b * RB + SEQ, 4, b * RB + kmin * 64, 16, lds, o, r0 + (wid >> 1), kmin);
    { LAS bf16* sw = (LAS bf16*)(lds + DIFF_STASH_OFF) + wid * 4096;
#pragma unroll
      for (int r = 0; r < 16; ++r)
#pragma unroll
          for (int d = 0; d < 2; ++d) sw[att::crow(r, hi) * 64 + d * 32 + r32] = (bf16)f2bf(o[d][r]);
      asm volatile("s_waitcnt lgkmcnt(0)" ::: "memory");
      bf16* yo = Y + (size_t)(rows0 + wid * 32) * DM + 768 + h * 64;
#pragma unroll
      for (int i = 0; i < 4; ++i) { const int row = i * 8 + (lane >> 3), ch = lane & 7; *(u32x4*)(yo + (size_t)row * DM + ch * 8) = *(const LAS u32x4*)(sw + row * 64 + ch * 8); }
      asm volatile("s_waitcnt lgkmcnt(0)" ::: "memory"); }
}
__device__ __forceinline__ void na_ctx_unit(const bf16* P, bf16* Y, int b, int h, LAS unsigned char* lds) {
    const int tid = tid_opaque(), lane = tid & 63, wid = __builtin_amdgcn_readfirstlane(tid >> 6), r32 = lane & 31, hi = lane >> 5; const int rows0 = b * RB + SEQ;
    f32x16 o[2];
    att::attn_body<64, 0>(P + (size_t)rows0 * PW + PC_NQ + h * 64, P + PC_NK + h * 64, P + PC_NV + h * 64, rows0, 4, 0, 4, lds, o, 0, 0);
    { LAS bf16* sw = (LAS bf16*)(lds + DIFF_STASH_OFF) + wid * 4096;
#pragma unroll
      for (int r = 0; r < 16; ++r)
#pragma unroll
          for (int d = 0; d < 2; ++d) sw[att::crow(r, hi) * 64 + d * 32 + r32] = (bf16)f2bf(o[d][r]);
      asm volatile("s_waitcnt lgkmcnt(0)" ::: "memory");
      bf16* yo = Y + (size_t)(rows0 + wid * 32) * DM + 768 + h * 64;
#pragma unroll
      for (int i = 0; i < 4; ++i) { const int row = i * 8 + (lane >> 3), ch = lane & 7; *(u32x4*)(yo + (size_t)row * DM + ch * 8) = *(const LAS u32x4*)(sw + row * 64 + ch * 8); }
      asm volatile("s_waitcnt lgkmcnt(0)" ::: "memory"); }
}
#ifndef WGM_IN
#define WGM_IN 4
#endif
#ifndef WGM_OUT
#define WGM_OUT 4
#endif
#ifndef WGM_UP
#define WGM_UP 4
#endif
#ifndef WGM_DOWN
#define WGM_DOWN 4
#endif
__global__ void __launch_bounds__(NTHREADS, 2) dit_fwd(Params p_unused) {
    (void)p_unused;
    LAS unsigned char* lds = (LAS unsigned char*)lds_raw;
    volatile LAS unsigned* MISC = (volatile LAS unsigned*)(lds + MISC_OFF);
    LAS int* mbase = (LAS int*)(lds + MISC_OFF + 128);
#define PH_ARGS KA p; p.k = (const CAS unsigned char*)__builtin_amdgcn_kernarg_segment_ptr(); asm volatile("" : "+s"(p.k)); unsigned char* const ws = p.ws(); (void)ws
#define PH_IDS PH_ARGS; const int tid = tid_opaque(), lane = tid & 63, wid = __builtin_amdgcn_readfirstlane(tid >> 6); (void)lane; (void)wid
#define BX (bx_opaque())
#define VCU ((BX & 7) * (GRID / 8) + (BX >> 3))
    for (int u = (int)threadIdx.x; u < (LDS_BYTES - LDSCTL_OFF) / 4; u += NTHREADS) ((LAS unsigned*)(lds + LDSCTL_OFF))[u] = 0u;
    __syncthreads();
    if ((threadIdx.x & 63) == 0) ((volatile LAS int*)(lds + WTAB_OFF))[hw_wave_slot()] = (int)(threadIdx.x >> 6);
    __syncthreads();
    { PH_ARGS; (void)xcd_barrier_post((unsigned*)(ws + WS_CTL) + CW_BAR, MISC + 8); }
#define GRID_BAR_T(FIRST) do { PH_ARGS; XcdBarrier b_; b_.bar = (unsigned*)(ws + WS_CTL) + CW_BAR; b_.x = xb_xcc_id(); b_.st = (volatile LAS unsigned*)(lds + MISC_OFF) + 8; xcd_barrier<FIRST>(b_); } while (0)
#define GRID_BAR() GRID_BAR_T(false)

#define MOD ((float*)(ws + WS_MOD))
#define OUTB ((unsigned char*)p.out())
#define XR ((bf16*)(ws + WS_XR))
#define HX ((bf16*)(OUTB + OUT_HX))
#define P ((bf16*)(ws + WS_P))
#define H ((bf16*)(ws + WS_H))
#define A2 ((bf16*)(OUTB + OUT_A2))
#define ZL ((float*)(ws + WS_ZLOC))
#define GB ((bf16*)(OUTB + OUT_GBUF))
#define MODL (MOD + (size_t)l * 17 * 6144)

    { PH_IDS; prologue_weights(p, lds, wid, lane);
      prologue_mod(p, lds, tid, wid, lane);
      if (BX >= 128 && BX < 192) prologue_s5(p, lds, tid, (BX - 128) >> 4, (BX - 128) & 15);
      if (BX == 255) prologue_small_tables(p, tid); }
    GRID_BAR_T(true);

    for (int l = 0; l < NLAYER; ++l) {
        const int last = (l == NLAYER - 1) ? 1 : 0;
        { PH_IDS; if (l == 0) norm_phase<false, true>(p, lds, tid, wid, lane, p.in(I_X), p.in(I_CTX), p.in(I_GMIX), MODL, MODL + 1024, nullptr, false);
          else norm_phase<false, false>(p, lds, tid, wid, lane, nullptr, nullptr, p.in(I_GMIX) + l * DM, MODL, MODL + 1024, nullptr, false); }
        GRID_BAR();
        { PH_ARGS; SchedRows S{(const char*)HX, (const char*)(ws + WS_WIN) + (size_t)l * INW * DM * 2, (size_t)256 * DM * 2, (size_t)256 * DM * 2, NPANEL, INW / 256, 0, 0, WGM_IN, 0};
          EpiInProj E{P, A2, (const float*)(ws + WS_ROPE)};
          pg8::gemm_phase<EpiInProj, SchedRows, false>(lds, DM, DM, DM, S, E); }
        GRID_BAR();
        { PH_ARGS; SchedS5 S{(const char*)A2 + 512, (const char*)(ws + WS_S5W1) + (size_t)l * 16 * 65536 * 2, (size_t)65536 * 2}; EpiZ E{ZL};
          pg8::gemm_phase<EpiZ, SchedS5, false>(lds, 256, 512, 256, S, E); }
        GRID_BAR();
        { PH_IDS; carry_phase(p, lds, tid, wid, lane, l); }
        GRID_BAR();
        { PH_ARGS; SchedS5 S{(const char*)A2, (const char*)(ws + WS_S5W2) + (size_t)l * 16 * 131072 * 2, (size_t)131072 * 2}; EpiY E{GB};
          pg8::gemm_phase<EpiY, SchedS5, false>(lds, 512, 512, 512, S, E); }
        { PH_ARGS; const float* lamp = (const float*)(ws + WS_LAM) + 2 * l; const float* gsub = p.in(I_SUBLN) + l * 128; const int vcu = VCU;
          for (int it = 0; it < 4; ++it) { const int bh = (vcu >> 4) + 16 * it, b = bh >> 2, h = bh & 3, qb = vcu & 15;
              diff_unit(P, HX, b * RB + qb * 256, h, b * RB, RB / 64, lamp, gsub, lds); }
          if (vcu < 64 && !last) { const int b = vcu >> 2, h = vcu & 3; diff_unit(P, HX, b * RB + SEQ, h, b * RB + SEQ, CTXL / 64, lamp, gsub, lds); }
          for (int it = 0; it < 4; ++it) { const int bh = (vcu >> 4) + 16 * it, b = bh >> 2, h = bh & 3, qb = vcu & 15;
              na_unit(P, HX, p.in(I_RPB) + (size_t)(l * 4 + h) * 465, b, h, qb, lds); }
          if (vcu >= 64 && vcu < 128 && !last) { const int b = (vcu - 64) >> 2, h = vcu & 3; na_ctx_unit(P, HX, b, h, lds); }
          __syncthreads(); }
        GRID_BAR();
        { PH_ARGS; SchedRows S{(const char*)GB, (const char*)(ws + WS_WGLU) + (size_t)l * 65536 * 2, (size_t)256 * 256 * 2, (size_t)256 * 256 * 2, last ? NB * 16 : NPANEL, 1, 0, 0, 4, last};
          EpiGlu E{GB, HX, p.in(I_BGLU) + l * 256};
          pg8::gemm_phase<EpiGlu, SchedRows, false>(lds, 256, 256, 256, S, E); }
        GRID_BAR();
        { PH_ARGS; SchedRows S{(const char*)HX, (const char*)(ws + WS_WOUT) + (size_t)l * DM * DM * 2, (size_t)256 * DM * 2, (size_t)256 * DM * 2, last ? NB * 16 : NPANEL, 4, 0, 0, WGM_OUT, last};
          if (l == 0) { EpiRes<true> E{p.in(I_X), p.in(I_CTX), XR, MODL + 2 * 1024}; pg8::gemm_phase<EpiRes<true>, SchedRows, false>(lds, DM, DM, DM, S, E); }
          else { EpiRes<false> E{nullptr, nullptr, XR, MODL + 2 * 1024}; pg8::gemm_phase<EpiRes<false>, SchedRows, false>(lds, DM, DM, DM, S, E); } }
        GRID_BAR();
        { PH_IDS; if (l & 1) norm_phase<true, false>(p, lds, tid, wid, lane, nullptr, nullptr, p.in(I_GFFN) + l * DM, MODL + 3 * 1024, MODL + 4 * 1024, p.in(I_ROUTER) + (size_t)(l >> 1) * DM * 8, l == NLAYER - 1);
          else norm_phase<false, false>(p, lds, tid, wid, lane, nullptr, nullptr, p.in(I_GFFN) + l * DM, MODL + 3 * 1024, MODL + 4 * 1024, nullptr, false); }
        GRID_BAR();
        if (!(l & 1)) {
            const int fi = l >> 1;
            for (int c = 0; c < 2; ++c) { const int pm0 = c * HCHUNK_PANELS, np = (NPANEL - pm0) < HCHUNK_PANELS ? (NPANEL - pm0) : HCHUNK_PANELS;
                { PH_ARGS; SchedRows S{(const char*)HX, (const char*)(ws + WS_W13D) + (size_t)fi * SZ_W13, (size_t)256 * DM * 2, (size_t)256 * DM * 2, np, 22, pm0, 0, WGM_UP, 0}; EpiSwi E{H};
                  pg8::gemm_phase<EpiSwi, SchedRows, false>(lds, DM, DM, DM, S, E); }
                GRID_BAR();
                { PH_ARGS; SchedRows S{(const char*)H, (const char*)(ws + WS_W2D) + (size_t)fi * SZ_W2, (size_t)256 * FF * 2, (size_t)256 * FF * 2, np, 4, pm0, 1, WGM_DOWN, 0};
                  EpiRes<false> E{nullptr, nullptr, XR, MODL + 5 * 1024};
                  pg8::gemm_phase<EpiRes<false>, SchedRows, false>(lds, FF, FF, FF, S, E); }
                GRID_BAR(); }
        } else {
            const int mi = l >> 1;
            { PH_IDS; route2_phase(p, lds, mbase, tid, wid, lane); }
            GRID_BAR();
            for (int s = 0; s < 2; ++s) { const int P0 = __builtin_amdgcn_readfirstlane(mbase[8 * s] >> 8), P1 = __builtin_amdgcn_readfirstlane(mbase[8 * s + 8] >> 8);
                for (int c = 0; c < 2; ++c) { const int p0 = P0 + c * HCHUNK_PANELS; if (p0 >= P1) break; const int np = (P1 - p0) < HCHUNK_PANELS ? (P1 - p0) : HCHUNK_PANELS;
                    { PH_ARGS; SchedMoe S{(const char*)HX, (const char*)(ws + WS_W13M) + (size_t)mi * 8 * SZ_W13, (const int*)(ws + WS_RSRC), mbase, np, 22, p0, s, 0, SZ_W13, (size_t)256 * DM * 2, WGM_UP}; EpiSwi E{H};
                      pg8::gemm_phase<EpiSwi, SchedMoe, true>(lds, DM, DM, DM, S, E); }
                    GRID_BAR();
                    { PH_ARGS; SchedMoe S{(const char*)H, (const char*)(ws + WS_W2M) + (size_t)mi * 8 * SZ_W2, (const int*)(ws + WS_RSRC), mbase, np, 4, p0, s, 1, SZ_W2, (size_t)256 * FF * 2, WGM_DOWN};
                      EpiMoeDown E{XR, MODL + 5 * 1024, (const int*)(ws + WS_RSRC), (const float*)(ws + WS_RGATE)};
                      pg8::gemm_phase<EpiMoeDown, SchedMoe, false>(lds, FF, FF, FF, S, E); }
                    GRID_BAR(); } }
        }
    }
    { PH_IDS; final_phase(p, wid, lane); }
#undef GRID_BAR
#undef GRID_BAR_T
#undef BX
#undef VCU
#undef MOD
#undef XR
#undef OUTB
#undef HX
#undef P
#undef H
#undef A2
#undef ZL
#undef GB
#undef MODL
}

extern "C" void kernel_launch(void* const* d_in, const int* in_sizes, int n_in, void* d_out, int out_size, void* d_ws, size_t ws_size, hipStream_t stream) {
    static int ready = 0;
    if (ready == 0) {
        if (n_in != 34 || in_sizes[0] != NB * SEQ * DM || out_size != NB * SEQ * DM || ws_size < WS_END) {
            fprintf(stderr, "kernel_launch: shape/workspace mismatch (n_in %d, x %d, out %d, ws %zu, need %zu); nothing launched\n", n_in, n_in > 0 ? in_sizes[0] : -1, out_size, ws_size, (size_t)WS_END); ready = -1; return; }
        if (hipFuncSetAttribute((const void*)dit_fwd, hipFuncAttributeMaxDynamicSharedMemorySize, LDS_BYTES) != hipSuccess) { fprintf(stderr, "kernel_launch: hipFuncSetAttribute failed\n"); ready = -1; return; }
        int per_cu = 0;
        if (hipOccupancyMaxActiveBlocksPerMultiprocessor(&per_cu, (const void*)dit_fwd, NTHREADS, LDS_BYTES) != hipSuccess || per_cu < 1) fprintf(stderr, "kernel_launch: note: occupancy query reports %d workgroups per CU\n", per_cu);
        (void)hipGetLastError();
        ready = 1;
    }
    if (ready < 0) return;
    if (hipMemsetAsync((char*)d_ws + WS_CTL, 0, CTL_BYTES, stream) != hipSuccess) { fprintf(stderr, "kernel_launch: memset failed\n"); return; }
    Params prm{};
    for (int i = 0; i < 34; ++i) prm.in[i] = (const float*)d_in[i];
    prm.out = (float*)d_out; prm.ws = (unsigned char*)d_ws;
    hipLaunchKernelGGL(dit_fwd, dim3(GRID), dim3(NTHREADS), LDS_BYTES, stream, prm);
    const hipError_t le = hipPeekAtLastError();
    if (le != hipSuccess) fprintf(stderr, "kernel_launch: launch failed: %s\n", hipGetErrorName(le));
}
```

```cpp
#include <hip/hip_runtime.h>
#include <cstdio>
#include <cstdint>

#define GAS __attribute__((address_space(1)))
#define LAS __attribute__((address_space(3)))
typedef unsigned short bf16;
typedef short bf16x8 __attribute__((ext_vector_type(8)));
typedef short s16x4 __attribute__((ext_vector_type(4)));
typedef float f32x2 __attribute__((ext_vector_type(2)));
typedef float f32x4 __attribute__((ext_vector_type(4)));
typedef float f32x8 __attribute__((ext_vector_type(8)));
typedef float f32x16 __attribute__((ext_vector_type(16)));
typedef unsigned u32x2 __attribute__((ext_vector_type(2)));
typedef unsigned u32x4 __attribute__((ext_vector_type(4)));

constexpr int DM = 1024, NB = 16, SEQ = 4096, CTXL = 256, RB = SEQ + CTXL, NR = NB * RB, NLAYER = 4;
constexpr int INW = 2560, PW = 2304, FF = 2816, NEXP = 8;
constexpr int PC_DQ = 0, PC_DK = 512, PC_DV = 1024, PC_NQ = 1536, PC_NK = 1792, PC_NV = 2048;
constexpr int NPANEL = NR / 256, PPB = RB / 256;
constexpr int NR16 = NR / 16;
constexpr int GRID = 256, NWAVES = 8, NTHREADS = 512, NGW = GRID * NWAVES, RPW = NR / NGW;
static_assert(RPW * NGW == NR, "rows per wave");
constexpr int MOE_ROWS = 2 * NR + 4096;
constexpr int HCHUNK_PANELS = 256;

constexpr size_t al4k(size_t x) { return (x + 4095) & ~(size_t)4095; }
constexpr size_t WS_CTL = 0, CTL_BYTES = 1u << 20;
constexpr size_t WS_MOD = WS_CTL + CTL_BYTES;                          constexpr size_t SZ_MOD = (size_t)NLAYER * 17 * 6144 * 4;
constexpr size_t WS_ROPE = al4k(WS_MOD + SZ_MOD);                      constexpr size_t SZ_ROPE = 64 * 16 * 8;
constexpr size_t WS_LAM = al4k(WS_ROPE + SZ_ROPE);                     constexpr size_t SZ_LAM = 4096;
constexpr size_t WS_A16 = al4k(WS_LAM + SZ_LAM);                       constexpr size_t SZ_A16 = (size_t)NLAYER * 2 * 16 * 64 * 16;
constexpr size_t WS_S5W1 = al4k(WS_A16 + SZ_A16);                      constexpr size_t SZ_S5W1 = (size_t)NLAYER * 16 * 256 * 256 * 2;
constexpr size_t WS_S5W2 = al4k(WS_S5W1 + SZ_S5W1);                    constexpr size_t SZ_S5W2 = (size_t)NLAYER * 16 * 256 * 512 * 2;
constexpr size_t WS_WIN = al4k(WS_S5W2 + SZ_S5W2);                     constexpr size_t SZ_WIN = (size_t)NLAYER * INW * DM * 2;
constexpr size_t WS_WOUT = al4k(WS_WIN + SZ_WIN);                      constexpr size_t SZ_WOUT = (size_t)NLAYER * DM * DM * 2;
constexpr size_t WS_WGLU = al4k(WS_WOUT + SZ_WOUT);                    constexpr size_t SZ_WGLU = (size_t)NLAYER * 256 * 256 * 2;
constexpr size_t WS_W13D = al4k(WS_WGLU + SZ_WGLU);                    constexpr size_t SZ_W13 = (size_t)2 * FF * DM * 2;
constexpr size_t WS_W2D = al4k(WS_W13D + 2 * SZ_W13);                  constexpr size_t SZ_W2 = (size_t)DM * FF * 2;
constexpr size_t WS_W13M = al4k(WS_W2D + 2 * SZ_W2);
constexpr size_t WS_W2M = al4k(WS_W13M + 16 * SZ_W13);
constexpr size_t SZ_HX = (size_t)NR * DM * 2;
constexpr size_t WS_XR = al4k(WS_W2M + 16 * SZ_W2);
constexpr size_t WS_P = al4k(WS_XR + SZ_HX);                           constexpr size_t SZ_P = (size_t)NR * PW * 2;
constexpr size_t WS_H = WS_P;                                          constexpr size_t SZ_H = (size_t)HCHUNK_PANELS * 256 * FF * 2;
constexpr size_t SZ_A2 = (size_t)16 * NR16 * 512 * 2, SZ_GBUF = (size_t)NR * 256 * 2;
constexpr size_t WS_ZLOC = al4k(WS_P + SZ_P);                          constexpr size_t SZ_ZLOC = (size_t)16 * NR16 * 256 * 4;
constexpr size_t WS_TOKE = al4k(WS_ZLOC + SZ_ZLOC);                    constexpr size_t SZ_TOKE = (size_t)NR * 4;
constexpr size_t WS_TOKG = al4k(WS_TOKE + SZ_TOKE);                    constexpr size_t SZ_TOKG = (size_t)NR * 8;
constexpr size_t WS_WCNT = al4k(WS_TOKG + SZ_TOKG);                    constexpr size_t SZ_WCNT = (size_t)NGW * 16 * 4;
constexpr size_t WS_MBASE = al4k(WS_WCNT + SZ_WCNT);                   constexpr size_t SZ_MBASE = 4096;
constexpr size_t WS_RSRC = al4k(WS_MBASE + SZ_MBASE);                  constexpr size_t SZ_RSRC = (size_t)MOE_ROWS * 4;
constexpr size_t WS_RGATE = al4k(WS_RSRC + SZ_RSRC);                   constexpr size_t SZ_RGATE = (size_t)MOE_ROWS * 4;
constexpr size_t WS_END = al4k(WS_RGATE + SZ_RGATE);
constexpr size_t OUT_HX = 0, OUT_A2 = OUT_HX + SZ_HX, OUT_GBUF = OUT_A2 + SZ_A2;
static_assert(OUT_GBUF + SZ_GBUF <= (size_t)NB * SEQ * DM * 4 && OUT_A2 % 4096 == 0 && OUT_GBUF % 4096 == 0, "scratch tensors inside d_out");
static_assert(WS_ZLOC == WS_P + SZ_P && SZ_H <= SZ_P + SZ_ZLOC, "hidden chunk overlays P and Zloc (both dead during the FFN)");
static_assert(WS_END <= ((size_t)1 << 30), "workspace map must fit 1 GiB");
constexpr int CW_BAR = 4096;

constexpr int RING_BYTES = 131072;
constexpr int LDSCTL_OFF = RING_BYTES;
constexpr int MISC_OFF = LDSCTL_OFF + 320;
constexpr int LDS_BYTES = 147456;

__device__ __forceinline__ unsigned f2bf(float f) { unsigned u = __builtin_bit_cast(unsigned, f); return (u + 0x7fffu + ((u >> 16) & 1u)) >> 16; }
__device__ __forceinline__ unsigned pk2(float lo, float hi) { return f2bf(lo) | (f2bf(hi) << 16); }
__device__ __forceinline__ float bf2f(unsigned h) { return __builtin_bit_cast(float, h << 16); }
__device__ __forceinline__ unsigned cvt_pk_bf16(float lo, float hi) { unsigned r; asm volatile("v_cvt_pk_bf16_f32 %0, %1, %2" : "=v"(r) : "v"(lo), "v"(hi)); return r; }
template <int X> __device__ __forceinline__ float swz_xor(float v) { return __builtin_bit_cast(float, __builtin_amdgcn_ds_swizzle(__builtin_bit_cast(int, v), (X << 10) | 0x1f)); }
__device__ __forceinline__ float half_sum(float v) {
    v += swz_xor<1>(v); v += swz_xor<2>(v); v += swz_xor<4>(v); v += swz_xor<8>(v); v += swz_xor<16>(v); return v; }
__device__ __forceinline__ float wave_sum(float v) {
    v = half_sum(v);
    auto rr = __builtin_amdgcn_permlane32_swap(__float_as_uint(v), __float_as_uint(v), false, false);
    return __uint_as_float(rr[0]) + __uint_as_float(rr[1]);
}
__device__ __forceinline__ int bx_opaque() { int b = (int)blockIdx.x; asm volatile("" : "+s"(b)); return b; }
extern __shared__ __attribute__((aligned(16))) unsigned char lds_raw[];
constexpr int WTAB_OFF = MISC_OFF + 256;
__device__ __forceinline__ int hw_wave_slot() { return (int)(__builtin_amdgcn_s_getreg((5 << 11) | 4) & 0x3fu); }
__device__ __forceinline__ int tid_opaque() {
    const int w = __builtin_amdgcn_readfirstlane(((volatile LAS int*)((LAS unsigned char*)lds_raw + WTAB_OFF))[hw_wave_slot()]);
    unsigned z = 0u; asm volatile("" : "+s"(z));
    int t = w * 64 + (int)__builtin_amdgcn_mbcnt_hi(~0u, __builtin_amdgcn_mbcnt_lo(~0u, z)); asm volatile("" : "+v"(t)); return t; }
#define LDS_WAIT() asm volatile("s_waitcnt lgkmcnt(0)" ::: "memory")
#define VM_WAIT() asm volatile("s_waitcnt vmcnt(0)" ::: "memory")
__device__ __forceinline__ float fast_exp(float x) { return __builtin_amdgcn_exp2f(x * 1.4426950408889634f); }
__device__ __forceinline__ float sigmoidf_(float x) { return __builtin_amdgcn_rcpf(1.f + fast_exp(-x)); }
__device__ __forceinline__ float siluf_(float x) { return x * sigmoidf_(x); }
__device__ __forceinline__ float gelu_tanh(float x) {
    const float u = 0.7978845608028654f * (x + 0.044715f * x * x * x);
    return x * sigmoidf_(2.f * u);
}

#define XB_TMO      128
#define XB_XCNT(j)  (256  + 64 * (j))
#define XB_XSUB(j)  (1280 + 64 * (j))
#define XB_XGEN(j)  (2304 + 64 * (j))
#define XB_TOP      3328
#define XB_TOPGEN   3392
#define XCD_BAR_WORDS 3456
#define XB_SPIN_CAP (1u << 18)

__device__ __forceinline__ unsigned xb_ld(unsigned* p)              { return __hip_atomic_load(p, __ATOMIC_RELAXED, __HIP_MEMORY_SCOPE_AGENT); }
__device__ __forceinline__ unsigned xb_add(unsigned* p, unsigned v) { return __hip_atomic_fetch_add(p, v, __ATOMIC_RELAXED, __HIP_MEMORY_SCOPE_AGENT); }
__device__ __forceinline__ unsigned xb_xcc_id() { return (unsigned)__builtin_amdgcn_s_getreg((3 << 11) | 20) & 0xFu; }
#define XB_SPIN(cond, bar) do { unsigned _sp = 0; while (cond) { __builtin_amdgcn_s_sleep(1); \
    if ((++_sp & 255u) == 0u) { if (xb_ld(&(bar)[XB_TMO])) break; if (_sp > XB_SPIN_CAP) { atomicAdd(&(bar)[XB_TMO], 1u); break; } } } } while (0)

struct XcdBarrier {
    unsigned* bar; unsigned x;
    volatile LAS unsigned* st;
};
__device__ __forceinline__ XcdBarrier xcd_barrier_post(unsigned* bar, volatile LAS unsigned* st) {
    XcdBarrier b; b.bar = bar; b.x = xb_xcc_id(); b.st = st;
    if (threadIdx.x == 0) (void)xb_add(&bar[XB_XCNT(b.x)], 1u);
    return b;
}
__device__ __forceinline__ void xcd_barrier_complete(unsigned* bar, unsigned x, unsigned& nloc, unsigned& nx) {
    const unsigned G = gridDim.x * gridDim.y * gridDim.z;
    unsigned sum, cnt, mine, sp = 0u;
    for (;;) {
        sum = 0u; cnt = 0u; mine = 0u;
#pragma unroll
        for (unsigned j = 0; j < 16; ++j) { const unsigned c = xb_ld(&bar[XB_XCNT(j)]); sum += c; cnt += (c > 0u) ? 1u : 0u; mine = (j == x) ? c : mine; }
        if (sum == G) break;
        __builtin_amdgcn_s_sleep(1);
        if ((++sp & 255u) == 0u) { if (xb_ld(&bar[XB_TMO])) break; if (sp > XB_SPIN_CAP) { atomicAdd(&bar[XB_TMO], 1u); break; } }
    }
    nloc = mine > 0u ? mine : 1u; nx = cnt > 0u ? cnt : 1u;
}
template <bool FIRST>
__device__ __forceinline__ void xcd_barrier(const XcdBarrier& b) {
    asm volatile("s_waitcnt vmcnt(0)" ::: "memory");
    __syncthreads();
    if (threadIdx.x == 0) {
        unsigned* bar = b.bar;
        __builtin_amdgcn_s_waitcnt(0);
        unsigned nloc = b.st[0], nx = b.st[1];
        if constexpr (FIRST) { if (nloc == 0u) { xcd_barrier_complete(bar, b.x, nloc, nx); b.st[0] = nloc; b.st[1] = nx; } }
        else { nloc = nloc ? nloc : 1u; nx = nx ? nx : 1u; }
        const unsigned old = xb_add(&bar[XB_XSUB(b.x)], 1u);
        const unsigned gen = old / nloc;
        if (old + 1u == (gen + 1u) * nloc) {
            __builtin_amdgcn_fence(__ATOMIC_RELEASE, "agent");
            asm volatile("s_waitcnt vmcnt(0)" ::: "memory");
            const unsigned og = xb_add(&bar[XB_TOP], 1u);
            const unsigned tg = og / nx;
            if (og + 1u == (tg + 1u) * nx) xb_add(&bar[XB_TOPGEN], 1u);
            else XB_SPIN(xb_ld(&bar[XB_TOPGEN]) == tg, bar);
            __builtin_amdgcn_fence(__ATOMIC_ACQUIRE, "agent");
            xb_add(&bar[XB_XGEN(b.x)], 1u);
            asm volatile("s_waitcnt vmcnt(0)" ::: "memory");
        } else {
            XB_SPIN(xb_ld(&bar[XB_XGEN(b.x)]) == gen, bar);
            __builtin_amdgcn_fence(__ATOMIC_ACQUIRE, "agent");
            asm volatile("s_waitcnt vmcnt(0)" ::: "memory");
        }
    }
    __syncthreads();
}

namespace pg8 {
__device__ __forceinline__ void glds16_s(const void* sbase, unsigned voff, unsigned lds_dst) {
    unsigned keep;
    asm volatile("s_mov_b32 %0, m0\n\ts_mov_b32 m0, %3\n\ts_nop 0\n\tglobal_load_lds_dwordx4 %1, %2\n\ts_mov_b32 m0, %0" : "=&s"(keep) : "v"(voff), "s"(sbase), "s"(lds_dst) : "memory");
}
constexpr int BM = 256, BK = 64, HALF = 128, HTB = HALF * BK * 2, STAGE_BYTES = 8 * HTB, NXCD = 8;
__host__ __device__ __forceinline__ int lds_byte(int r, int c) { const int st = (r >> 4) * 2 + (c >> 5), rr = r & 15, cc = c & 31, ob = rr * 64 + cc * 2; return st * 1024 + (ob ^ (((ob >> 9) & 1) << 5)); }
__host__ __device__ __forceinline__ void stage_rc(int b, int& R, int& C) { const int st = b / 1024, sb = b % 1024, swz = sb ^ (((sb >> 9) & 1) << 5); R = (st >> 1) * 16 + swz / 64; C = (st & 1) * 32 + (swz % 64) / 2; }
__host__ __device__ __forceinline__ int perm32(int rho) { const int n = rho >> 4, i = rho & 15; return 8 * (i >> 2) + 4 * n + (i & 3); }

struct GUnit { const char* A; const char* B; int pm, pn, aux; const int* rows; };

__device__ __forceinline__ long deal_index(int i, int G, int c, int late, int xl) { return (i < xl) ? (long)i * G + c : (c < late ? -1L : (long)xl * G + (long)(i - xl) * (G - late) + (c - late)); }
__device__ __forceinline__ bool tile_order(int i, int G, int c, int nM, int nN, int WGM, int& pm, int& pn, int late = 0, int xl = 0x7fffff) {
    const int nwg = nM * nN; const long L = late ? deal_index(i, G, c, late, xl) : (long)i * G + c; if (L < 0 || L >= nwg) return false;
    int wgid = (int)L; { const int q = nwg / NXCD, r = nwg % NXCD, xcd = wgid % NXCD, off = wgid / NXCD; wgid = (xcd < r ? xcd * (q + 1) : r * (q + 1) + (xcd - r) * q) + off; }
    const int nig = WGM * nN, gid = wgid / nig, fm = gid * WGM, gsz = (nM - fm) < WGM ? (nM - fm) : WGM;
    pm = fm + ((wgid % nig) % gsz); pn = (wgid % nig) / gsz; return true;
}

template <class Epi, class Sched, bool GATHER>
__device__ __forceinline__ void gemm_phase(LAS unsigned char* lds, const int K, const int lda, const int ldb, const Sched& S, const Epi& E) {
    const int tid = tid_opaque(), wid = __builtin_amdgcn_readfirstlane(tid >> 6), lane = tid & 63, wr = wid >> 2, wc = wid & 3, fr = lane & 15, fq = lane >> 4;
    int nt = K / BK; asm volatile("" : "+s"(nt));
    int sR[2], sC[2]; unsigned voffB[2];
#pragma unroll
    for (int i = 0; i < 2; ++i) { stage_rc(tid * 16 + i * 8192, sR[i], sC[i]); const int Rb = (sR[i] & ~31) + perm32(sR[i] & 31); voffB[i] = (unsigned)(Rb * ldb + sC[i]) * 2u; }
    const size_t kstep = (size_t)(BK * 2);
    const size_t hstepB = (size_t)HALF * ldb * 2;
    const unsigned ldsb = (unsigned)(uintptr_t)lds + (unsigned)wid * 1024u;
    const int aoff = lds_byte(wr * 64 + fr, fq * 8), boff = lds_byte(wc * 32 + fr, fq * 8);
#define PG8_SA(b, h) (((b) * 2 + (h)) * HTB)
#define PG8_SB(b, h) ((4 + (b) * 2 + (h)) * HTB)
#define PG8_STAGE(bufoff, gbase, voff) do { _Pragma("unroll") for (int _i = 0; _i < 2; ++_i) \
        glds16_s((const void*)(gbase), (voff)[_i], ldsb + (unsigned)((bufoff) + _i * 8192)); } while (0)
#define PG8_LDA(dst, b, h) do { _Pragma("unroll") for (int m = 0; m < 4; ++m) _Pragma("unroll") for (int k = 0; k < 2; ++k) dst[m][k] = *(const LAS bf16x8*)(lds + PG8_SA(b, h) + aoff + m * 2048 + k * 1024); } while (0)
#define PG8_LDB(dst, b, h) do { _Pragma("unroll") for (int n = 0; n < 2; ++n) _Pragma("unroll") for (int k = 0; k < 2; ++k) dst[n][k] = *(const LAS bf16x8*)(lds + PG8_SB(b, h) + boff + n * 2048 + k * 1024); } while (0)
#define PG8_MMA(ai, bj, At, Bt) do { __builtin_amdgcn_s_setprio(1); _Pragma("unroll") for (int m = 0; m < 4; ++m) _Pragma("unroll") for (int n = 0; n < 2; ++n) _Pragma("unroll") for (int k = 0; k < 2; ++k) \
        acc[ai][bj][m][n] = __builtin_amdgcn_mfma_f32_16x16x32_bf16(Bt[n][k], At[m][k], acc[ai][bj][m][n], 0, 0, 0); __builtin_amdgcn_s_setprio(0); } while (0)
#define PG8_WAIT_V(n) asm volatile("s_waitcnt vmcnt(" #n ")" ::: "memory")
#define PG8_WAIT_L(n) asm volatile("s_waitcnt lgkmcnt(" #n ")" ::: "memory")
#define PG8_BAR __builtin_amdgcn_s_barrier()
#define PG8_SCHED __builtin_amdgcn_sched_barrier(0)
#define PG8_AOFF(dst, u) do { _Pragma("unroll") for (int _h = 0; _h < 2; ++_h) _Pragma("unroll") for (int _i = 0; _i < 2; ++_i) { \
        if constexpr (GATHER) { int _r = (u).rows[_h * HALF + sR[_i]]; _r = _r < 0 ? 0 : _r; dst[_h][_i] = (unsigned)(_r * lda + sC[_i]) * 2u; } \
        else dst[_h][_i] = (unsigned)((_h * HALF + sR[_i]) * lda + sC[_i]) * 2u; } } while (0)
    GUnit cur, nxt; int ui = 0;
    if (!S.next(0, cur)) return;
    f32x4 acc[2][2][4][2];
#pragma unroll
    for (int a = 0; a < 2; ++a)
#pragma unroll
        for (int b = 0; b < 2; ++b)
#pragma unroll
            for (int m = 0; m < 4; ++m)
#pragma unroll
                for (int n = 0; n < 2; ++n) acc[a][b][m][n] = (f32x4){0.f, 0.f, 0.f, 0.f};
    bf16x8 At[4][2], B0[2][2], B1[2][2];
    unsigned oC[2][2], oN[2][2];
    PG8_AOFF(oC, cur);
    const char* cA = cur.A; const char* cB = cur.B;
    PG8_STAGE(PG8_SB(0, 0), cB, voffB); PG8_STAGE(PG8_SB(0, 1), cB + hstepB, voffB); PG8_STAGE(PG8_SA(0, 0), cA, oC[0]); PG8_STAGE(PG8_SA(0, 1), cA, oC[1]);
    if (wr == 1) PG8_BAR;
    PG8_WAIT_V(2); PG8_BAR;
    PG8_STAGE(PG8_SB(1, 0), cB + kstep, voffB); PG8_STAGE(PG8_SA(1, 0), cA + kstep, oC[0]); PG8_STAGE(PG8_SB(1, 1), cB + hstepB + kstep, voffB);
    PG8_WAIT_V(6); PG8_BAR;
    for (;;) {
        const bool has_next = S.next(ui + 1, nxt);
        const char* nA = has_next ? nxt.A : cA; const char* nB = has_next ? nxt.B : cB;
        if (has_next) { PG8_AOFF(oN, nxt); } else {
#pragma unroll
            for (int h = 0; h < 2; ++h)
#pragma unroll
                for (int i = 0; i < 2; ++i) oN[h][i] = oC[h][i]; }
        for (int t = 0; t < nt; t += 2) {
            const bool last = (t == nt - 2);
            const char* a1 = cA + (size_t)(t + 1) * kstep;
            const char* a2 = last ? nA : cA + (size_t)(t + 2) * kstep; const char* b2 = last ? nB : cB + (size_t)(t + 2) * kstep;
            const char* a3 = a2 + kstep; const char* b3 = b2 + kstep;
            unsigned o2[2][2];
#pragma unroll
            for (int h = 0; h < 2; ++h)
#pragma unroll
                for (int i = 0; i < 2; ++i) o2[h][i] = last ? oN[h][i] : oC[h][i];
            PG8_LDB(B0, 0, 0); PG8_LDB(B1, 0, 1); PG8_SCHED; PG8_LDA(At, 0, 0); PG8_STAGE(PG8_SA(1, 1), a1, oC[1]);
            PG8_WAIT_V(8); PG8_WAIT_L(0); PG8_BAR; PG8_MMA(0, 0, At, B0); PG8_MMA(0, 1, At, B1); PG8_BAR; PG8_SCHED;
            PG8_LDA(At, 0, 1); PG8_STAGE(PG8_SB(0, 0), b2, voffB); PG8_STAGE(PG8_SB(0, 1), b2 + hstepB, voffB); PG8_STAGE(PG8_SA(0, 0), a2, o2[0]);
            PG8_WAIT_V(8); PG8_WAIT_L(0); PG8_BAR; PG8_MMA(1, 0, At, B0); PG8_MMA(1, 1, At, B1); PG8_BAR; PG8_SCHED;
            PG8_LDB(B0, 1, 0); PG8_LDB(B1, 1, 1); PG8_SCHED; PG8_LDA(At, 1, 0); PG8_STAGE(PG8_SA(0, 1), a2, o2[1]);
            PG8_WAIT_V(8); PG8_WAIT_L(0); PG8_BAR; PG8_MMA(0, 0, At, B0); PG8_MMA(0, 1, At, B1); PG8_BAR; PG8_SCHED;
            PG8_LDA(At, 1, 1); PG8_STAGE(PG8_SB(1, 0), b3, voffB); PG8_STAGE(PG8_SB(1, 1), b3 + hstepB, voffB); PG8_STAGE(PG8_SA(1, 0), a3, o2[0]);
            PG8_WAIT_V(8); PG8_WAIT_L(0); PG8_BAR; PG8_MMA(1, 0, At, B0); PG8_MMA(1, 1, At, B1); PG8_BAR; PG8_SCHED;
        }
        if (wr == 0) PG8_BAR;
        E(acc, cur, wr, wc, fr, fq);
        if (!has_next) break;
#pragma unroll
        for (int a = 0; a < 2; ++a)
#pragma unroll
            for (int b = 0; b < 2; ++b)
#pragma unroll
                for (int m = 0; m < 4; ++m)
#pragma unroll
                    for (int n = 0; n < 2; ++n) acc[a][b][m][n] = (f32x4){0.f, 0.f, 0.f, 0.f};
        cur = nxt; cA = nA; cB = nB; ++ui;
#pragma unroll
        for (int h = 0; h < 2; ++h)
#pragma unroll
            for (int i = 0; i < 2; ++i) oC[h][i] = oN[h][i];
        if (wr == 1) PG8_BAR;
    }
    PG8_WAIT_V(0);
    PG8_BAR;
#undef PG8_SA
#undef PG8_SB
#undef PG8_STAGE
#undef PG8_LDA
#undef PG8_LDB
#undef PG8_MMA
#undef PG8_WAIT_V
#undef PG8_WAIT_L
#undef PG8_BAR
#undef PG8_SCHED
#undef PG8_AOFF
}
}
namespace att {
constexpr float QSCALE = 0.125f * 1.4426950408889634f;
constexpr int SHM_V = 16384, SHM_K = 8192;
constexpr int OFF_V = 0, OFF_K = 4 * SHM_V, OFF_WS = OFF_K + 4 * SHM_K, OFF_RPB = OFF_WS + NWAVES * 64 * 4, RPB_PITCH = 128, ATT_LDS = OFF_RPB + 15 * RPB_PITCH * 4;
#define ATT_KSWZ(row, colB) ((row) * 128 + ((colB) ^ ((((row) >> 1) & 7) << 4)))
#define ATT_SBAR() __builtin_amdgcn_sched_barrier(0)
__device__ __forceinline__ int crow(int r, int hi) { return (r & 3) + 8 * (r >> 2) + 4 * hi; }

__device__ __forceinline__ void firstSM(f32x16& p0, f32x16& p1, float& mhat, f32x16& negm) {
#define ATT_MX3(a, b, c) __builtin_fmaxf(__builtin_fmaxf((a), (b)), (c))
    float a = ATT_MX3(p0[0], p0[1], p1[0]), b = ATT_MX3(p0[2], p0[3], p1[1]); a = ATT_MX3(a, p1[2], p1[3]);
#pragma unroll
    for (int r = 4; r < 16; r += 4) { a = ATT_MX3(a, p0[r], p0[r + 1]); b = ATT_MX3(b, p0[r + 2], p0[r + 3]); a = ATT_MX3(a, p1[r], p1[r + 1]); b = ATT_MX3(b, p1[r + 2], p1[r + 3]); }
#undef ATT_MX3
    float pmax = fmaxf(a, b);
    { auto rr = __builtin_amdgcn_permlane32_swap(__float_as_uint(pmax), __float_as_uint(pmax), false, false);
      pmax = fmaxf(__uint_as_float(rr[0]), __uint_as_float(rr[1])); }
    mhat += pmax;
#pragma unroll
    for (int r = 0; r < 16; ++r) { p0[r] = __builtin_amdgcn_exp2f(p0[r] - pmax); p1[r] = __builtin_amdgcn_exp2f(p1[r] - pmax); negm[r] = -mhat; }
}
__device__ __forceinline__ void sumcvt(const f32x16& p0, const f32x16& p1, float alpha, float& l_reg, bf16x8& pa0, bf16x8& pa1, bf16x8& pa2, bf16x8& pa3) {
    { f32x2 s2 = (f32x2){p0[0], p0[1]} + (f32x2){p1[0], p1[1]};
#pragma unroll
      for (int r = 2; r < 16; r += 2) { s2 += (f32x2){p0[r], p0[r + 1]}; s2 += (f32x2){p1[r], p1[r + 1]}; }
      float ps = s2[0] + s2[1];
      auto rr = __builtin_amdgcn_permlane32_swap(__float_as_uint(ps), __float_as_uint(ps), false, false);
      ps = __uint_as_float(rr[0]) + __uint_as_float(rr[1]);
      l_reg = l_reg * alpha + ps; }
#define ATT_PK4(P, BASE, OUT) do { u32x4 w = {cvt_pk_bf16(P[BASE + 0], P[BASE + 1]), cvt_pk_bf16(P[BASE + 2], P[BASE + 3]), cvt_pk_bf16(P[BASE + 4], P[BASE + 5]), cvt_pk_bf16(P[BASE + 6], P[BASE + 7])}; \
    OUT = __builtin_bit_cast(bf16x8, w); } while (0)
    ATT_PK4(p0, 0, pa0); ATT_PK4(p0, 8, pa1); ATT_PK4(p1, 0, pa2); ATT_PK4(p1, 8, pa3);
#undef ATT_PK4
}
__device__ __forceinline__ void qkt(f32x16& p0, f32x16& p1, const LAS unsigned char* Ks, const bf16x8* qr, const f32x16& negm, int r32, int hi) {
    p0 = negm; p1 = negm;
#pragma unroll
    for (int d0 = 0; d0 < 4; ++d0) { const int cb = (d0 * 16 + hi * 8) * 2;
        const bf16x8 b0 = *(const LAS bf16x8*)(Ks + ATT_KSWZ(r32, cb));
        const bf16x8 b1 = *(const LAS bf16x8*)(Ks + ATT_KSWZ(32 + r32, cb));
        p0 = __builtin_amdgcn_mfma_f32_32x32x16_bf16(b0, qr[d0], p0, 0, 0, 0);
        p1 = __builtin_amdgcn_mfma_f32_32x32x16_bf16(b1, qr[d0], p1, 0, 0, 0); }
}
__device__ __forceinline__ int v_st(int k, int c) { const int kk = k;     return ((kk >> 3) * 4 + (c >> 5)) * 512 + ((kk & 7) * 32 + (c & 31)) * 2; }
__device__ __forceinline__ int v_rd_base(int lane) { return ((lane & 3) << 3) | (((lane >> 2) & 3) << 6) | (((lane >> 4) & 1) << 5) | (((lane >> 5) & 1) << 8); }
constexpr int v_rd_off(int d0, int ks, int half) { return d0 * 512 + ks * 4096 + half * 2048; }
template <int OFF> __device__ __forceinline__ s16x4 tr_read(int vb) {
    s16x4 r; asm volatile("ds_read_b64_tr_b16 %0, %1 offset:%2" : "=&v"(r) : "v"(vb), "i"(OFF) : "memory"); return r;
}
template <int D0> __device__ __forceinline__ void pv_one(f32x16& od, int vb, bf16x8 pa0, bf16x8 pa1, bf16x8 pa2, bf16x8 pa3) {
    const s16x4 l0 = tr_read<v_rd_off(D0, 0, 0)>(vb), h0 = tr_read<v_rd_off(D0, 0, 1)>(vb), l1 = tr_read<v_rd_off(D0, 1, 0)>(vb), h1 = tr_read<v_rd_off(D0, 1, 1)>(vb);
    const s16x4 l2 = tr_read<v_rd_off(D0, 2, 0)>(vb), h2 = tr_read<v_rd_off(D0, 2, 1)>(vb), l3 = tr_read<v_rd_off(D0, 3, 0)>(vb), h3 = tr_read<v_rd_off(D0, 3, 1)>(vb);
    asm volatile("s_waitcnt lgkmcnt(0)" ::: "memory"); ATT_SBAR();
#define ATT_PKV(L, H) (bf16x8){L[0], L[1], L[2], L[3], H[0], H[1], H[2], H[3]}
    od = __builtin_amdgcn_mfma_f32_32x32x16_bf16(pa0, ATT_PKV(l0, h0), od, 0, 0, 0);
    od = __builtin_amdgcn_mfma_f32_32x32x16_bf16(pa1, ATT_PKV(l1, h1), od, 0, 0, 0);
    od = __builtin_amdgcn_mfma_f32_32x32x16_bf16(pa2, ATT_PKV(l2, h2), od, 0, 0, 0);
    od = __builtin_amdgcn_mfma_f32_32x32x16_bf16(pa3, ATT_PKV(l3, h3), od, 0, 0, 0);
#undef ATT_PKV
}
template <int DV> __device__ __forceinline__ void pv_all(f32x16* o, int vb, bf16x8 pa0, bf16x8 pa1, bf16x8 pa2, bf16x8 pa3) {
    pv_one<0>(o[0], vb, pa0, pa1, pa2, pa3); pv_one<1>(o[1], vb, pa0, pa1, pa2, pa3);
    if constexpr (DV == 128) { pv_one<2>(o[2], vb, pa0, pa1, pa2, pa3); pv_one<3>(o[3], vb, pa0, pa1, pa2, pa3); }
}

#define ATT_VADD(acc, x) asm volatile("v_add_f32 %0, %1, %0" : "+v"(acc) : "v"(x))
template <int DV> __device__ __forceinline__ float sum_tail(const f32x16& e1, const float (&sm)[4], float odd);
template <int OFF> __device__ __forceinline__ bf16x8 k_read(int addr) { bf16x8 r; asm volatile("ds_read_b128 %0, %1 offset:%2" : "=&v"(r) : "v"(addr), "i"(OFF) : "memory"); return r; }
template <int G> __device__ __forceinline__ void qk_fill(const f32x16& e0, const f32x16& e1, unsigned (&w)[16], float (&so)[2]) {
    const f32x16& e = (G < 4) ? e0 : e1; constexpr int b = (G & 3) * 4;
    typedef __bf16 bf2_t __attribute__((ext_vector_type(2)));
    w[2 * G] = __builtin_bit_cast(unsigned, __builtin_convertvector((f32x2){e[b], e[b + 1]}, bf2_t)); w[2 * G + 1] = __builtin_bit_cast(unsigned, __builtin_convertvector((f32x2){e[b + 2], e[b + 3]}, bf2_t));
    if constexpr (G == 0) { so[0] = e[b + 1]; so[1] = e[b + 3]; } else { ATT_VADD(so[0], e[b + 1]); ATT_VADD(so[1], e[b + 3]); }
}
#define ATT_KW(n, x) asm volatile("s_waitcnt lgkmcnt(" #n ")" : "+v"(x) :: "memory")
template <int DV, int KOFF, int VB>
__device__ __forceinline__ void qk_sum(f32x16& p0, f32x16& p1, const int (&ka)[4], const bf16x8* qr, const f32x16& negm, const f32x16& e0, const f32x16& e1, const float (&smi)[4], float& l_reg,
                                       bf16x8& pa0, bf16x8& pa1, bf16x8& pa2, bf16x8& pa3, int vb, s16x4 (&f)[8], bf16x8& a0, bf16x8& b0, bf16x8& a1, bf16x8& b1) {
    unsigned w[16]; float so[2];
    ATT_KW(3, a0); asm volatile("v_mfma_f32_32x32x16_bf16 %0, %1, %2, %3" : "=&v"(p0) : "v"(a0), "v"(qr[0]), "v"(negm)); qk_fill<0>(e0, e1, w, so); ATT_SBAR();
    ATT_KW(2, b0); asm volatile("v_mfma_f32_32x32x16_bf16 %0, %1, %2, %3" : "=&v"(p1) : "v"(b0), "v"(qr[0]), "v"(negm));
    a0 = k_read<KOFF>(ka[2]); b0 = k_read<KOFF + 4096>(ka[2]); qk_fill<1>(e0, e1, w, so); ATT_SBAR();
    ATT_KW(3, a1); p0 = __builtin_amdgcn_mfma_f32_32x32x16_bf16(a1, qr[1], p0, 0, 0, 0); qk_fill<2>(e0, e1, w, so); ATT_SBAR();
    ATT_KW(2, b1); p1 = __builtin_amdgcn_mfma_f32_32x32x16_bf16(b1, qr[1], p1, 0, 0, 0);
    a1 = k_read<KOFF>(ka[3]); b1 = k_read<KOFF + 4096>(ka[3]); qk_fill<3>(e0, e1, w, so); ATT_SBAR();
    ATT_KW(3, a0); p0 = __builtin_amdgcn_mfma_f32_32x32x16_bf16(a0, qr[2], p0, 0, 0, 0);
    f[0] = tr_read<VB + v_rd_off(0, 0, 0)>(vb); f[1] = tr_read<VB + v_rd_off(0, 0, 1)>(vb); f[2] = tr_read<VB + v_rd_off(0, 1, 0)>(vb); f[3] = tr_read<VB + v_rd_off(0, 1, 1)>(vb);
    qk_fill<4>(e0, e1, w, so); ATT_SBAR();
    ATT_KW(6, b0); p1 = __builtin_amdgcn_mfma_f32_32x32x16_bf16(b0, qr[2], p1, 0, 0, 0);
    f[4] = tr_read<VB + v_rd_off(0, 2, 0)>(vb); f[5] = tr_read<VB + v_rd_off(0, 2, 1)>(vb); f[6] = tr_read<VB + v_rd_off(0, 3, 0)>(vb); f[7] = tr_read<VB + v_rd_off(0, 3, 1)>(vb);
    qk_fill<5>(e0, e1, w, so); ATT_SBAR();
    ATT_KW(9, a1); p0 = __builtin_amdgcn_mfma_f32_32x32x16_bf16(a1, qr[3], p0, 0, 0, 0); qk_fill<6>(e0, e1, w, so); ATT_SBAR();
    ATT_KW(8, b1); p1 = __builtin_amdgcn_mfma_f32_32x32x16_bf16(b1, qr[3], p1, 0, 0, 0); qk_fill<7>(e0, e1, w, so); ATT_SBAR();
    l_reg += sum_tail<DV>(e1, smi, so[0] + so[1]);
    pa0 = __builtin_bit_cast(bf16x8, (u32x4){w[0], w[1], w[2], w[3]}); pa1 = __builtin_bit_cast(bf16x8, (u32x4){w[4], w[5], w[6], w[7]});
    pa2 = __builtin_bit_cast(bf16x8, (u32x4){w[8], w[9], w[10], w[11]}); pa3 = __builtin_bit_cast(bf16x8, (u32x4){w[12], w[13], w[14], w[15]});
}
template <int DV, int G> __device__ __forceinline__ void pvx_fill(f32x16& q0, f32x16& q1, float (&sm)[4]) {
    constexpr int NG = DV / 8, EPG = 32 / NG;
#define ATT_QV(i) (((i) < 16) ? q0[(i) & 15] : q1[(i) & 15])
#pragma unroll
    for (int e = 0; e < EPG; ++e) { constexpr int i0 = G * EPG; const int i = i0 + e; if (i < 16) q0[i & 15] = __builtin_amdgcn_exp2f(q0[i & 15]); else q1[i & 15] = __builtin_amdgcn_exp2f(q1[i & 15]); }
    if constexpr (G > 0) {
#pragma unroll
        for (int e = 0; e < EPG; e += 2) { const int i = (G - 1) * EPG + e;
            if (i < 4) { sm[(i >> 1) & 1] = ATT_QV(i); asm volatile("" :: "v"(ATT_QV(i + 1))); } else asm volatile("v_add_f32 %0, %1, %0" : "+v"(sm[(i >> 1) & 1]) : "v"(ATT_QV(i)), "v"(ATT_QV(i + 1))); } }
#undef ATT_QV
}
template <int DV, int D0, int VB, bool NOWAIT = false> __device__ __forceinline__ void pvx_grp(f32x16& od, int vb, bf16x8 pa0, bf16x8 pa1, bf16x8 pa2, bf16x8 pa3, s16x4 (&f)[8], f32x16& q0, f32x16& q1, float (&sm)[4]) {
    constexpr int ND = DV / 32; constexpr bool NX = (D0 + 1 < ND);
#define ATT_PKV(L, H) (bf16x8){L[0], L[1], L[2], L[3], H[0], H[1], H[2], H[3]}
#define ATT_PVGAP(KS, PA, WNX, WLAST) do { \
    if constexpr (NOWAIT) { } else if constexpr (NX) asm volatile("s_waitcnt lgkmcnt(" #WNX ")" : "+v"(f[2 * KS]), "+v"(f[2 * KS + 1]) :: "memory"); else asm volatile("s_waitcnt lgkmcnt(" #WLAST ")" : "+v"(f[2 * KS]), "+v"(f[2 * KS + 1]) :: "memory"); \
    od = __builtin_amdgcn_mfma_f32_32x32x16_bf16(PA, ATT_PKV(f[2 * KS], f[2 * KS + 1]), od, 0, 0, 0); \
    if constexpr (NX) { f[2 * KS] = tr_read<VB + v_rd_off(NX ? D0 + 1 : 0, KS, 0)>(vb); f[2 * KS + 1] = tr_read<VB + v_rd_off(NX ? D0 + 1 : 0, KS, 1)>(vb); } \
    pvx_fill<DV, D0 * 4 + KS>(q0, q1, sm); ATT_SBAR(); } while (0)
    ATT_PVGAP(0, pa0, 6, 6); ATT_PVGAP(1, pa1, 6, 4); ATT_PVGAP(2, pa2, 6, 2); ATT_PVGAP(3, pa3, 6, 0);
#undef ATT_PVGAP
#undef ATT_PKV
}
template <int DV, int VB> __device__ __forceinline__ void pv_head(f32x16* o, int vb, bf16x8 pa0, bf16x8 pa1, bf16x8 pa2, bf16x8 pa3, s16x4 (&f)[8], f32x16& q0, f32x16& q1, float (&sm)[4]) {
    ATT_SBAR();
    pvx_grp<DV, 0, VB>(o[0], vb, pa0, pa1, pa2, pa3, f, q0, q1, sm);
    if constexpr (DV == 128) { pvx_grp<DV, 1, VB>(o[1], vb, pa0, pa1, pa2, pa3, f, q0, q1, sm); pvx_grp<DV, 2, VB>(o[2], vb, pa0, pa1, pa2, pa3, f, q0, q1, sm); }
}
template <int DV, int VB> __device__ __forceinline__ void pv_tail(f32x16* o, int vb, bf16x8 pa0, bf16x8 pa1, bf16x8 pa2, bf16x8 pa3, s16x4 (&f)[8], f32x16& q0, f32x16& q1, float (&sm)[4]) {
    ATT_SBAR();
    pvx_grp<DV, DV / 32 - 1, VB, true>(o[DV / 32 - 1], vb, pa0, pa1, pa2, pa3, f, q0, q1, sm);
}
template <int DV> __device__ __forceinline__ float sum_tail(const f32x16& e1, const float (&sm)[4], float odd) {
    float ps;
    if constexpr (DV == 128) ps = ((sm[0] + sm[1]) + e1[14]) + odd;
    else ps = ((sm[0] + e1[12]) + (sm[1] + e1[14])) + odd;
    auto rr = __builtin_amdgcn_permlane32_swap(__float_as_uint(ps), __float_as_uint(ps), false, false);
    return __uint_as_float(rr[0]) + __uint_as_float(rr[1]);
}
__device__ __forceinline__ unsigned na_colmask(int cq, int hi) {
    const int cst = min(max(cq - 8, 0), 48); unsigned m = 0u;
#pragma unroll
    for (int r = 0; r < 16; ++r) { const int kc = crow(r, hi); if (!((unsigned)(kc - cst) < 16u)) m |= 1u << r; if (!((unsigned)(kc + 32 - cst) < 16u)) m |= 1u << (16 + r); }
    return m;
}
__device__ __forceinline__ void na_mask(f32x16& p0, f32x16& p1, int krow, int qrow, int cq, int hi, unsigned cmi, const LAS float* tbl) {
    const int start = min(max(qrow - 4, 0), 56);
    if ((krow >= start) && (krow < start + 8)) {
        const LAS float* tb = tbl + (krow - qrow + 7) * RPB_PITCH + (63 - cq + 4 * hi);
#pragma unroll
        for (int r = 0; r < 16; ++r) { const int cr = (r & 3) + 8 * (r >> 2);
            const float pen0 = __uint_as_float((unsigned)__builtin_amdgcn_sbfe(cmi, r, 1) & 0xF149F2CAu), pen1 = __uint_as_float((unsigned)__builtin_amdgcn_sbfe(cmi, 16 + r, 1) & 0xF149F2CAu);
            p0[r] = (p0[r] + tb[cr]) + pen0; p1[r] = (p1[r] + tb[cr + 32]) + pen1; }
    } else {
#pragma unroll
        for (int r = 0; r < 16; ++r) { p0[r] = -1e30f; p1[r] = -1e30f; }
    }
}

template <int DV, int MODE>
__device__ __forceinline__ void attn_body(const bf16* __restrict__ Qp, const bf16* __restrict__ Kp, const bf16* __restrict__ Vp, int baseA, int nA, int baseB, int NT,
                                          LAS unsigned char* lds, f32x16 (&o)[DV / 32], int qrow, int kmin, unsigned long long* dbg = nullptr, const bf16* KpN = nullptr, const bf16* VpN = nullptr, bool pre_in = false) {
    const int tid = tid_opaque(), wid = __builtin_amdgcn_readfirstlane(tid >> 6), lane = tid & 63, r32 = lane & 31, hi = lane >> 5;
    LAS unsigned char* V_lds = lds + OFF_V; LAS unsigned char* K_lds = lds + OFF_K;
    LAS float* al_l = (LAS float*)(lds + OFF_WS) + wid * 64; LAS float* li_l = al_l + 32;
    const LAS float* tbl = (const LAS float*)(lds + OFF_RPB);
    const int cq = (wid & 1) * 32 + r32; const unsigned cmi = (MODE == 1) ? na_colmask(cq, hi) : 0u;
    float mhat = 0.f, l_reg = 0.f; f32x16 negm = f32x16{}; bf16x8 qr[4];
#pragma unroll
    for (int d = 0; d < DV / 32; ++d) o[d] = f32x16{};
    { const bf16* Qw = Qp + (size_t)(wid * 32 + r32) * PW + hi * 8;
#pragma unroll
      for (int d0 = 0; d0 < 4; ++d0) qr[d0] = *(const bf16x8*)(Qw + d0 * 16); }
    const int kr = tid >> 3;
    const unsigned voffK = (unsigned)(kr * PW + (((tid & 7) ^ ((kr >> 1) & 7)) * 8)) * 2u;
    const unsigned voffV = (DV == 128) ? (unsigned)((8 * (wid >> 1) + ((lane & 31) >> 2)) * PW + (2 * (wid & 1) + (lane >> 5)) * 32 + (lane & 3) * 8) * 2u
                                       : (unsigned)((8 * wid + ((lane & 31) >> 2)) * PW + (lane >> 5) * 32 + (lane & 3) * 8) * 2u;
    const unsigned ldsK = (unsigned)(uintptr_t)K_lds + (unsigned)wid * 1024u, ldsV = (unsigned)(uintptr_t)V_lds + (unsigned)wid * ((DV == 128) ? 1024u : 2048u);
    const int vb0 = (int)(unsigned)(uintptr_t)V_lds + v_rd_base(lane);
#define ATT_TROW(t) ((t) < nA ? baseA + 64 * (t) : baseB + 64 * ((t) - nA))
#define ATT_DMAV(vb, t) do { const char* vs_ = (const char*)(Vp + (size_t)ATT_TROW(t) * PW); pg8::glds16_s(vs_, voffV, ldsV + (vb) * SHM_V); \
    if constexpr (DV == 128) pg8::glds16_s(vs_ + (size_t)32 * PW * 2, voffV, ldsV + (vb) * SHM_V + 8192); } while (0)
#define ATT_DMAK(kb, t) do { pg8::glds16_s((const char*)(Kp + (size_t)ATT_TROW(t) * PW), voffK, ldsK + (kb) * SHM_K); } while (0)
#define ATT_SLOT_END() do { asm volatile("s_waitcnt vmcnt(0)" ::: "memory"); asm volatile("s_waitcnt lgkmcnt(0)" ::: "memory"); __builtin_amdgcn_s_barrier(); ATT_SBAR(); } while (0)
#define ATT_MASK(P0, P1, t) do { if constexpr (MODE == 1) { if ((t) >= nA) na_mask(P0, P1, kmin + (t) - nA, qrow, cq, hi, cmi, tbl); } } while (0)
    f32x16 pA0, pA1, pB0, pB1; bf16x8 pa0, pa1, pa2, pa3, ka0, kb0, ka1, kb1; s16x4 vf[8]; float sm[4];
    int ka[4];
#pragma unroll
    for (int d0 = 0; d0 < 4; ++d0) ka[d0] = (int)(unsigned)(uintptr_t)K_lds + ATT_KSWZ(r32, (d0 * 16 + hi * 8) * 2);
#define ATT_KPRE(KOFF) do { ka0 = k_read<KOFF>(ka[0]); kb0 = k_read<KOFF + 4096>(ka[0]); ka1 = k_read<KOFF>(ka[1]); kb1 = k_read<KOFF + 4096>(ka[1]); } while (0)
    __syncthreads();
    if (!pre_in) { ATT_DMAK(0, 0); ATT_DMAK(1, 1); ATT_DMAV(0, 0); }
    ATT_SLOT_END();
    if (!pre_in) { ATT_DMAK(2, 2); ATT_DMAK(3, 3); ATT_DMAV(1, 1); ATT_DMAV(2, 2); }
    qkt(pA0, pA1, K_lds, qr, negm, r32, hi); ATT_MASK(pA0, pA1, 0); firstSM(pA0, pA1, mhat, negm);
    { constexpr int NL = (DV == 128) ? 14 : 12; float t0 = 0.f, t1 = 0.f;
#pragma unroll
      for (int r = 0; r < 16; r += 4) { t0 += pA0[r]; t1 += pA0[r + 2]; }
#pragma unroll
      for (int r = 0; r < NL; r += 2) { if (r & 2) t1 += pA1[r]; else t0 += pA1[r]; }
      sm[0] = t0; sm[1] = t1; sm[2] = 0.f; sm[3] = 0.f; }
    ATT_KPRE(SHM_K); ATT_SBAR();
    qk_sum<DV, SHM_K, 0>(pB0, pB1, ka, qr, negm, pA0, pA1, sm, l_reg, pa0, pa1, pa2, pa3, vb0, vf, ka0, kb0, ka1, kb1); ATT_MASK(pB0, pB1, 1);
#ifdef ATT_PROBE
    const unsigned long long tc0 = __builtin_amdgcn_s_memtime();
#endif
#define ATT_STEP_BAR(VH, KQ, VN, QE0, QE1, QN0, QN1, tq, DMAS) do { \
        pv_head<DV, (VH) * SHM_V>(o, vb0, pa0, pa1, pa2, pa3, vf, QE0, QE1, sm); \
        ATT_SLOT_END(); ATT_KPRE((KQ) * SHM_K); ATT_SBAR(); \
        pv_tail<DV, (VH) * SHM_V>(o, vb0, pa0, pa1, pa2, pa3, vf, QE0, QE1, sm); DMAS; ATT_SBAR(); \
        qk_sum<DV, (KQ) * SHM_K, (VN) * SHM_V>(QN0, QN1, ka, qr, negm, QE0, QE1, sm, l_reg, pa0, pa1, pa2, pa3, vb0, vf, ka0, kb0, ka1, kb1); ATT_MASK(QN0, QN1, tq); } while (0)
#define ATT_STEP_NOBAR(VH, KQ, VN, QE0, QE1, QN0, QN1, tq, DMAS) do { \
        pv_head<DV, (VH) * SHM_V>(o, vb0, pa0, pa1, pa2, pa3, vf, QE0, QE1, sm); \
        ATT_KPRE((KQ) * SHM_K); asm volatile("s_waitcnt lgkmcnt(4)" ::: "memory"); ATT_SBAR();     \
        pv_tail<DV, (VH) * SHM_V>(o, vb0, pa0, pa1, pa2, pa3, vf, QE0, QE1, sm); DMAS; ATT_SBAR(); \
        qk_sum<DV, (KQ) * SHM_K, (VN) * SHM_V>(QN0, QN1, ka, qr, negm, QE0, QE1, sm, l_reg, pa0, pa1, pa2, pa3, vb0, vf, ka0, kb0, ka1, kb1); ATT_MASK(QN0, QN1, tq); } while (0)
    int t = 0;
    for (; t + 4 < NT; t += 4) {
        ATT_STEP_BAR(0, 2, 1, pB0, pB1, pA0, pA1, t + 2, { ATT_DMAV(3, t + 3); ATT_DMAK(0, t + 4); });
        ATT_STEP_NOBAR(1, 3, 2, pA0, pA1, pB0, pB1, t + 3, { ATT_DMAV(0, t + 4); ATT_DMAK(1, t + 5); });
        ATT_STEP_BAR(2, 0, 3, pB0, pB1, pA0, pA1, t + 4, { ATT_DMAV(1, t + 5); ATT_DMAK(2, t + 6); });
        ATT_STEP_NOBAR(3, 1, 0, pA0, pA1, pB0, pB1, t + 5, { ATT_DMAV(2, t + 6); ATT_DMAK(3, t + 7); });
    }
#ifdef ATT_PROBE
    if (DV == 128 && dbg && lane == 0 && wid == 0) { atomicAdd(dbg + 0, __builtin_amdgcn_s_memtime() - tc0); atomicAdd(dbg + 1, (unsigned long long)(NT - 4)); }
#endif
    ATT_STEP_BAR(0, 2, 1, pB0, pB1, pA0, pA1, t + 2, { ATT_DMAV(3, t + 3); });
    ATT_STEP_NOBAR(1, 3, 2, pA0, pA1, pB0, pB1, t + 3, { });
    pv_head<DV, 2 * SHM_V>(o, vb0, pa0, pa1, pa2, pa3, vf, pB0, pB1, sm);
    ATT_SLOT_END(); ATT_SBAR();
    if (KpN) {
#define ATT_DMAVN(vb, t) do { const char* vs_ = (const char*)(VpN + (size_t)ATT_TROW(t) * PW); pg8::glds16_s(vs_, voffV, ldsV + (vb) * SHM_V); \
    if constexpr (DV == 128) pg8::glds16_s(vs_ + (size_t)32 * PW * 2, voffV, ldsV + (vb) * SHM_V + 8192); } while (0)
#define ATT_DMAKN(kb, t) do { pg8::glds16_s((const char*)(KpN + (size_t)ATT_TROW(t) * PW), voffK, ldsK + (kb) * SHM_K); } while (0)
        ATT_DMAKN(0, 0); ATT_DMAKN(1, 1); ATT_DMAVN(0, 0); ATT_DMAKN(2, 2); ATT_DMAKN(3, 3); ATT_DMAVN(1, 1); ATT_DMAVN(2, 2); ATT_SBAR();
#undef ATT_DMAVN
#undef ATT_DMAKN
    }
    pv_tail<DV, 2 * SHM_V>(o, vb0, pa0, pa1, pa2, pa3, vf, pB0, pB1, sm);
    { float od = 0.f;
#pragma unroll
      for (int r = 1; r < 16; r += 2) od += pB0[r] + pB1[r];
      l_reg += sum_tail<DV>(pB1, sm, od); }
    { float dummy = 0.f; sumcvt(pB0, pB1, 1.f, dummy, pa0, pa1, pa2, pa3); } ATT_SBAR();
    pv_all<DV>(o, vb0 + 3 * SHM_V, pa0, pa1, pa2, pa3);
#undef ATT_STEP_BAR
#undef ATT_STEP_NOBAR
#undef ATT_KPRE
    if (hi == 0) li_l[r32] = l_reg; asm volatile("s_waitcnt lgkmcnt(0)" ::: "memory");
#pragma unroll
    for (int r = 0; r < 16; ++r) { const float rl = __builtin_amdgcn_rcpf(li_l[crow(r, hi)]);
#pragma unroll
        for (int d = 0; d < DV / 32; ++d) o[d][r] *= rl; }
#undef ATT_TROW
#undef ATT_DMAV
#undef ATT_DMAK
#undef ATT_SLOT_END
#undef ATT_MASK
}
}
struct Params { const float* in[34]; float* out; unsigned char* ws; };
#define CAS __attribute__((address_space(4)))
struct KA { const CAS unsigned char* k;
    __device__ __forceinline__ const float* in(int i) const { return *(const float* const CAS*)(k + 8 * i); }
    __device__ __forceinline__ float* out() const { return *(float* const CAS*)(k + 8 * 34); }
    __device__ __forceinline__ unsigned char* ws() const { return *(unsigned char* const CAS*)(k + 8 * 35); } };
enum { I_X = 0, I_C, I_CTX, I_CCTX, I_WMOD, I_BMOD, I_GMIX, I_GFFN, I_WIN, I_WOUT, I_LAMRE, I_LAMIM, I_BRE, I_BIM, I_CRE, I_CIM, I_LOGSTEP, I_SSMD, I_WGLU, I_BGLU,
       I_LQ1, I_LK1, I_LQ2, I_LK2, I_SUBLN, I_RPB, I_FW1, I_FW3, I_FW2, I_ROUTER, I_MW1, I_MW3, I_MW2, I_GFINAL };

__device__ __forceinline__ size_t res_off(int r, bool& is_ctx) { const int b = r / RB, n = r - b * RB; is_ctx = n >= SEQ; return is_ctx ? ((size_t)b * CTXL + (n - SEQ)) * DM : ((size_t)b * SEQ + n) * DM; }

using pg8::GUnit;
#define EPI_ROWS_COLS const int row0 = wr * 64 + fr, col0 = wc * 32 + 8 * fq
__device__ __forceinline__ u32x4 pack8(f32x4 a, f32x4 b) { u32x4 w; w.x = cvt_pk_bf16(a[0], a[1]); w.y = cvt_pk_bf16(a[2], a[3]); w.z = cvt_pk_bf16(b[0], b[1]); w.w = cvt_pk_bf16(b[2], b[3]); return w; }

struct EpiInProj {
    bf16* P; bf16* A2; const float* rope;
    __device__ __forceinline__ void operator()(const f32x4 (&acc)[2][2][4][2], const GUnit& u, int wr, int wc, int fr, int fq) const {
        EPI_ROWS_COLS; const int pl = u.pm % PPB; const bool lat = pl < 16;
        if (u.pn == 0) {
#pragma unroll
            for (int ai = 0; ai < 2; ++ai)
#pragma unroll
                for (int m = 0; m < 4; ++m) { const int r = u.pm * 256 + ai * 128 + row0 + m * 16;
#pragma unroll
                    for (int bj = 0; bj < 2; ++bj) { const int c = bj * 128 + col0, g = c >> 4, h0 = c & 15;
                        *(u32x4*)(A2 + ((size_t)g * NR16 + (r >> 4)) * 512 + 256 + (r & 15) * 16 + h0) = pack8(acc[ai][bj][m][0], acc[ai][bj][m][1]); } }
        } else {
            const bool rope_on = lat && u.pn <= 4; const int pcol0 = u.pn * 256 - 256;
            const float qs = (u.pn <= 2 || u.pn == 7) ? att::QSCALE : 1.f;
#pragma unroll
            for (int ai = 0; ai < 2; ++ai)
#pragma unroll
                for (int m = 0; m < 4; ++m) { const int rl = ai * 128 + row0 + m * 16, r = u.pm * 256 + rl, t = pl * 256 + rl;
#pragma unroll
                    for (int bj = 0; bj < 2; ++bj) { const int c = bj * 128 + col0; f32x4 v0 = acc[ai][bj][m][0] * qs, v1 = acc[ai][bj][m][1] * qs;
                        if (rope_on) { const int i0 = (c & 63) >> 1, axis = i0 >> 4, k0 = i0 & 15, pos = axis ? (t & 63) : (t >> 6);
                            const f32x4 cs0 = *(const f32x4*)(rope + (pos * 16 + k0) * 2), cs1 = *(const f32x4*)(rope + (pos * 16 + k0) * 2 + 4);
                            f32x4 w0, w1;
                            w0[0] = v0[0] * cs0[0] - v0[1] * cs0[1]; w0[1] = v0[0] * cs0[1] + v0[1] * cs0[0];
                            w0[2] = v0[2] * cs0[2] - v0[3] * cs0[3]; w0[3] = v0[2] * cs0[3] + v0[3] * cs0[2];
                            w1[0] = v1[0] * cs1[0] - v1[1] * cs1[1]; w1[1] = v1[0] * cs1[1] + v1[1] * cs1[0];
                            w1[2] = v1[2] * cs1[2] - v1[3] * cs1[3]; w1[3] = v1[2] * cs1[3] + v1[3] * cs1[2];
                            v0 = w0; v1 = w1; }
                        *(u32x4*)(P + (size_t)r * PW + pcol0 + c) = pack8(v0, v1); } }
        }
    }
};
struct EpiZ {
    float* Z;
    __device__ __forceinline__ void operator()(const f32x4 (&acc)[2][2][4][2], const GUnit& u, int wr, int wc, int fr, int fq) const {
        EPI_ROWS_COLS;
#pragma unroll
        for (int ai = 0; ai < 2; ++ai)
#pragma unroll
            for (int m = 0; m < 4; ++m) { float* rp = Z + ((size_t)u.aux * NR16 + u.pm * 256 + ai * 128 + row0 + m * 16) * 256;
#pragma unroll
                for (int bj = 0; bj < 2; ++bj) { *(f32x4*)(rp + bj * 128 + col0) = acc[ai][bj][m][0]; *(f32x4*)(rp + bj * 128 + col0 + 4) = acc[ai][bj][m][1]; } }
    }
};
struct EpiY {
    bf16* G;
    __device__ __forceinline__ void operator()(const f32x4 (&acc)[2][2][4][2], const GUnit& u, int wr, int wc, int fr, int fq) const {
        EPI_ROWS_COLS;
#pragma unroll
        for (int ai = 0; ai < 2; ++ai)
#pragma unroll
            for (int m = 0; m < 4; ++m) { const int r16 = u.pm * 256 + ai * 128 + row0 + m * 16;
#pragma unroll
                for (int bj = 0; bj < 2; ++bj) { const int c = bj * 128 + col0, i = c >> 4, h0 = c & 15; f32x4 v0 = acc[ai][bj][m][0], v1 = acc[ai][bj][m][1];
#pragma unroll
                    for (int k = 0; k < 4; ++k) { v0[k] = gelu_tanh(v0[k]); v1[k] = gelu_tanh(v1[k]); }
                    *(u32x4*)(G + ((size_t)r16 * 16 + i) * 256 + u.aux * 16 + h0) = pack8(v0, v1); } }
    }
};
struct EpiGlu {
    const bf16* G; bf16* Y; const float* bglu;
    __device__ __forceinline__ void operator()(const f32x4 (&acc)[2][2][4][2], const GUnit& u, int wr, int wc, int fr, int fq) const {
        EPI_ROWS_COLS;
#pragma unroll
        for (int bj = 0; bj < 2; ++bj) { const int c = bj * 128 + col0; const f32x4 b0 = *(const f32x4*)(bglu + c), b1 = *(const f32x4*)(bglu + c + 4);
#pragma unroll
            for (int ai = 0; ai < 2; ++ai)
#pragma unroll
                for (int m = 0; m < 4; ++m) { const size_t r = (size_t)u.pm * 256 + ai * 128 + row0 + m * 16;
                    const u32x4 gw = *(const u32x4*)(G + r * 256 + c); f32x4 v0 = acc[ai][bj][m][0] + b0, v1 = acc[ai][bj][m][1] + b1;
                    v0[0] = bf2f(gw.x & 0xffffu) * sigmoidf_(v0[0]); v0[1] = bf2f(gw.x >> 16) * sigmoidf_(v0[1]); v0[2] = bf2f(gw.y & 0xffffu) * sigmoidf_(v0[2]); v0[3] = bf2f(gw.y >> 16) * sigmoidf_(v0[3]);
                    v1[0] = bf2f(gw.z & 0xffffu) * sigmoidf_(v1[0]); v1[1] = bf2f(gw.z >> 16) * sigmoidf_(v1[1]); v1[2] = bf2f(gw.w & 0xffffu) * sigmoidf_(v1[2]); v1[3] = bf2f(gw.w >> 16) * sigmoidf_(v1[3]);
                    *(u32x4*)(Y + r * DM + c) = pack8(v0, v1); } }
    }
};
template <bool F32SRC>
struct EpiRes {
    const float* srcL; const float* srcC; bf16* XR; const float* gate;
    __device__ __forceinline__ void operator()(const f32x4 (&acc)[2][2][4][2], const GUnit& u, int wr, int wc, int fr, int fq) const {
        EPI_ROWS_COLS; const int b = u.pm / PPB, pl = u.pm - b * PPB; const bool isc = pl >= 16;
        const float* src = isc ? srcC + (size_t)b * CTXL * DM : srcL + ((size_t)b * SEQ + pl * 256) * DM; bf16* dst = XR + (size_t)u.pm * 256 * DM; const float* gv = gate + (isc ? 16 : b) * 6144;
        if constexpr (F32SRC) {
#pragma unroll
            for (int bj = 0; bj < 2; ++bj) { const int c = u.pn * 256 + bj * 128 + col0; const f32x4 g0 = *(const f32x4*)(gv + c), g1 = *(const f32x4*)(gv + c + 4);
#pragma unroll
                for (int ai = 0; ai < 2; ++ai)
#pragma unroll
                    for (int m = 0; m < 4; ++m) { const size_t o = (size_t)(ai * 128 + row0 + m * 16) * DM + c; const f32x4 x0 = *(const f32x4*)(src + o), x1 = *(const f32x4*)(src + o + 4);
                        *(u32x4*)(dst + o) = pack8(x0 + g0 * acc[ai][bj][m][0], x1 + g1 * acc[ai][bj][m][1]); } }
        } else {
            u32x4 xw[2][2][4];
#pragma unroll
            for (int bj = 0; bj < 2; ++bj)
#pragma unroll
                for (int ai = 0; ai < 2; ++ai)
#pragma unroll
                    for (int m = 0; m < 4; ++m) xw[bj][ai][m] = *(const u32x4*)(dst + (size_t)(ai * 128 + row0 + m * 16) * DM + u.pn * 256 + bj * 128 + col0);
#pragma unroll
            for (int bj = 0; bj < 2; ++bj) { const int c = u.pn * 256 + bj * 128 + col0; const f32x4 g0 = *(const f32x4*)(gv + c), g1 = *(const f32x4*)(gv + c + 4);
#pragma unroll
                for (int ai = 0; ai < 2; ++ai)
#pragma unroll
                    for (int m = 0; m < 4; ++m) { const size_t o = (size_t)(ai * 128 + row0 + m * 16) * DM + c; const u32x4 w = xw[bj][ai][m];
                        const f32x4 x0 = {bf2f(w.x & 0xffffu), bf2f(w.x >> 16), bf2f(w.y & 0xffffu), bf2f(w.y >> 16)}, x1 = {bf2f(w.z & 0xffffu), bf2f(w.z >> 16), bf2f(w.w & 0xffffu), bf2f(w.w >> 16)};
                        *(u32x4*)(dst + o) = pack8(x0 + g0 * acc[ai][bj][m][0], x1 + g1 * acc[ai][bj][m][1]); } }
        }
    }
};
struct EpiSwi {
    bf16* H;
    __device__ __forceinline__ void operator()(const f32x4 (&acc)[2][2][4][2], const GUnit& u, int wr, int wc, int fr, int fq) const {
        EPI_ROWS_COLS; const int c = u.pn * 128 + col0;
#pragma unroll
        for (int ai = 0; ai < 2; ++ai)
#pragma unroll
            for (int m = 0; m < 4; ++m) { const size_t r = (size_t)u.aux * 256 + ai * 128 + row0 + m * 16; f32x4 v[2];
#pragma unroll
                for (int n = 0; n < 2; ++n) { const f32x4 g = acc[ai][0][m][n], up = acc[ai][1][m][n];
                    const f32x4 e = {__builtin_amdgcn_exp2f(g[0]), __builtin_amdgcn_exp2f(g[1]), __builtin_amdgcn_exp2f(g[2]), __builtin_amdgcn_exp2f(g[3])};
                    const f32x4 d = e + 1.f; const f32x4 rr = {__builtin_amdgcn_rcpf(d[0]), __builtin_amdgcn_rcpf(d[1]), __builtin_amdgcn_rcpf(d[2]), __builtin_amdgcn_rcpf(d[3])};
                    v[n] = (g * up) * rr; }
                *(u32x4*)(H + r * FF + c) = pack8(v[0], v[1]); }
    }
};
struct EpiMoeDown {
    bf16* XR; const float* gate; const int* rsrc; const float* rgate;
    __device__ __forceinline__ void operator()(const f32x4 (&acc)[2][2][4][2], const GUnit& u, int wr, int wc, int fr, int fq) const {
        EPI_ROWS_COLS;
#pragma unroll
        for (int ai = 0; ai < 2; ++ai)
#pragma unroll
            for (int m = 0; m < 4; ++m) { const int pos = u.aux + ai * 128 + row0 + m * 16; const int tok = rsrc[pos];
                if (tok >= 0) { const float rg = rgate[pos]; const int b = tok / RB; const bool isc = (tok - b * RB) >= SEQ; bf16* dst = XR + (size_t)tok * DM; const float* gv = gate + (isc ? 16 : b) * 6144;
#pragma unroll
                    for (int bj = 0; bj < 2; ++bj) { const int c = u.pn * 256 + bj * 128 + col0;
                        const f32x4 g0 = *(const f32x4*)(gv + c) * rg, g1 = *(const f32x4*)(gv + c + 4) * rg; const u32x4 w = *(const u32x4*)(dst + c);
                        const f32x4 x0 = {bf2f(w.x & 0xffffu), bf2f(w.x >> 16), bf2f(w.y & 0xffffu), bf2f(w.y >> 16)}, x1 = {bf2f(w.z & 0xffffu), bf2f(w.z >> 16), bf2f(w.w & 0xffffu), bf2f(w.w >> 16)};
                        *(u32x4*)(dst + c) = pack8(x0 + g0 * acc[ai][bj][m][0], x1 + g1 * acc[ai][bj][m][1]); } } }
    }
};

struct SchedRows {
    const char* A; const char* B; size_t a_tile, b_tile; int nM, nN, pm0, a_local, wgm, lat_only, late = 0, xl = 0;
    __device__ __forceinline__ bool next(int i, GUnit& u) const { int pm, pn; if (!pg8::tile_order(i, GRID, bx_opaque(), nM, nN, wgm, pm, pn, late, xl)) return false;
        u.pm = lat_only ? pm + (pm >> 4) : pm0 + pm; u.pn = pn; u.aux = pm; u.rows = nullptr; u.A = A + (size_t)(a_local ? pm : u.pm) * a_tile; u.B = B + (size_t)pn * b_tile; return true; }
};
struct SchedS5 {
    const char* A; const char* B; size_t b_group; int mix = 0;
    __device__ __forceinline__ bool next(int i, GUnit& u) const { int L;
        if (!mix) L = i * GRID + bx_opaque();
        else { const int bx = bx_opaque(), vcu = (bx & 7) * (GRID / 8) + (bx >> 3), q = vcu & 31, gr = vcu >> 5;
            if ((unsigned)(q - 2) < 8u) return false;
            if ((unsigned)(q - 10) < 8u) { if (i > 0) return false; L = 208 + gr * 8 + (q - 10); }
            else { const int k = gr * 16 + (q < 2 ? q : q - 16); if (i > 1) return false; L = i * 128 + k; if (i == 1 && L >= 208) return false; } }
        if (L >= 17 * 16) return false;
        const int g = L & 15, pm = L >> 4; u.pm = pm; u.pn = 0; u.aux = g; u.rows = nullptr;
        u.A = A + ((size_t)g * NR16 + (size_t)pm * 256) * 512 * 2; u.B = B + (size_t)g * b_group; return true; }
};
struct SchedMoe {
    const char* A; const char* B; const int* rsrc; const LAS int* mbase; int np, nN, p0, slot, down; size_t b_exp, b_tile; int wgm, late = 0, xl = 0;
    __device__ __forceinline__ bool next(int i, GUnit& u) const { int pm, pn; if (!pg8::tile_order(i, GRID, bx_opaque(), np, nN, wgm, pm, pn, late, xl)) return false;
        const int gp = p0 + pm; int e = 0;
#pragma unroll
        for (int k = 1; k < 8; ++k) e += (gp * 256 >= mbase[slot * 8 + k]) ? 1 : 0;
        e = __builtin_amdgcn_readfirstlane(e);
        u.pm = gp; u.pn = pn; u.B = B + (size_t)e * b_exp + (size_t)pn * b_tile;
        if (down) { u.aux = gp * 256; u.rows = nullptr; u.A = A + (size_t)pm * 256 * FF * 2; }
        else { u.aux = pm; u.rows = rsrc + (size_t)gp * 256; u.A = A; }
        return true; }
};
__device__ __forceinline__ void transpose_item(const float* __restrict__ W, int N, bf16* __restrict__ WT, int Kd, int dst_row0, int k0, int n0, LAS float* scr, int lane, float scale = 1.f) {
    { const int kq = lane >> 3, n4 = (lane & 7) * 4; f32x4 v[8];
#pragma unroll
      for (int i = 0; i < 8; ++i) v[i] = *(const f32x4*)(W + (size_t)(k0 + kq + 8 * i) * N + n0 + n4);
#pragma unroll
      for (int i = 0; i < 8; ++i) { LAS float* d = scr + (kq + 8 * i) * 33 + n4; d[0] = v[i][0] * scale; d[1] = v[i][1] * scale; d[2] = v[i][2] * scale; d[3] = v[i][3] * scale; } }
    LDS_WAIT(); asm volatile("" ::: "memory");
    const int c = lane & 7;
#pragma unroll
    for (int j = 0; j < 4; ++j) { const int n = (lane >> 3) + 8 * j; const LAS float* s = scr + (8 * c) * 33 + n;
        u32x4 o; o.x = pk2(s[0 * 33], s[1 * 33]); o.y = pk2(s[2 * 33], s[3 * 33]); o.z = pk2(s[4 * 33], s[5 * 33]); o.w = pk2(s[6 * 33], s[7 * 33]);
        *(u32x4*)(WT + (size_t)(dst_row0 + n) * Kd + k0 + 8 * c) = o; }
    LDS_WAIT(); asm volatile("" ::: "memory");
}
constexpr int PW_PER_LAYER = 1280 + 512 + 32, PW_N_A = NLAYER * PW_PER_LAYER, PW_PER_F = 3 * 1408;
__device__ __forceinline__ void ffn_item(const KA& p, int r0, LAS float* scr, int lane) {
    unsigned char* ws = p.ws();
    const int f = r0 / PW_PER_F, r = r0 - f * PW_PER_F, which = r / 1408, q = r - which * 1408;
    const bool dense = f < 2; const int mi = dense ? f : f - 2;
    const size_t wo = (size_t)mi * DM * FF;
    if (which < 2) { const float* W = (which == 0 ? (dense ? p.in(I_FW1) : p.in(I_MW1)) : (dense ? p.in(I_FW3) : p.in(I_MW3))) + wo;
        bf16* WT = (bf16*)(ws + (dense ? WS_W13D : WS_W13M) + (size_t)mi * SZ_W13);
        const int kb = q / 88, nb = q % 88, n0 = 32 * nb;
        transpose_item(W, FF, WT, DM, (n0 >> 7) * 256 + which * 128 + (n0 & 127), 64 * kb, n0, scr, lane, which == 0 ? -1.4426950408889634f : -0.6931471805599453f);
    } else { const float* W = (dense ? p.in(I_FW2) : p.in(I_MW2)) + wo; bf16* WT = (bf16*)(ws + (dense ? WS_W2D : WS_W2M) + (size_t)mi * SZ_W2);
        const int kb = q / 32, nb = q % 32; transpose_item(W, DM, WT, FF, 32 * nb, 64 * kb, 32 * nb, scr, lane); }
}
constexpr int PW_INPROJ_PART = 3584;
constexpr int PW_PROLOGUE_F = 10;
constexpr int PW_DEFER_ITEMS = 8 * PW_PER_F, PW_DEFER_PART = PW_DEFER_ITEMS / 4;
static_assert(PW_DEFER_ITEMS % 4 == 0, "deferred items split in four");
__device__ __forceinline__ void prologue_weights(const KA& p, LAS unsigned char* lds, int wid, int lane) {
    LAS float* scr = (LAS float*)(lds + wid * 16384);
    const int bx = bx_opaque(); if (bx >= 128 && bx < 192) return;
    const int gw = (bx < 128 ? bx : bx - 64) * NWAVES + wid;
    constexpr int N_ALL = PW_N_A + PW_PROLOGUE_F * PW_PER_F - 2 * PW_INPROJ_PART;
    unsigned char* ws = p.ws();
    for (int it = gw; it < N_ALL; it += (GRID - 64) * NWAVES) {
        if (it < PW_N_A) { const int l = it / PW_PER_LAYER; int r = it - l * PW_PER_LAYER;
            if (r < 1280) { transpose_item(p.in(I_WIN) + (size_t)l * DM * INW, INW, (bf16*)(ws + WS_WIN) + (size_t)l * INW * DM, DM, 32 * (r % 80), 64 * (r / 80), 32 * (r % 80), scr, lane); continue; } r -= 1280;
            if (r < 512) { transpose_item(p.in(I_WOUT) + (size_t)l * DM * DM, DM, (bf16*)(ws + WS_WOUT) + (size_t)l * DM * DM, DM, 32 * (r % 32), 64 * (r / 32), 32 * (r % 32), scr, lane); continue; } r -= 512;
            transpose_item(p.in(I_WGLU) + (size_t)l * 65536, 256, (bf16*)(ws + WS_WGLU) + (size_t)l * 65536, 256, 32 * (r % 8), 64 * (r / 8), 32 * (r % 8), scr, lane);
        } else ffn_item(p, it - PW_N_A, scr, lane);
    }
}
__device__ __forceinline__ void deferred_weights(const KA& p, LAS unsigned char* lds, int wid, int lane, int first, int count, int nbusy) {
    const int bx = bx_opaque(); int idx = bx - nbusy, n = GRID - nbusy; if (n <= 0) { idx = bx; n = GRID; }
    if (idx < 0) return;
    LAS float* scr = (LAS float*)(lds + wid * 16384);
    for (int j = idx * NWAVES + wid; j < count; j += n * NWAVES) ffn_item(p, PW_PROLOGUE_F * PW_PER_F + first + j, scr, lane);
}
__device__ __forceinline__ void prologue_mod(const KA& p, LAS unsigned char* lds, int tid, int wid, int lane) {
    LAS float* sc = (LAS float*)lds; LAS float* red = (LAS float*)(lds + 17 * 1024 * 4);
    __syncthreads();
    for (int idx = tid; idx < 17 * 1024; idx += NTHREADS) { const int cond = idx >> 10, k = idx & 1023; const float v = cond < 16 ? p.in(I_C)[cond * 1024 + k] : p.in(I_CCTX)[k]; sc[idx] = v / (1.f + expf(-v)); }
    __syncthreads();
    float* MOD = (float*)(p.ws() + WS_MOD);
    const int bxm = bx_opaque(); const bool s5b = bxm >= 128 && bxm < 192;
    for (int t = 0; t < (s5b ? 3 : 1); ++t) { const int u = s5b ? (bxm - 128) + 64 * t : 192 + (bxm < 128 ? bxm : bxm - 64); const int l = u / 96, cb = u % 96;
        float acc[17];
#pragma unroll
        for (int c = 0; c < 17; ++c) acc[c] = 0.f;
        const float* wp = p.in(I_WMOD) + ((size_t)l * 1024 + wid * 128) * 6144 + cb * 64 + lane;
        for (int k = 0; k < 128; k += 16) { float w[16];
#pragma unroll
            for (int q = 0; q < 16; ++q) w[q] = wp[(size_t)(k + q) * 6144];
#pragma unroll
            for (int q = 0; q < 16; q += 4)
#pragma unroll
                for (int c = 0; c < 17; ++c) { const f32x4 s = *(const LAS f32x4*)(sc + c * 1024 + wid * 128 + k + q); acc[c] += s[0] * w[q] + s[1] * w[q + 1] + s[2] * w[q + 2] + s[3] * w[q + 3]; } }
#pragma unroll
        for (int c = 0; c < 17; ++c) red[(wid * 17 + c) * 64 + lane] = acc[c];
        __syncthreads();
        for (int o = tid; o < 17 * 64; o += NTHREADS) { const int c = o >> 6, j = o & 63; float s = p.in(I_BMOD)[l * 6144 + cb * 64 + j];
#pragma unroll
            for (int w = 0; w < 8; ++w) s += red[(w * 17 + c) * 64 + j];
            MOD[((size_t)l * 17 + c) * 6144 + cb * 64 + j] = s; }
        __syncthreads();
    }
}
__device__ __forceinline__ void prologue_small_tables(const KA& p, int tid) {
    float* rope = (float*)(p.ws() + WS_ROPE); float* lamt = (float*)(p.ws() + WS_LAM);
    for (int i = tid; i < 1024; i += NTHREADS) { const int pos = i >> 4, k = i & 15; const float inv = exp2f(-(float)k * (13.287712379549449f / 16.f)); const float a = (float)pos * inv; rope[2 * i] = cosf(a); rope[2 * i + 1] = sinf(a); }
    if (tid < NLAYER) { const int l = tid; float d1 = 0.f, d2 = 0.f;
        for (int k = 0; k < 64; ++k) { d1 += p.in(I_LQ1)[l * 64 + k] * p.in(I_LK1)[l * 64 + k]; d2 += p.in(I_LQ2)[l * 64 + k] * p.in(I_LK2)[l * 64 + k]; }
        const float li = 0.8f - 0.6f * expf(-0.3f * (float)l); lamt[2 * l] = expf(d1) - expf(d2) + li; lamt[2 * l + 1] = li; }
}
__device__ __forceinline__ f32x2 cpow_turns(float lre_dt, double rev, int k) {
    const float mag = expf((float)k * lre_dt); double tk = rev * (double)k; tk -= __builtin_floor(tk + 0.5); const float ang = (float)(tk * 6.283185307179586);
    return (f32x2){mag * cosf(ang), mag * sinf(ang)};
}
__device__ __forceinline__ void prologue_s5(const KA& p, LAS unsigned char* lds, int tid, int l, int g) {
    LAS f32x2* apow = (LAS f32x2*)lds;
    LAS f32x2* bb = (LAS f32x2*)(lds + 17408);
    LAS f32x2* cc = (LAS f32x2*)(lds + 33792);
    LAS float* KT = (LAS float*)(lds + 50176);
    __syncthreads();
    if (tid < 128) { const int dir = tid >> 6, pp = tid & 63, gi = (l * 2 + dir) * 16 + g, idx = gi * 64 + pp;
        const float lre = p.in(I_LAMRE)[idx], lim = p.in(I_LAMIM)[idx], dt = expf(p.in(I_LOGSTEP)[gi]);
        const double rev = (double)lim * (double)dt * 0.15915494309189535; const float lre_dt = lre * dt;
        for (int k = 0; k <= 16; ++k) apow[(dir * 17 + k) * 64 + pp] = cpow_turns(lre_dt, rev, k);
        const f32x2 a1 = cpow_turns(lre_dt, rev, 1), a16 = cpow_turns(lre_dt, rev, 16), a544 = cpow_turns(lre_dt, rev, 544);
        ((f32x4*)(p.ws() + WS_A16))[idx] = (f32x4){a16.x, a16.y, a544.x, a544.y};
        const float nre = a1.x - 1.f, nim = a1.y, den = lre * lre + lim * lim, fre = (nre * lre + nim * lim) / den, fim = (nim * lre - nre * lim) / den;
        for (int h = 0; h < 16; ++h) { const float br = p.in(I_BRE)[(size_t)idx * 16 + h], bi = p.in(I_BIM)[(size_t)idx * 16 + h]; bb[(dir * 64 + pp) * 16 + h] = (f32x2){fre * br - fim * bi, fre * bi + fim * br}; } }
    for (int e = tid; e < 2048; e += NTHREADS) { const int dir = e >> 10, h = (e >> 6) & 15, pp = e & 63; const size_t ci = ((size_t)((l * 2 + dir) * 16 + g) * 16 + h) * 64 + pp;
        cc[e] = (f32x2){p.in(I_CRE)[ci], p.in(I_CIM)[ci]}; }
    __syncthreads();
    bf16* W1 = (bf16*)(p.ws() + WS_S5W1) + (size_t)(l * 16 + g) * 65536; bf16* W2 = (bf16*)(p.ws() + WS_S5W2) + (size_t)(l * 16 + g) * 131072;
    for (int it = 0; it < 128; ++it) { const int e = it * NTHREADS + tid, n = e >> 8, k = e & 255;
        { const int dir = n >> 7, part = (n >> 6) & 1, pp = n & 63, j = k >> 4, hh = k & 15, pw = dir == 0 ? 15 - j : j;
          const f32x2 a = apow[(dir * 17 + pw) * 64 + pp], b = bb[(dir * 64 + pp) * 16 + hh];
          W1[e] = (bf16)f2bf(part ? (a.x * b.y + a.y * b.x) : (a.x * b.x - a.y * b.y)); }
        { const int i = n >> 4, h = n & 15, dir = k >> 7, part = (k >> 6) & 1, pp = k & 63, pw = dir == 0 ? i + 1 : 16 - i;
          const f32x2 a = apow[(dir * 17 + pw) * 64 + pp], c = cc[(dir * 16 + h) * 64 + pp];
          W2[(size_t)n * 512 + k] = (bf16)f2bf(part ? -(c.x * a.y + c.y * a.x) : (c.x * a.x - c.y * a.y)); } }
    { const int dir = tid >> 8, h = (tid >> 4) & 15, hh = tid & 15;
      for (int lag = 0; lag < 16; ++lag) { float s = 0.f;
          for (int pp = 0; pp < 64; ++pp) { const f32x2 c = cc[(dir * 16 + h) * 64 + pp], a = apow[(dir * 17 + lag) * 64 + pp], b = bb[(dir * 64 + pp) * 16 + hh];
              const float cax = c.x * a.x - c.y * a.y, cay = c.x * a.y + c.y * a.x; s += cax * b.x - cay * b.y; }
          KT[(dir * 16 + lag) * 256 + h * 16 + hh] = s; } }
    __syncthreads();
    for (int it = 0; it < 128; ++it) { const int e = it * NTHREADS + tid, n = e >> 8, kk = e & 255, i = n >> 4, h = n & 15, j = kk >> 4, hh = kk & 15;
        float v = 0.f; if (j <= i) v += KT[(i - j) * 256 + h * 16 + hh]; if (j >= i) v += KT[(16 + j - i) * 256 + h * 16 + hh];
        if (i == j && h == hh) v += p.in(I_SSMD)[l * 256 + g * 16 + h];
        W2[(size_t)n * 512 + 256 + kk] = (bf16)f2bf(v); }
    __syncthreads();
}

template <bool ROUTER, bool F32SRC>
__device__ __forceinline__ void norm_phase(const KA& p, LAS unsigned char* lds, int tid, int wid, int lane, const float* srcL, const float* srcC, const float* gvec, const float* shiftv, const float* scalev,
                                           const float* router, bool skip_ctx) {
    bf16* HX = (bf16*)((unsigned char*)p.out() + OUT_HX); const bf16* XR = (const bf16*)(p.ws() + WS_XR);
    const int gw = bx_opaque() * NWAVES + wid;
    LAS int* wcnt = (LAS int*)lds + wid * 16;
    f32x4 wr0[ROUTER ? 16 : 1], wr1[ROUTER ? 16 : 1];
    if constexpr (ROUTER) {
        __syncthreads(); if (lane < 16) wcnt[lane] = 0;
        int* rsrc = (int*)(p.ws() + WS_RSRC); for (int i = bx_opaque() * NTHREADS + tid; i < MOE_ROWS; i += GRID * NTHREADS) rsrc[i] = -1;
#pragma unroll
        for (int j = 0; j < 4; ++j)
#pragma unroll
            for (int k = 0; k < 4; ++k) { const int c = 4 * lane + 256 * j + k; wr0[j * 4 + k] = *(const f32x4*)(router + (size_t)c * 8); wr1[j * 4 + k] = *(const f32x4*)(router + (size_t)c * 8 + 4); }
    }
    f32x4 Av[4], Bv[4]; int cur_cond = -1;
    constexpr int NB_ROWS = F32SRC ? 4 : (ROUTER ? 3 : 9);
    for (int rr0 = 0; rr0 < RPW; rr0 += NB_ROWS) {
        f32x4 rawf[F32SRC ? NB_ROWS : 1][4]; u32x2 rawh[F32SRC ? 1 : NB_ROWS][4];
#pragma unroll
        for (int d = 0; d < NB_ROWS; ++d) if (rr0 + d < RPW) { const int r = gw * RPW + rr0 + d;
            if constexpr (F32SRC) { bool isc; const size_t ro = res_off(r, isc); const float* xr = (isc ? srcC : srcL) + ro;
#pragma unroll
                for (int j = 0; j < 4; ++j) rawf[d][j] = *(const f32x4*)(xr + 4 * lane + 256 * j); }
            else {
#pragma unroll
                for (int j = 0; j < 4; ++j) rawh[d][j] = *(const u32x2*)(XR + (size_t)r * DM + 4 * lane + 256 * j); } }
#pragma unroll
        for (int d = 0; d < NB_ROWS; ++d) if (rr0 + d < RPW) { const int r = gw * RPW + rr0 + d; const int bq = r / RB; const bool isc = (r - bq * RB) >= SEQ; const int cond = isc ? 16 : bq;
        if (cond != cur_cond) { cur_cond = cond;
#pragma unroll
            for (int j = 0; j < 4; ++j) { const int c = 4 * lane + 256 * j; const f32x4 g = *(const f32x4*)(gvec + c), s = *(const f32x4*)(scalev + (size_t)cond * 6144 + c); Av[j] = g * (s + 1.f); Bv[j] = *(const f32x4*)(shiftv + (size_t)cond * 6144 + c); } }
        f32x4 v[4]; float ss = 0.f;
#pragma unroll
        for (int j = 0; j < 4; ++j) {
            if constexpr (F32SRC) v[j] = rawf[d][j];
            else { const u32x2 w = rawh[d][j]; v[j] = (f32x4){bf2f(w.x & 0xffffu), bf2f(w.x >> 16), bf2f(w.y & 0xffffu), bf2f(w.y >> 16)}; }
            ss += (v[j][0] * v[j][0] + v[j][1] * v[j][1]) + (v[j][2] * v[j][2] + v[j][3] * v[j][3]); }
        const float rinv = 1.f / sqrtf(wave_sum(ss) * (1.f / DM) + 1e-6f);
#pragma unroll
        for (int j = 0; j < 4; ++j) { v[j] = v[j] * rinv * Av[j] + Bv[j]; *(u32x2*)(HX + (size_t)r * DM + 4 * lane + 256 * j) = (u32x2){pk2(v[j][0], v[j][1]), pk2(v[j][2], v[j][3])}; }
        if constexpr (ROUTER) {
            int* toke = (int*)(p.ws() + WS_TOKE); f32x2* tokg = (f32x2*)(p.ws() + WS_TOKG);
            if (isc && skip_ctx) { if (lane == 0) toke[r] = 0xFFFF; }
            else { f32x4 l0 = {0.f, 0.f, 0.f, 0.f}, l1 = {0.f, 0.f, 0.f, 0.f};
#pragma unroll
                for (int j = 0; j < 4; ++j)
#pragma unroll
                    for (int k = 0; k < 4; ++k) { l0 += wr0[j * 4 + k] * v[j][k]; l1 += wr1[j * 4 + k] * v[j][k]; }
                float lg[8];
#pragma unroll
                for (int e = 0; e < 4; ++e) { lg[e] = wave_sum(l0[e]); lg[4 + e] = wave_sum(l1[e]); }
                int e0 = 0; float v0 = lg[0];
#pragma unroll
                for (int e = 1; e < 8; ++e) if (lg[e] > v0) { v0 = lg[e]; e0 = e; }
                int e1 = -1; float v1 = -3.0e38f;
#pragma unroll
                for (int e = 0; e < 8; ++e) if (e != e0 && lg[e] > v1) { v1 = lg[e]; e1 = e; }
                const float g0 = 1.f / (1.f + expf(v1 - v0));
                if (lane == 0) { toke[r] = e0 | (e1 << 8); tokg[r] = (f32x2){g0, 1.f - g0}; wcnt[e0] += 1; wcnt[8 + e1] += 1; } }
        }
        }
    }
    if constexpr (ROUTER) { LDS_WAIT(); if (lane < 16) ((int*)(p.ws() + WS_WCNT))[gw * 16 + lane] = wcnt[lane]; }
}
__device__ __forceinline__ void route2_phase(const KA& p, LAS unsigned char* lds, LAS int* mbase_lds, int tid, int wid, int lane) {
    LAS int* segsum = (LAS int*)lds;
    LAS int* wpre = segsum + 512;
    LAS int* tot = wpre + 128;
    LAS int* wstart = tot + 16;
    const int* wcnt = (const int*)(p.ws() + WS_WCNT);
    __syncthreads();
    { const int seg = tid >> 4, bin = tid & 15, myseg = bx_opaque() >> 3, wg0 = (bx_opaque() & 7) * 8; int s = 0;
      for (int k = 0; k < 64; ++k) { const int c = wcnt[(seg * 64 + k) * 16 + bin]; if (seg == myseg && k >= wg0 && k < wg0 + 8) wpre[(k - wg0) * 16 + bin] = s; s += c; }
      segsum[seg * 16 + bin] = s; }
    __syncthreads();
    if (tid < 16) { int s = 0; for (int k = 0; k < 32; ++k) s += segsum[k * 16 + tid]; tot[tid] = s; }
    __syncthreads();
    if (tid == 0) { int b = 0; for (int k = 0; k < 16; ++k) { mbase_lds[k] = b; b += (tot[k] + 255) & ~255; } mbase_lds[16] = b; }
    __syncthreads();
    if (bx_opaque() == 0 && tid < 17) ((int*)(p.ws() + WS_MBASE))[tid] = mbase_lds[tid];
    if (tid < 128) { const int w = tid >> 4, bin = tid & 15, myseg = bx_opaque() >> 3; int s = mbase_lds[bin] + wpre[w * 16 + bin]; for (int k = 0; k < myseg; ++k) s += segsum[k * 16 + bin]; wstart[w * 16 + bin] = s; }
    __syncthreads();
    { const int gw = bx_opaque() * NWAVES + wid; const int* toke = (const int*)(p.ws() + WS_TOKE); const f32x2* tokg = (const f32x2*)(p.ws() + WS_TOKG);
      int* rsrc = (int*)(p.ws() + WS_RSRC); float* rgate = (float*)(p.ws() + WS_RGATE);
      const bool act = lane < RPW; const int r = gw * RPW + (act ? lane : 0); const int te = act ? toke[r] : 0xFFFF; const f32x2 g = act ? tokg[r] : (f32x2){0.f, 0.f};
      const bool valid = te != 0xFFFF; const int e0 = te & 255, e1 = (te >> 8) & 255; int p0 = 0, p1 = 0;
      const unsigned long long ltm = (1ull << lane) - 1ull;
#pragma unroll
      for (int bin = 0; bin < 8; ++bin) { const unsigned long long m0 = __ballot(valid && e0 == bin), m1 = __ballot(valid && e1 == bin);
          if (e0 == bin) p0 = wstart[wid * 16 + bin] + __popcll(m0 & ltm);
          if (e1 == bin) p1 = wstart[wid * 16 + 8 + bin] + __popcll(m1 & ltm); }
      if (valid) { rsrc[p0] = r; rgate[p0] = g.x; rsrc[p1] = r; rgate[p1] = g.y; } }
    __syncthreads();
}
__device__ __forceinline__ void carry_phase(const KA& p, LAS unsigned char* lds, int tid, int wid, int lane, int l) {
    LAS f32x2* segend = (LAS f32x2*)lds;
    const float* Z = (const float*)(p.ws() + WS_ZLOC); bf16* A2 = (bf16*)((unsigned char*)p.out() + OUT_A2);
    for (int u = bx_opaque(); u < NB * 16 * 2; u += GRID) { const int dir = u & 1, g = (u >> 1) & 15, b = u >> 5;
        const f32x4 at = ((const f32x4*)(p.ws() + WS_A16))[((l * 2 + dir) * 16 + g) * 64 + lane];
        const float ar = at[0], ai = at[1];
        const size_t zrow0 = (size_t)g * NR16 + (size_t)b * 272;
        float lr[34], li[34];
#pragma unroll
        for (int k = 0; k < 34; ++k) { const int q = wid * 34 + k, cp = dir == 0 ? (q < 16 ? 256 + q : q - 16) : 271 - q; const float* zp = Z + (zrow0 + cp) * 256 + dir * 128 + lane; lr[k] = zp[0]; li[k] = zp[64]; }
        float zr = 0.f, zi = 0.f;
#pragma unroll
        for (int k = 0; k < 34; ++k) { const float nr = ar * zr - ai * zi + lr[k], ni = ar * zi + ai * zr + li[k]; zr = nr; zi = ni; }
        __syncthreads();
        segend[wid * 64 + lane] = (f32x2){zr, zi};
        __syncthreads();
        float cr = 0.f, ci = 0.f;
        for (int w = 0; w < wid; ++w) { const f32x2 s = segend[w * 64 + lane]; const float nr = at[2] * cr - at[3] * ci + s.x, ni = at[2] * ci + at[3] * cr + s.y; cr = nr; ci = ni; }
        zr = cr; zi = ci;
#pragma unroll
        for (int k = 0; k < 34; ++k) { const int q = wid * 34 + k, cp = dir == 0 ? (q < 16 ? 256 + q : q - 16) : 271 - q;
            bf16* ap = A2 + (zrow0 + cp) * 512 + dir * 128 + lane; ap[0] = (bf16)f2bf(zr); ap[64] = (bf16)f2bf(zi);
            const float nr = ar * zr - ai * zi + lr[k], ni = ar * zi + ai * zr + li[k]; zr = nr; zi = ni; }
    }
    __syncthreads();
}
__device__ __forceinline__ void final_phase(const KA& p, int wid, int lane) {
    const int gw = bx_opaque() * NWAVES + wid; f32x4 g[4]; const bf16* XR = (const bf16*)(p.ws() + WS_XR);
#pragma unroll
    for (int j = 0; j < 4; ++j) g[j] = *(const f32x4*)(p.in(I_GFINAL) + 4 * lane + 256 * j);
    for (int rl0 = gw * 32; rl0 < gw * 32 + 32; rl0 += 8) { u32x2 raw[8][4];
#pragma unroll
        for (int d = 0; d < 8; ++d) { const int rl = rl0 + d, b = rl >> 12, n = rl & 4095; const bf16* xr = XR + ((size_t)b * RB + n) * DM;
#pragma unroll
            for (int j = 0; j < 4; ++j) raw[d][j] = *(const u32x2*)(xr + 4 * lane + 256 * j); }
#pragma unroll
        for (int d = 0; d < 8; ++d) { float* orow = p.out() + (size_t)(rl0 + d) * DM; f32x4 v[4]; float ss = 0.f;
#pragma unroll
            for (int j = 0; j < 4; ++j) { const u32x2 w = raw[d][j]; v[j] = (f32x4){bf2f(w.x & 0xffffu), bf2f(w.x >> 16), bf2f(w.y & 0xffffu), bf2f(w.y >> 16)};
                ss += (v[j][0] * v[j][0] + v[j][1] * v[j][1]) + (v[j][2] * v[j][2] + v[j][3] * v[j][3]); }
            const float rinv = 1.f / sqrtf(wave_sum(ss) * (1.f / DM) + 1e-6f);
#pragma unroll
            for (int j = 0; j < 4; ++j) *(f32x4*)(orow + 4 * lane + 256 * j) = v[j] * rinv * g[j]; } }
}

constexpr int STAGE_LO = att::ATT_LDS, STAGE_HI = WTAB_OFF + 256;
static_assert(STAGE_LO % 16 == 0 && STAGE_HI % 16 == 0 && STAGE_LO + 5 * 4096 <= RING_BYTES && STAGE_HI + 3 * 4096 <= LDS_BYTES, "output stage placement");
__device__ __forceinline__ LAS bf16* stage_ptr(LAS unsigned char* lds, int wid) { return (LAS bf16*)(lds + (wid < 5 ? STAGE_LO + wid * 4096 : STAGE_HI + (wid - 5) * 4096)); }
__device__ __forceinline__ void diff_unit(const bf16* P, bf16* Y, int rows0, int h, int kbase, int NT, const float* lamp, const float* gsub, LAS unsigned char* lds, unsigned* gst, bool pre_in, bool has_next, size_t ndelta) {
    const int tid = tid_opaque(), lane = tid & 63, wid = __builtin_amdgcn_readfirstlane(tid >> 6), r32 = lane & 31, hi = lane >> 5;
    LAS bf16* st = stage_ptr(lds, wid) + r32;
    unsigned* gs = gst + ((size_t)(bx_opaque() * NWAVES + wid) * 32) * 64 + lane;
    {
        f32x16 o[4];
        att::attn_body<128, 0>(P + (size_t)rows0 * PW + PC_DQ + h * 128, P + PC_DK + h * 128, P + PC_DV + h * 128, kbase, NT, 0, NT, lds, o, 0, 0, nullptr, P + PC_DK + h * 128 + 64, P + PC_DV + h * 128, pre_in);
#pragma unroll
        for (int d = 0; d < 4; ++d)
#pragma unroll
            for (int j = 0; j < 8; ++j) gs[(d * 8 + j) * 64] = cvt_pk_bf16(o[d][2 * j], o[d][2 * j + 1]);
    }
    __builtin_amdgcn_sched_barrier(0);
    {
        f32x16 o[4];
        att::attn_body<128, 0>(P + (size_t)rows0 * PW + PC_DQ + h * 128 + 64, P + PC_DK + h * 128 + 64, P + PC_DV + h * 128, kbase, NT, 0, NT, lds, o, 0, 0, nullptr,
                               has_next ? P + PC_DK + h * 128 + ndelta : nullptr, has_next ? P + PC_DV + h * 128 + ndelta : nullptr, true);
        const float lam = lamp[0], lam_init = lamp[1];
        float ss[16];
#pragma unroll
        for (int r = 0; r < 16; ++r) ss[r] = 0.f;
        unsigned sw_[32];
#pragma unroll
        for (int k = 0; k < 32; ++k) sw_[k] = __hip_atomic_load(gs + k * 64, __ATOMIC_RELAXED, __HIP_MEMORY_SCOPE_AGENT);
        __builtin_amdgcn_sched_barrier(0);
#pragma unroll
        for (int d = 0; d < 4; ++d)
#pragma unroll
            for (int j = 0; j < 8; ++j) { const unsigned w = sw_[d * 8 + j];
                const float v0 = bf2f(w & 0xffffu) - lam * o[d][2 * j], v1 = bf2f(w >> 16) - lam * o[d][2 * j + 1]; o[d][2 * j] = v0; o[d][2 * j + 1] = v1; ss[2 * j] += v0 * v0; ss[2 * j + 1] += v1 * v1; }
#pragma unroll
        for (int r = 0; r < 16; ++r) {
            ss[r] = half_sum(ss[r]);
            ss[r] = (1.f / sqrtf(ss[r] * (1.f / 128.f) + 1e-5f)) * (1.f - lam_init); }
        float gs[4];
#pragma unroll
        for (int d = 0; d < 4; ++d) gs[d] = gsub[d * 32 + r32];
        { const LAS bf16* sw = stage_ptr(lds, wid); bf16* yo = Y + (size_t)(rows0 + wid * 32) * DM + 256 + h * 128;
#pragma unroll
          for (int q = 0; q < 2; ++q) {
#pragma unroll
            for (int r = 8 * q; r < 8 * q + 8; ++r)
#pragma unroll
                for (int d = 0; d < 4; ++d) st[(att::crow(r, hi) - 16 * q) * 128 + d * 32] = (bf16)f2bf(o[d][r] * ss[r] * gs[d]);
            asm volatile("s_waitcnt lgkmcnt(0)" ::: "memory");
#pragma unroll
            for (int i = 0; i < 4; ++i) { const int row = i * 4 + (lane >> 4), ch = lane & 15; *(u32x4*)(yo + (size_t)(16 * q + row) * DM + ch * 8) = *(const LAS u32x4*)(sw + row * 128 + ch * 8); }
            asm volatile("s_waitcnt lgkmcnt(0)" ::: "memory"); } }
    }
}
__device__ __forceinline__ void na_unit(const bf16* P, bf16* Y, const float* rpb_h, int b, int h, int qb, LAS unsigned char* lds, bool fill, bool pre_in, bool has_next, size_t ndelta) {
    const int tid = tid_opaque(), lane = tid & 63, wid = __builtin_amdgcn_readfirstlane(tid >> 6), r32 = lane & 31, hi = lane >> 5; const int rows0 = b * RB + qb * 256, r0 = qb * 4;
    const int kmin = min(min(max(r0 - 4, 0), 56), 52);
    __syncthreads();
    if (fill) { LAS float* tbl = (LAS float*)(lds + att::OFF_RPB);
      for (int i = tid; i < 15 * att::RPB_PITCH; i += NTHREADS) { const int ri = i >> 7, cj = (i & 127) - 48; tbl[i] = ((unsigned)cj < 31u) ? rpb_h[ri * 31 + cj] * 1.4426950408889634f : 0.f; } }
    f32x16 o[2];
    att::attn_body<64, 1>(P + (size_t)rows0 * PW + PC_NQ + h * 64, P + PC_NK + h * 64, P + PC_NV + h * 64, b * RB + SEQ, 4, b * RB + kmin * 64, 16, lds, o, r0 + (wid >> 1), kmin, nullptr,
                          has_next ? P + PC_NK + h * 64 + ndelta : nullptr, has_next ? P + PC_NV + h * 64 + ndelta : nullptr, pre_in);
    { LAS bf16* sw = stage_ptr(lds, wid);
#pragma unroll
      for (int r = 0; r < 16; ++r)
#pragma unroll
          for (int d = 0; d < 2; ++d) sw[att::crow(r, hi) * 64 + d * 32 + r32] = (bf16)f2bf(o[d][r]);
      asm volatile("s_waitcnt lgkmcnt(0)" ::: "memory");
      bf16* yo = Y + (size_t)(rows0 + wid * 32) * DM + 768 + h * 64;
#pragma unroll
      for (int i = 0; i < 4; ++i) { const int row = i * 8 + (lane >> 3), ch = lane & 7; *(u32x4*)(yo + (size_t)row * DM + ch * 8) = *(const LAS u32x4*)(sw + row * 64 + ch * 8); }
      asm volatile("s_waitcnt lgkmcnt(0)" ::: "memory"); }
}
__device__ __forceinline__ void na_ctx_unit(const bf16* P, bf16* Y, int b, int h, LAS unsigned char* lds) {
    const int tid = tid_opaque(), lane = tid & 63, wid = __builtin_amdgcn_readfirstlane(tid >> 6), r32 = lane & 31, hi = lane >> 5; const int rows0 = b * RB + SEQ;
    f32x16 o[2];
    att::attn_body<64, 0>(P + (size_t)rows0 * PW + PC_NQ + h * 64, P + PC_NK + h * 64, P + PC_NV + h * 64, rows0, 4, 0, 4, lds, o, 0, 0);
    { LAS bf16* sw = stage_ptr(lds, wid);
#pragma unroll
      for (int r = 0; r < 16; ++r)
#pragma unroll
          for (int d = 0; d < 2; ++d) sw[att::crow(r, hi) * 64 + d * 32 + r32] = (bf16)f2bf(o[d][r]);
      asm volatile("s_waitcnt lgkmcnt(0)" ::: "memory");
      bf16* yo = Y + (size_t)(rows0 + wid * 32) * DM + 768 + h * 64;
#pragma unroll
      for (int i = 0; i < 4; ++i) { const int row = i * 8 + (lane >> 3), ch = lane & 7; *(u32x4*)(yo + (size_t)row * DM + ch * 8) = *(const LAS u32x4*)(sw + row * 64 + ch * 8); }
      asm volatile("s_waitcnt lgkmcnt(0)" ::: "memory"); }
}
#ifndef WGM_IN
#define WGM_IN 4
#endif
#ifndef WGM_OUT
#define WGM_OUT 4
#endif
#ifndef WGM_UP
#define WGM_UP 4
#endif
#ifndef WGM_DOWN
#define WGM_DOWN 4
#endif
__global__ void __launch_bounds__(NTHREADS, 2) dit_fwd(Params p_unused) {
    (void)p_unused;
    LAS unsigned char* lds = (LAS unsigned char*)lds_raw;
    volatile LAS unsigned* MISC = (volatile LAS unsigned*)(lds + MISC_OFF);
    LAS int* mbase = (LAS int*)(lds + MISC_OFF + 128);
#define PH_ARGS KA p; p.k = (const CAS unsigned char*)__builtin_amdgcn_kernarg_segment_ptr(); asm volatile("" : "+s"(p.k)); unsigned char* const ws = p.ws(); (void)ws
#define PH_IDS PH_ARGS; const int tid = tid_opaque(), lane = tid & 63, wid = __builtin_amdgcn_readfirstlane(tid >> 6); (void)lane; (void)wid
#define BX (bx_opaque())
#define VCU ((BX & 7) * (GRID / 8) + (BX >> 3))
    for (int u = (int)threadIdx.x; u < (LDS_BYTES - LDSCTL_OFF) / 4; u += NTHREADS) ((LAS unsigned*)(lds + LDSCTL_OFF))[u] = 0u;
    __syncthreads();
    if ((threadIdx.x & 63) == 0) ((volatile LAS int*)(lds + WTAB_OFF))[hw_wave_slot()] = (int)(threadIdx.x >> 6);
    __syncthreads();
    { PH_ARGS; (void)xcd_barrier_post((unsigned*)(ws + WS_CTL) + CW_BAR, MISC + 8); }
#define GRID_BAR_T(FIRST) do { PH_ARGS; XcdBarrier b_; b_.bar = (unsigned*)(ws + WS_CTL) + CW_BAR; b_.x = xb_xcc_id(); b_.st = (volatile LAS unsigned*)(lds + MISC_OFF) + 8; xcd_barrier<FIRST>(b_); } while (0)
#define GRID_BAR() GRID_BAR_T(false)

#define MOD ((float*)(ws + WS_MOD))
#define OUTB ((unsigned char*)p.out())
#define XR ((bf16*)(ws + WS_XR))
#define HX ((bf16*)(OUTB + OUT_HX))
#define P ((bf16*)(ws + WS_P))
#define H ((bf16*)(ws + WS_H))
#define A2 ((bf16*)(OUTB + OUT_A2))
#define ZL ((float*)(ws + WS_ZLOC))
#define GB ((bf16*)(OUTB + OUT_GBUF))
#define MODL (MOD + (size_t)l * 17 * 6144)

    { PH_IDS; if (BX & 1) { prologue_mod(p, lds, tid, wid, lane); __syncthreads(); prologue_weights(p, lds, wid, lane); }
      else { prologue_weights(p, lds, wid, lane); prologue_mod(p, lds, tid, wid, lane); }
      if (BX >= 128 && BX < 192) prologue_s5(p, lds, tid, (BX - 128) >> 4, (BX - 128) & 15);
      if (BX == 255) prologue_small_tables(p, tid); }
    GRID_BAR_T(true);

    for (int l = 0; l < NLAYER; ++l) {
        const int last = (l == NLAYER - 1) ? 1 : 0;
        { PH_IDS; if (l == 0) norm_phase<false, true>(p, lds, tid, wid, lane, p.in(I_X), p.in(I_CTX), p.in(I_GMIX), MODL, MODL + 1024, nullptr, false);
          else norm_phase<false, false>(p, lds, tid, wid, lane, nullptr, nullptr, p.in(I_GMIX) + l * DM, MODL, MODL + 1024, nullptr, false); }
        GRID_BAR();
        { PH_ARGS; SchedRows S{(const char*)HX, (const char*)(ws + WS_WIN) + (size_t)l * INW * DM * 2, (size_t)256 * DM * 2, (size_t)256 * DM * 2, NPANEL, INW / 256, 0, 0, WGM_IN, 0};
          EpiInProj E{P, A2, (const float*)(ws + WS_ROPE)};
          pg8::gemm_phase<EpiInProj, SchedRows, false>(lds, DM, DM, DM, S, E); }
        if (l < 2) { PH_IDS; deferred_weights(p, lds, wid, lane, (l - 2) * PW_INPROJ_PART, PW_INPROJ_PART, (NPANEL * (INW / 256)) % GRID); }
        GRID_BAR();
        { PH_ARGS; SchedS5 S{(const char*)A2 + 512, (const char*)(ws + WS_S5W1) + (size_t)l * 16 * 65536 * 2, (size_t)65536 * 2}; EpiZ E{ZL};
          pg8::gemm_phase<EpiZ, SchedS5, false>(lds, 256, 512, 256, S, E); }
        GRID_BAR();
        { PH_IDS; carry_phase(p, lds, tid, wid, lane, l); }
        GRID_BAR();
        { PH_ARGS; SchedS5 S{(const char*)A2, (const char*)(ws + WS_S5W2) + (size_t)l * 16 * 131072 * 2, (size_t)131072 * 2, last ? 0 : 1}; EpiY E{GB};
          pg8::gemm_phase<EpiY, SchedS5, false>(lds, 512, 512, 512, S, E); }
        { PH_ARGS; const float* lamp = (const float*)(ws + WS_LAM) + 2 * l; const float* gsub = p.in(I_SUBLN) + l * 128; const int vcu = VCU;
          for (int it = 0; it < 4; ++it) { const int bh = (vcu >> 4) + 16 * it, b = bh >> 2, h = bh & 3, qb = vcu & 15;
              diff_unit(P, HX, b * RB + qb * 256, h, b * RB, RB / 64, lamp, gsub, lds, (unsigned*)(ws + WS_ZLOC), it > 0, it < 3, (size_t)4 * RB * PW); }
          if ((unsigned)((vcu & 31) - 2) < 8u && !last) { const int ci_ = (vcu >> 5) * 8 + (vcu & 31) - 2, b = ci_ >> 2, h = ci_ & 3; diff_unit(P, HX, b * RB + SEQ, h, b * RB + SEQ, CTXL / 64, lamp, gsub, lds, (unsigned*)(ws + WS_ZLOC), false, false, 0); }
          for (int it = 0; it < 4; ++it) { const int bh = (vcu >> 4) + 16 * it, b = bh >> 2, h = bh & 3, qb = vcu & 15;
              na_unit(P, HX, p.in(I_RPB) + (size_t)(l * 4 + h) * 465, b, h, qb, lds, it == 0, it > 0, it < 3, (size_t)4 * RB * PW); }
          if ((unsigned)((vcu & 31) - 10) < 8u && !last) { const int ci_ = (vcu >> 5) * 8 + (vcu & 31) - 10, b = ci_ >> 2, h = ci_ & 3; na_ctx_unit(P, HX, b, h, lds); }
          __syncthreads(); }
        GRID_BAR();
        { PH_ARGS; SchedRows S{(const char*)GB, (const char*)(ws + WS_WGLU) + (size_t)l * 65536 * 2, (size_t)256 * 256 * 2, (size_t)256 * 256 * 2, last ? NB * 16 : NPANEL, 1, 0, 0, 4, last};
          EpiGlu E{GB, HX, p.in(I_BGLU) + l * 256};
          pg8::gemm_phase<EpiGlu, SchedRows, false>(lds, 256, 256, 256, S, E); }
        GRID_BAR();
        { PH_ARGS; SchedRows S{(const char*)HX, (const char*)(ws + WS_WOUT) + (size_t)l * DM * DM * 2, (size_t)256 * DM * 2, (size_t)256 * DM * 2, last ? NB * 16 : NPANEL, 4, 0, 0, WGM_OUT, last};
          if (l == 0) { EpiRes<true> E{p.in(I_X), p.in(I_CTX), XR, MODL + 2 * 1024}; pg8::gemm_phase<EpiRes<true>, SchedRows, false>(lds, DM, DM, DM, S, E); }
          else { EpiRes<false> E{nullptr, nullptr, XR, MODL + 2 * 1024}; pg8::gemm_phase<EpiRes<false>, SchedRows, false>(lds, DM, DM, DM, S, E); } }
        if (l < 3) { PH_IDS; deferred_weights(p, lds, wid, lane, l * PW_DEFER_PART, PW_DEFER_PART, (NPANEL * 4) % GRID); }
        GRID_BAR();
        { PH_IDS; if (l & 1) norm_phase<true, false>(p, lds, tid, wid, lane, nullptr, nullptr, p.in(I_GFFN) + l * DM, MODL + 3 * 1024, MODL + 4 * 1024, p.in(I_ROUTER) + (size_t)(l >> 1) * DM * 8, l == NLAYER - 1);
          else norm_phase<false, false>(p, lds, tid, wid, lane, nullptr, nullptr, p.in(I_GFFN) + l * DM, MODL + 3 * 1024, MODL + 4 * 1024, nullptr, false); }
        GRID_BAR();
#define FFN_XL(nd, nup, xl_out) do { int best_ = 0x7fffffff; xl_out = 0x7fffff; if ((nd) > 0) { for (int x_ = 18; x_ <= 22; ++x_) { const int rest_ = (nup) - (nd) * x_; if (rest_ < 0) break; \
            const int oth_ = (rest_ + (GRID - (nd)) - 1) / (GRID - (nd)); const int cost_ = (5 + 2 * x_) > 2 * oth_ ? (5 + 2 * x_) : 2 * oth_; if (cost_ < best_) { best_ = cost_; xl_out = x_; } } } } while (0)
        if (!(l & 1)) {
            const int fi = l >> 1;
            for (int ci = 0; ci < 2; ++ci) { const int c = 1 - ci, pm0 = c * HCHUNK_PANELS, np = (NPANEL - pm0) < HCHUNK_PANELS ? (NPANEL - pm0) : HCHUNK_PANELS;
                const int nd = c == 0 ? (NPANEL - HCHUNK_PANELS) * 4 : 0; int xl; FFN_XL(nd, np * 22, xl);
                { PH_ARGS; bf16* const Hc = c == 1 ? A2 : H; SchedRows S{(const char*)HX, (const char*)(ws + WS_W13D) + (size_t)fi * SZ_W13, (size_t)256 * DM * 2, (size_t)256 * DM * 2, np, 22, pm0, 0, WGM_UP, 0, nd, xl}; EpiSwi E{Hc};
                  pg8::gemm_phase<EpiSwi, SchedRows, false>(lds, DM, DM, DM, S, E); }
                if (c == 1) { PH_IDS; deferred_weights(p, lds, wid, lane, 3 * PW_DEFER_PART + (l >> 1) * (PW_DEFER_PART / 2), PW_DEFER_PART / 2, (np * 22) % GRID); }
                GRID_BAR();
                { PH_ARGS; bf16* const Hc = c == 1 ? A2 : H; SchedRows S{(const char*)Hc, (const char*)(ws + WS_W2D) + (size_t)fi * SZ_W2, (size_t)256 * FF * 2, (size_t)256 * FF * 2, np, 4, pm0, 1, WGM_DOWN, 0};
                  EpiRes<false> E{nullptr, nullptr, XR, MODL + 5 * 1024};
                  pg8::gemm_phase<EpiRes<false>, SchedRows, false>(lds, FF, FF, FF, S, E); }
                if (c == 0) GRID_BAR(); }
        } else {
            const int mi = l >> 1;
            { PH_IDS; route2_phase(p, lds, mbase, tid, wid, lane); }
            GRID_BAR();
            for (int s = 0; s < 2; ++s) { const int P0 = __builtin_amdgcn_readfirstlane(mbase[8 * s] >> 8), P1 = __builtin_amdgcn_readfirstlane(mbase[8 * s + 8] >> 8);
                const int nrem = (P1 - P0) > HCHUNK_PANELS ? (P1 - P0) - HCHUNK_PANELS : 0;
                for (int ci = 0; ci < 2; ++ci) { const int c = 1 - ci; if (c == 1 && nrem == 0) continue;
                    const int p0 = P0 + c * HCHUNK_PANELS, np = c == 1 ? nrem : ((P1 - P0) < HCHUNK_PANELS ? (P1 - P0) : HCHUNK_PANELS);
                    const int nd = c == 0 ? nrem * 4 : 0; int xl; FFN_XL(nd, np * 22, xl);
                        { PH_ARGS; bf16* const Hc = c == 1 ? A2 : H; SchedMoe S{(const char*)HX, (const char*)(ws + WS_W13M) + (size_t)mi * 8 * SZ_W13, (const int*)(ws + WS_RSRC), mbase, np, 22, p0, s, 0, SZ_W13, (size_t)256 * DM * 2, WGM_UP, nd, xl}; EpiSwi E{Hc};
                      pg8::gemm_phase<EpiSwi, SchedMoe, true>(lds, DM, DM, DM, S, E); }
                    GRID_BAR();
                    { PH_ARGS; bf16* const Hc = c == 1 ? A2 : H; SchedMoe S{(const char*)Hc, (const char*)(ws + WS_W2M) + (size_t)mi * 8 * SZ_W2, (const int*)(ws + WS_RSRC), mbase, np, 4, p0, s, 1, SZ_W2, (size_t)256 * FF * 2, WGM_DOWN};
                      EpiMoeDown E{XR, MODL + 5 * 1024, (const int*)(ws + WS_RSRC), (const float*)(ws + WS_RGATE)};
                      pg8::gemm_phase<EpiMoeDown, SchedMoe, false>(lds, FF, FF, FF, S, E); }
                    if (c == 0) GRID_BAR(); } }
        }
#undef FFN_XL
    }
    { PH_IDS; final_phase(p, wid, lane); }
#undef GRID_BAR
#undef GRID_BAR_T
#undef BX
#undef VCU
#undef MOD
#undef XR
#undef OUTB
#undef HX
#undef P
#undef H
#undef A2
#undef ZL
#undef GB
#undef MODL
}

extern "C" void kernel_launch(void* const* d_in, const int* in_sizes, int n_in, void* d_out, int out_size, void* d_ws, size_t ws_size, hipStream_t stream) {
    static int ready = 0;
    if (ready == 0) {
        if (n_in != 34 || in_sizes[0] != NB * SEQ * DM || out_size != NB * SEQ * DM || ws_size < WS_END) {
            fprintf(stderr, "kernel_launch: shape/workspace mismatch (n_in %d, x %d, out %d, ws %zu, need %zu); nothing launched\n", n_in, n_in > 0 ? in_sizes[0] : -1, out_size, ws_size, (size_t)WS_END); ready = -1; return; }
        if (hipFuncSetAttribute((const void*)dit_fwd, hipFuncAttributeMaxDynamicSharedMemorySize, LDS_BYTES) != hipSuccess) { fprintf(stderr, "kernel_launch: hipFuncSetAttribute failed\n"); ready = -1; return; }
        int per_cu = 0;
        if (hipOccupancyMaxActiveBlocksPerMultiprocessor(&per_cu, (const void*)dit_fwd, NTHREADS, LDS_BYTES) != hipSuccess || per_cu < 1) fprintf(stderr, "kernel_launch: note: occupancy query reports %d workgroups per CU\n", per_cu);
        (void)hipGetLastError();
        ready = 1;
    }
    if (ready < 0) return;
    if (hipMemsetAsync((char*)d_ws + WS_CTL, 0, (size_t)(CW_BAR + XCD_BAR_WORDS) * 4, stream) != hipSuccess) { fprintf(stderr, "kernel_launch: memset failed\n"); return; }
    Params prm{};
    for (int i = 0; i < 34; ++i) prm.in[i] = (const float*)d_in[i];
    prm.out = (float*)d_out; prm.ws = (unsigned char*)d_ws;
    hipLaunchKernelGGL(dit_fwd, dim3(GRID), dim3(NTHREADS), LDS_BYTES, stream, prm);
    const hipError_t le = hipPeekAtLastError();
    if (le != hipSuccess) fprintf(stderr, "kernel_launch: launch failed: %s\n", hipGetErrorName(le));
}
```

```cpp
#include <hip/hip_runtime.h>
#include <cstdio>
#include <cstdint>

#define GAS __attribute__((address_space(1)))
#define LAS __attribute__((address_space(3)))
typedef unsigned short bf16;
typedef short bf16x8 __attribute__((ext_vector_type(8)));
typedef short s16x4 __attribute__((ext_vector_type(4)));
typedef float f32x2 __attribute__((ext_vector_type(2)));
typedef float f32x4 __attribute__((ext_vector_type(4)));
typedef float f32x8 __attribute__((ext_vector_type(8)));
typedef float f32x16 __attribute__((ext_vector_type(16)));
typedef unsigned u32x2 __attribute__((ext_vector_type(2)));
typedef unsigned u32x4 __attribute__((ext_vector_type(4)));

constexpr int DM = 1024, NB = 16, SEQ = 4096, CTXL = 256, RB = SEQ + CTXL, NR = NB * RB, NLAYER = 4;
constexpr int INW = 2560, PW = 2304, FF = 2816, NEXP = 8;
constexpr int PC_DQ = 0, PC_DK = 512, PC_DV = 1024, PC_NQ = 1536, PC_NK = 1792, PC_NV = 2048;
constexpr int NPANEL = NR / 256, PPB = RB / 256;
constexpr int NR16 = NR / 16;
constexpr int GRID = 256, NWAVES = 8, NTHREADS = 512, NGW = GRID * NWAVES, RPW = NR / NGW;
static_assert(RPW * NGW == NR, "rows per wave");
constexpr int MOE_ROWS = 2 * NR + 4096;
constexpr int HCHUNK_PANELS = 256;

constexpr size_t al4k(size_t x) { return (x + 4095) & ~(size_t)4095; }
constexpr size_t WS_CTL = 0, CTL_BYTES = 1u << 20;
constexpr size_t WS_MOD = WS_CTL + CTL_BYTES;                          constexpr size_t SZ_MOD = (size_t)NLAYER * 17 * 6144 * 4;
constexpr size_t WS_ROPE = al4k(WS_MOD + SZ_MOD);                      constexpr size_t SZ_ROPE = 64 * 16 * 8;
constexpr size_t WS_LAM = al4k(WS_ROPE + SZ_ROPE);                     constexpr size_t SZ_LAM = 4096;
constexpr size_t WS_A16 = al4k(WS_LAM + SZ_LAM);                       constexpr size_t SZ_A16 = (size_t)NLAYER * 2 * 16 * 64 * 16;
constexpr size_t WS_S5W1 = al4k(WS_A16 + SZ_A16);                      constexpr size_t SZ_S5W1 = (size_t)NLAYER * 16 * 256 * 256 * 2;
constexpr size_t WS_S5W2 = al4k(WS_S5W1 + SZ_S5W1);                    constexpr size_t SZ_S5W2 = (size_t)NLAYER * 16 * 256 * 512 * 2;
constexpr size_t WS_WIN = al4k(WS_S5W2 + SZ_S5W2);                     constexpr size_t SZ_WIN = (size_t)NLAYER * INW * DM * 2;
constexpr size_t WS_WOUT = al4k(WS_WIN + SZ_WIN);                      constexpr size_t SZ_WOUT = (size_t)NLAYER * DM * DM * 2;
constexpr size_t WS_WGLU = al4k(WS_WOUT + SZ_WOUT);                    constexpr size_t SZ_WGLU = (size_t)NLAYER * 256 * 256 * 2;
constexpr size_t WS_W13D = al4k(WS_WGLU + SZ_WGLU);                    constexpr size_t SZ_W13 = (size_t)2 * FF * DM * 2;
constexpr size_t WS_W2D = al4k(WS_W13D + 2 * SZ_W13);                  constexpr size_t SZ_W2 = (size_t)DM * FF * 2;
constexpr size_t WS_W13M = al4k(WS_W2D + 2 * SZ_W2);
constexpr size_t WS_W2M = al4k(WS_W13M + 16 * SZ_W13);
constexpr size_t SZ_HX = (size_t)NR * DM * 2;
constexpr size_t WS_XR = al4k(WS_W2M + 16 * SZ_W2);
constexpr size_t WS_P = al4k(WS_XR + SZ_HX);                           constexpr size_t SZ_P = (size_t)NR * PW * 2;
constexpr size_t WS_H = WS_P;                                          constexpr size_t SZ_H = (size_t)HCHUNK_PANELS * 256 * FF * 2;
constexpr size_t SZ_A2 = (size_t)16 * NR16 * 512 * 2, SZ_GBUF = (size_t)NR * 256 * 2;
constexpr size_t WS_ZLOC = al4k(WS_P + SZ_P);                          constexpr size_t SZ_ZLOC = (size_t)16 * NR16 * 256 * 4;
constexpr size_t WS_TOKE = al4k(WS_ZLOC + SZ_ZLOC);                    constexpr size_t SZ_TOKE = (size_t)NR * 4;
constexpr size_t WS_TOKG = al4k(WS_TOKE + SZ_TOKE);                    constexpr size_t SZ_TOKG = (size_t)NR * 8;
constexpr size_t WS_WCNT = al4k(WS_TOKG + SZ_TOKG);                    constexpr size_t SZ_WCNT = (size_t)NGW * 16 * 4;
constexpr size_t WS_MBASE = al4k(WS_WCNT + SZ_WCNT);                   constexpr size_t SZ_MBASE = 4096;
constexpr size_t WS_RSRC = al4k(WS_MBASE + SZ_MBASE);                  constexpr size_t SZ_RSRC = (size_t)MOE_ROWS * 4;
constexpr size_t WS_RGATE = al4k(WS_RSRC + SZ_RSRC);                   constexpr size_t SZ_RGATE = (size_t)MOE_ROWS * 4;
constexpr size_t WS_END = al4k(WS_RGATE + SZ_RGATE);
constexpr size_t OUT_HX = 0, OUT_A2 = OUT_HX + SZ_HX, OUT_GBUF = OUT_A2 + SZ_A2;
static_assert(OUT_GBUF + SZ_GBUF <= (size_t)NB * SEQ * DM * 4 && OUT_A2 % 4096 == 0 && OUT_GBUF % 4096 == 0, "scratch tensors inside d_out");
static_assert(WS_ZLOC == WS_P + SZ_P && SZ_H <= SZ_P + SZ_ZLOC, "hidden chunk overlays P and Zloc (both dead during the FFN)");
static_assert(WS_END <= ((size_t)1 << 30), "workspace map must fit 1 GiB");
constexpr int CW_BAR = 4096;

constexpr int RING_BYTES = 131072;
constexpr int LDSCTL_OFF = RING_BYTES;
constexpr int MISC_OFF = LDSCTL_OFF + 320;
constexpr int LDS_BYTES = 147456;

__device__ __forceinline__ unsigned f2bf(float f) { unsigned u = __builtin_bit_cast(unsigned, f); return (u + 0x7fffu + ((u >> 16) & 1u)) >> 16; }
__device__ __forceinline__ unsigned pk2(float lo, float hi) { return f2bf(lo) | (f2bf(hi) << 16); }
__device__ __forceinline__ float bf2f(unsigned h) { return __builtin_bit_cast(float, h << 16); }
__device__ __forceinline__ unsigned cvt_pk_bf16(float lo, float hi) { unsigned r; asm volatile("v_cvt_pk_bf16_f32 %0, %1, %2" : "=v"(r) : "v"(lo), "v"(hi)); return r; }
template <int X> __device__ __forceinline__ float swz_xor(float v) { return __builtin_bit_cast(float, __builtin_amdgcn_ds_swizzle(__builtin_bit_cast(int, v), (X << 10) | 0x1f)); }
__device__ __forceinline__ float half_sum(float v) {
    v += swz_xor<1>(v); v += swz_xor<2>(v); v += swz_xor<4>(v); v += swz_xor<8>(v); v += swz_xor<16>(v); return v; }
__device__ __forceinline__ float wave_sum(float v) {
    v = half_sum(v);
    auto rr = __builtin_amdgcn_permlane32_swap(__float_as_uint(v), __float_as_uint(v), false, false);
    return __uint_as_float(rr[0]) + __uint_as_float(rr[1]);
}
__device__ __forceinline__ int bx_opaque() { int b = (int)blockIdx.x; asm volatile("" : "+s"(b)); return b; }
extern __shared__ __attribute__((aligned(16))) unsigned char lds_raw[];
constexpr int WTAB_OFF = MISC_OFF + 256;
__device__ __forceinline__ int hw_wave_slot() { return (int)(__builtin_amdgcn_s_getreg((5 << 11) | 4) & 0x3fu); }
__device__ __forceinline__ int tid_opaque() {
    const int w = __builtin_amdgcn_readfirstlane(((volatile LAS int*)((LAS unsigned char*)lds_raw + WTAB_OFF))[hw_wave_slot()]);
    unsigned z = 0u; asm volatile("" : "+s"(z));
    int t = w * 64 + (int)__builtin_amdgcn_mbcnt_hi(~0u, __builtin_amdgcn_mbcnt_lo(~0u, z)); asm volatile("" : "+v"(t)); return t; }
#define LDS_WAIT() asm volatile("s_waitcnt lgkmcnt(0)" ::: "memory")
#define VM_WAIT() asm volatile("s_waitcnt vmcnt(0)" ::: "memory")
__device__ __forceinline__ float fast_exp(float x) { return __builtin_amdgcn_exp2f(x * 1.4426950408889634f); }
__device__ __forceinline__ float sigmoidf_(float x) { return __builtin_amdgcn_rcpf(1.f + fast_exp(-x)); }
__device__ __forceinline__ float siluf_(float x) { return x * sigmoidf_(x); }
__device__ __forceinline__ float gelu_tanh(float x) {
    const float u = 0.7978845608028654f * (x + 0.044715f * x * x * x);
    return x * sigmoidf_(2.f * u);
}

#define XB_TMO      128
#define XB_XCNT(j)  (256  + 64 * (j))
#define XB_XSUB(j)  (1280 + 64 * (j))
#define XB_XGEN(j)  (2304 + 64 * (j))
#define XB_TOP      3328
#define XB_TOPGEN   3392
#define XCD_BAR_WORDS 3456
#define XB_SPIN_CAP (1u << 18)

__device__ __forceinline__ unsigned xb_ld(unsigned* p)              { return __hip_atomic_load(p, __ATOMIC_RELAXED, __HIP_MEMORY_SCOPE_AGENT); }
__device__ __forceinline__ unsigned xb_add(unsigned* p, unsigned v) { return __hip_atomic_fetch_add(p, v, __ATOMIC_RELAXED, __HIP_MEMORY_SCOPE_AGENT); }
__device__ __forceinline__ unsigned xb_xcc_id() { return (unsigned)__builtin_amdgcn_s_getreg((3 << 11) | 20) & 0xFu; }
#define XB_SPIN(cond, bar) do { unsigned _sp = 0; while (cond) { __builtin_amdgcn_s_sleep(1); \
    if ((++_sp & 255u) == 0u) { if (xb_ld(&(bar)[XB_TMO])) break; if (_sp > XB_SPIN_CAP) { atomicAdd(&(bar)[XB_TMO], 1u); break; } } } } while (0)

struct XcdBarrier {
    unsigned* bar; unsigned x;
    volatile LAS unsigned* st;
};
__device__ __forceinline__ XcdBarrier xcd_barrier_post(unsigned* bar, volatile LAS unsigned* st) {
    XcdBarrier b; b.bar = bar; b.x = xb_xcc_id(); b.st = st;
    if (threadIdx.x == 0) (void)xb_add(&bar[XB_XCNT(b.x)], 1u);
    return b;
}
__device__ __forceinline__ void xcd_barrier_complete(unsigned* bar, unsigned x, unsigned& nloc, unsigned& nx) {
    const unsigned G = gridDim.x * gridDim.y * gridDim.z;
    unsigned sum, cnt, mine, sp = 0u;
    for (;;) {
        sum = 0u; cnt = 0u; mine = 0u;
#pragma unroll
        for (unsigned j = 0; j < 16; ++j) { const unsigned c = xb_ld(&bar[XB_XCNT(j)]); sum += c; cnt += (c > 0u) ? 1u : 0u; mine = (j == x) ? c : mine; }
        if (sum == G) break;
        __builtin_amdgcn_s_sleep(1);
        if ((++sp & 255u) == 0u) { if (xb_ld(&bar[XB_TMO])) break; if (sp > XB_SPIN_CAP) { atomicAdd(&bar[XB_TMO], 1u); break; } }
    }
    nloc = mine > 0u ? mine : 1u; nx = cnt > 0u ? cnt : 1u;
}
template <bool FIRST>
__device__ __forceinline__ void xcd_barrier(const XcdBarrier& b) {
    asm volatile("s_waitcnt vmcnt(0)" ::: "memory");
    __syncthreads();
    if (threadIdx.x == 0) {
        unsigned* bar = b.bar;
        __builtin_amdgcn_s_waitcnt(0);
        unsigned nloc = b.st[0], nx = b.st[1];
        if constexpr (FIRST) { if (nloc == 0u) { xcd_barrier_complete(bar, b.x, nloc, nx); b.st[0] = nloc; b.st[1] = nx; } }
        else { nloc = nloc ? nloc : 1u; nx = nx ? nx : 1u; }
        const unsigned old = xb_add(&bar[XB_XSUB(b.x)], 1u);
        const unsigned gen = old / nloc;
        if (old + 1u == (gen + 1u) * nloc) {
            __builtin_amdgcn_fence(__ATOMIC_RELEASE, "agent");
            asm volatile("s_waitcnt vmcnt(0)" ::: "memory");
            const unsigned og = xb_add(&bar[XB_TOP], 1u);
            const unsigned tg = og / nx;
            if (og + 1u == (tg + 1u) * nx) xb_add(&bar[XB_TOPGEN], 1u);
            else XB_SPIN(xb_ld(&bar[XB_TOPGEN]) == tg, bar);
            __builtin_amdgcn_fence(__ATOMIC_ACQUIRE, "agent");
            xb_add(&bar[XB_XGEN(b.x)], 1u);
            asm volatile("s_waitcnt vmcnt(0)" ::: "memory");
        } else {
            XB_SPIN(xb_ld(&bar[XB_XGEN(b.x)]) == gen, bar);
            __builtin_amdgcn_fence(__ATOMIC_ACQUIRE, "agent");
            asm volatile("s_waitcnt vmcnt(0)" ::: "memory");
        }
    }
    __syncthreads();
}

namespace pg8 {
__device__ __forceinline__ void glds16_s(const void* sbase, unsigned voff, unsigned lds_dst) {
    unsigned keep;
    asm volatile("s_mov_b32 %0, m0\n\ts_mov_b32 m0, %3\n\ts_nop 0\n\tglobal_load_lds_dwordx4 %1, %2\n\ts_mov_b32 m0, %0" : "=&s"(keep) : "v"(voff), "s"(sbase), "s"(lds_dst) : "memory");
}
constexpr int BM = 256, BK = 64, HALF = 128, HTB = HALF * BK * 2, STAGE_BYTES = 8 * HTB, NXCD = 8;
__host__ __device__ __forceinline__ int lds_byte(int r, int c) { const int st = (r >> 4) * 2 + (c >> 5), rr = r & 15, cc = c & 31, ob = rr * 64 + cc * 2; return st * 1024 + (ob ^ (((ob >> 9) & 1) << 5)); }
__host__ __device__ __forceinline__ void stage_rc(int b, int& R, int& C) { const int st = b / 1024, sb = b % 1024, swz = sb ^ (((sb >> 9) & 1) << 5); R = (st >> 1) * 16 + swz / 64; C = (st & 1) * 32 + (swz % 64) / 2; }
__host__ __device__ __forceinline__ int perm32(int rho) { const int n = rho >> 4, i = rho & 15; return 8 * (i >> 2) + 4 * n + (i & 3); }

struct GUnit { const char* A; const char* B; int pm, pn, aux; const int* rows; };

__device__ __forceinline__ long deal_index(int i, int G, int c, int late, int xl) { return (i < xl) ? (long)i * G + c : (c < late ? -1L : (long)xl * G + (long)(i - xl) * (G - late) + (c - late)); }
__device__ __forceinline__ bool tile_order(int i, int G, int c, int nM, int nN, int WGM, int& pm, int& pn, int late = 0, int xl = 0x7fffff) {
    const int nwg = nM * nN; const long L = late ? deal_index(i, G, c, late, xl) : (long)i * G + c; if (L < 0 || L >= nwg) return false;
    int wgid = (int)L; { const int q = nwg / NXCD, r = nwg % NXCD, xcd = wgid % NXCD, off = wgid / NXCD; wgid = (xcd < r ? xcd * (q + 1) : r * (q + 1) + (xcd - r) * q) + off; }
    const int nig = WGM * nN, gid = wgid / nig, fm = gid * WGM, gsz = (nM - fm) < WGM ? (nM - fm) : WGM;
    pm = fm + ((wgid % nig) % gsz); pn = (wgid % nig) / gsz; return true;
}

template <class Epi, class Sched, bool GATHER>
__device__ __forceinline__ void gemm_phase(LAS unsigned char* lds, const int K, const int lda, const int ldb, const Sched& S, const Epi& E) {
    const int tid = tid_opaque(), wid = __builtin_amdgcn_readfirstlane(tid >> 6), lane = tid & 63, wr = wid >> 2, wc = wid & 3, fr = lane & 15, fq = lane >> 4;
    int nt = K / BK; asm volatile("" : "+s"(nt));
    int sR[2], sC[2]; unsigned voffB[2];
#pragma unroll
    for (int i = 0; i < 2; ++i) { stage_rc(tid * 16 + i * 8192, sR[i], sC[i]); const int Rb = (sR[i] & ~31) + perm32(sR[i] & 31); voffB[i] = (unsigned)(Rb * ldb + sC[i]) * 2u; }
    const size_t kstep = (size_t)(BK * 2);
    const size_t hstepB = (size_t)HALF * ldb * 2;
    const unsigned ldsb = (unsigned)(uintptr_t)lds + (unsigned)wid * 1024u;
    const int aoff = lds_byte(wr * 64 + fr, fq * 8), boff = lds_byte(wc * 32 + fr, fq * 8);
#define PG8_SA(b, h) (((b) * 2 + (h)) * HTB)
#define PG8_SB(b, h) ((4 + (b) * 2 + (h)) * HTB)
#define PG8_STAGE(bufoff, gbase, voff) do { _Pragma("unroll") for (int _i = 0; _i < 2; ++_i) \
        glds16_s((const void*)(gbase), (voff)[_i], ldsb + (unsigned)((bufoff) + _i * 8192)); } while (0)
#define PG8_LDA(dst, b, h) do { _Pragma("unroll") for (int m = 0; m < 4; ++m) _Pragma("unroll") for (int k = 0; k < 2; ++k) dst[m][k] = *(const LAS bf16x8*)(lds + PG8_SA(b, h) + aoff + m * 2048 + k * 1024); } while (0)
#define PG8_LDB(dst, b, h) do { _Pragma("unroll") for (int n = 0; n < 2; ++n) _Pragma("unroll") for (int k = 0; k < 2; ++k) dst[n][k] = *(const LAS bf16x8*)(lds + PG8_SB(b, h) + boff + n * 2048 + k * 1024); } while (0)
#define PG8_MMA(ai, bj, At, Bt) do { __builtin_amdgcn_s_setprio(1); _Pragma("unroll") for (int m = 0; m < 4; ++m) _Pragma("unroll") for (int n = 0; n < 2; ++n) _Pragma("unroll") for (int k = 0; k < 2; ++k) \
        acc[ai][bj][m][n] = __builtin_amdgcn_mfma_f32_16x16x32_bf16(Bt[n][k], At[m][k], acc[ai][bj][m][n], 0, 0, 0); __builtin_amdgcn_s_setprio(0); } while (0)
#define PG8_WAIT_V(n) asm volatile("s_waitcnt vmcnt(" #n ")" ::: "memory")
#define PG8_WAIT_L(n) asm volatile("s_waitcnt lgkmcnt(" #n ")" ::: "memory")
#define PG8_BAR __builtin_amdgcn_s_barrier()
#define PG8_SCHED __builtin_amdgcn_sched_barrier(0)
#define PG8_AOFF(dst, u) do { _Pragma("unroll") for (int _h = 0; _h < 2; ++_h) _Pragma("unroll") for (int _i = 0; _i < 2; ++_i) { \
        if constexpr (GATHER) { int _r = (u).rows[_h * HALF + sR[_i]]; _r = _r < 0 ? 0 : _r; dst[_h][_i] = (unsigned)(_r * lda + sC[_i]) * 2u; } \
        else dst[_h][_i] = (unsigned)((_h * HALF + sR[_i]) * lda + sC[_i]) * 2u; } } while (0)
    GUnit cur, nxt; int ui = 0;
    if (!S.next(0, cur)) return;
    f32x4 acc[2][2][4][2];
#pragma unroll
    for (int a = 0; a < 2; ++a)
#pragma unroll
        for (int b = 0; b < 2; ++b)
#pragma unroll
            for (int m = 0; m < 4; ++m)
#pragma unroll
                for (int n = 0; n < 2; ++n) acc[a][b][m][n] = (f32x4){0.f, 0.f, 0.f, 0.f};
    bf16x8 At[4][2], B0[2][2], B1[2][2];
    unsigned oC[2][2], oN[2][2];
    PG8_AOFF(oC, cur);
    const char* cA = cur.A; const char* cB = cur.B;
    PG8_STAGE(PG8_SB(0, 0), cB, voffB); PG8_STAGE(PG8_SB(0, 1), cB + hstepB, voffB); PG8_STAGE(PG8_SA(0, 0), cA, oC[0]); PG8_STAGE(PG8_SA(0, 1), cA, oC[1]);
    if (wr == 1) PG8_BAR;
    PG8_WAIT_V(2); PG8_BAR;
    PG8_STAGE(PG8_SB(1, 0), cB + kstep, voffB); PG8_STAGE(PG8_SA(1, 0), cA + kstep, oC[0]); PG8_STAGE(PG8_SB(1, 1), cB + hstepB + kstep, voffB);
    PG8_WAIT_V(6); PG8_BAR;
    for (;;) {
        const bool has_next = S.next(ui + 1, nxt);
        const char* nA = has_next ? nxt.A : cA; const char* nB = has_next ? nxt.B : cB;
        if (has_next) { PG8_AOFF(oN, nxt); } else {
#pragma unroll
            for (int h = 0; h < 2; ++h)
#pragma unroll
                for (int i = 0; i < 2; ++i) oN[h][i] = oC[h][i]; }
        for (int t = 0; t < nt; t += 2) {
            const bool last = (t == nt - 2);
            const char* a1 = cA + (size_t)(t + 1) * kstep;
            const char* a2 = last ? nA : cA + (size_t)(t + 2) * kstep; const char* b2 = last ? nB : cB + (size_t)(t + 2) * kstep;
            const char* a3 = a2 + kstep; const char* b3 = b2 + kstep;
            unsigned o2[2][2];
#pragma unroll
            for (int h = 0; h < 2; ++h)
#pragma unroll
                for (int i = 0; i < 2; ++i) o2[h][i] = last ? oN[h][i] : oC[h][i];
            PG8_LDB(B0, 0, 0); PG8_LDB(B1, 0, 1); PG8_SCHED; PG8_LDA(At, 0, 0); PG8_STAGE(PG8_SA(1, 1), a1, oC[1]);
            PG8_WAIT_V(8); PG8_WAIT_L(0); PG8_BAR; PG8_MMA(0, 0, At, B0); PG8_MMA(0, 1, At, B1); PG8_BAR; PG8_SCHED;
            PG8_LDA(At, 0, 1); PG8_STAGE(PG8_SB(0, 0), b2, voffB); PG8_STAGE(PG8_SB(0, 1), b2 + hstepB, voffB); PG8_STAGE(PG8_SA(0, 0), a2, o2[0]);
            PG8_WAIT_V(8); PG8_WAIT_L(0); PG8_BAR; PG8_MMA(1, 0, At, B0); PG8_MMA(1, 1, At, B1); PG8_BAR; PG8_SCHED;
            PG8_LDB(B0, 1, 0); PG8_LDB(B1, 1, 1); PG8_SCHED; PG8_LDA(At, 1, 0); PG8_STAGE(PG8_SA(0, 1), a2, o2[1]);
            PG8_WAIT_V(8); PG8_WAIT_L(0); PG8_BAR; PG8_MMA(0, 0, At, B0); PG8_MMA(0, 1, At, B1); PG8_BAR; PG8_SCHED;
            PG8_LDA(At, 1, 1); PG8_STAGE(PG8_SB(1, 0), b3, voffB); PG8_STAGE(PG8_SB(1, 1), b3 + hstepB, voffB); PG8_STAGE(PG8_SA(1, 0), a3, o2[0]);
            PG8_WAIT_V(8); PG8_WAIT_L(0); PG8_BAR; PG8_MMA(1, 0, At, B0); PG8_MMA(1, 1, At, B1); PG8_BAR; PG8_SCHED;
        }
        if (wr == 0) PG8_BAR;
        E(acc, cur, wr, wc, fr, fq);
        if (!has_next) break;
#pragma unroll
        for (int a = 0; a < 2; ++a)
#pragma unroll
            for (int b = 0; b < 2; ++b)
#pragma unroll
                for (int m = 0; m < 4; ++m)
#pragma unroll
                    for (int n = 0; n < 2; ++n) acc[a][b][m][n] = (f32x4){0.f, 0.f, 0.f, 0.f};
        cur = nxt; cA = nA; cB = nB; ++ui;
#pragma unroll
        for (int h = 0; h < 2; ++h)
#pragma unroll
            for (int i = 0; i < 2; ++i) oC[h][i] = oN[h][i];
        if (wr == 1) PG8_BAR;
    }
    PG8_WAIT_V(0);
    PG8_BAR;
#undef PG8_SA
#undef PG8_SB
#undef PG8_STAGE
#undef PG8_LDA
#undef PG8_LDB
#undef PG8_MMA
#undef PG8_WAIT_V
#undef PG8_WAIT_L
#undef PG8_BAR
#undef PG8_SCHED
#undef PG8_AOFF
}
}
namespace att {
constexpr float QSCALE = 0.125f * 1.4426950408889634f;
constexpr int SHM_V = 16384, SHM_K = 8192;
constexpr int OFF_V = 0, OFF_K = 4 * SHM_V, OFF_WS = OFF_K + 4 * SHM_K, OFF_RPB = OFF_WS + NWAVES * 64 * 4, RPB_PITCH = 128, ATT_LDS = OFF_RPB + 15 * RPB_PITCH * 4;
#define ATT_KSWZ(row, colB) ((row) * 128 + ((colB) ^ ((((row) >> 1) & 7) << 4)))
#define ATT_SBAR() __builtin_amdgcn_sched_barrier(0)
__device__ __forceinline__ int crow(int r, int hi) { return (r & 3) + 8 * (r >> 2) + 4 * hi; }

__device__ __forceinline__ void firstSM(f32x16& p0, f32x16& p1, float& mhat, f32x16& negm) {
#define ATT_MX3(a, b, c) __builtin_fmaxf(__builtin_fmaxf((a), (b)), (c))
    float a = ATT_MX3(p0[0], p0[1], p1[0]), b = ATT_MX3(p0[2], p0[3], p1[1]); a = ATT_MX3(a, p1[2], p1[3]);
#pragma unroll
    for (int r = 4; r < 16; r += 4) { a = ATT_MX3(a, p0[r], p0[r + 1]); b = ATT_MX3(b, p0[r + 2], p0[r + 3]); a = ATT_MX3(a, p1[r], p1[r + 1]); b = ATT_MX3(b, p1[r + 2], p1[r + 3]); }
#undef ATT_MX3
    float pmax = fmaxf(a, b);
    { auto rr = __builtin_amdgcn_permlane32_swap(__float_as_uint(pmax), __float_as_uint(pmax), false, false);
      pmax = fmaxf(__uint_as_float(rr[0]), __uint_as_float(rr[1])); }
    mhat += pmax;
#pragma unroll
    for (int r = 0; r < 16; ++r) { p0[r] = __builtin_amdgcn_exp2f(p0[r] - pmax); p1[r] = __builtin_amdgcn_exp2f(p1[r] - pmax); negm[r] = -mhat; }
}
__device__ __forceinline__ void sumcvt(const f32x16& p0, const f32x16& p1, float alpha, float& l_reg, bf16x8& pa0, bf16x8& pa1, bf16x8& pa2, bf16x8& pa3) {
    { f32x2 s2 = (f32x2){p0[0], p0[1]} + (f32x2){p1[0], p1[1]};
#pragma unroll
      for (int r = 2; r < 16; r += 2) { s2 += (f32x2){p0[r], p0[r + 1]}; s2 += (f32x2){p1[r], p1[r + 1]}; }
      float ps = s2[0] + s2[1];
      auto rr = __builtin_amdgcn_permlane32_swap(__float_as_uint(ps), __float_as_uint(ps), false, false);
      ps = __uint_as_float(rr[0]) + __uint_as_float(rr[1]);
      l_reg = l_reg * alpha + ps; }
#define ATT_PK4(P, BASE, OUT) do { u32x4 w = {cvt_pk_bf16(P[BASE + 0], P[BASE + 1]), cvt_pk_bf16(P[BASE + 2], P[BASE + 3]), cvt_pk_bf16(P[BASE + 4], P[BASE + 5]), cvt_pk_bf16(P[BASE + 6], P[BASE + 7])}; \
    OUT = __builtin_bit_cast(bf16x8, w); } while (0)
    ATT_PK4(p0, 0, pa0); ATT_PK4(p0, 8, pa1); ATT_PK4(p1, 0, pa2); ATT_PK4(p1, 8, pa3);
#undef ATT_PK4
}
__device__ __forceinline__ void qkt(f32x16& p0, f32x16& p1, const LAS unsigned char* Ks, const bf16x8* qr, const f32x16& negm, int r32, int hi) {
    p0 = negm; p1 = negm;
#pragma unroll
    for (int d0 = 0; d0 < 4; ++d0) { const int cb = (d0 * 16 + hi * 8) * 2;
        const bf16x8 b0 = *(const LAS bf16x8*)(Ks + ATT_KSWZ(r32, cb));
        const bf16x8 b1 = *(const LAS bf16x8*)(Ks + ATT_KSWZ(32 + r32, cb));
        p0 = __builtin_amdgcn_mfma_f32_32x32x16_bf16(b0, qr[d0], p0, 0, 0, 0);
        p1 = __builtin_amdgcn_mfma_f32_32x32x16_bf16(b1, qr[d0], p1, 0, 0, 0); }
}
__device__ __forceinline__ int v_st(int k, int c) { const int kk = k;     return ((kk >> 3) * 4 + (c >> 5)) * 512 + ((kk & 7) * 32 + (c & 31)) * 2; }
__device__ __forceinline__ int v_rd_base(int lane) { return ((lane & 3) << 3) | (((lane >> 2) & 3) << 6) | (((lane >> 4) & 1) << 5) | (((lane >> 5) & 1) << 8); }
constexpr int v_rd_off(int d0, int ks, int half) { return d0 * 512 + ks * 4096 + half * 2048; }
template <int OFF> __device__ __forceinline__ s16x4 tr_read(int vb) {
    s16x4 r; asm volatile("ds_read_b64_tr_b16 %0, %1 offset:%2" : "=&v"(r) : "v"(vb), "i"(OFF) : "memory"); return r;
}
template <int D0> __device__ __forceinline__ void pv_one(f32x16& od, int vb, bf16x8 pa0, bf16x8 pa1, bf16x8 pa2, bf16x8 pa3) {
    const s16x4 l0 = tr_read<v_rd_off(D0, 0, 0)>(vb), h0 = tr_read<v_rd_off(D0, 0, 1)>(vb), l1 = tr_read<v_rd_off(D0, 1, 0)>(vb), h1 = tr_read<v_rd_off(D0, 1, 1)>(vb);
    const s16x4 l2 = tr_read<v_rd_off(D0, 2, 0)>(vb), h2 = tr_read<v_rd_off(D0, 2, 1)>(vb), l3 = tr_read<v_rd_off(D0, 3, 0)>(vb), h3 = tr_read<v_rd_off(D0, 3, 1)>(vb);
    asm volatile("s_waitcnt lgkmcnt(0)" ::: "memory"); ATT_SBAR();
#define ATT_PKV(L, H) (bf16x8){L[0], L[1], L[2], L[3], H[0], H[1], H[2], H[3]}
    od = __builtin_amdgcn_mfma_f32_32x32x16_bf16(pa0, ATT_PKV(l0, h0), od, 0, 0, 0);
    od = __builtin_amdgcn_mfma_f32_32x32x16_bf16(pa1, ATT_PKV(l1, h1), od, 0, 0, 0);
    od = __builtin_amdgcn_mfma_f32_32x32x16_bf16(pa2, ATT_PKV(l2, h2), od, 0, 0, 0);
    od = __builtin_amdgcn_mfma_f32_32x32x16_bf16(pa3, ATT_PKV(l3, h3), od, 0, 0, 0);
#undef ATT_PKV
}
template <int DV> __device__ __forceinline__ void pv_all(f32x16* o, int vb, bf16x8 pa0, bf16x8 pa1, bf16x8 pa2, bf16x8 pa3) {
    pv_one<0>(o[0], vb, pa0, pa1, pa2, pa3); pv_one<1>(o[1], vb, pa0, pa1, pa2, pa3);
    if constexpr (DV == 128) { pv_one<2>(o[2], vb, pa0, pa1, pa2, pa3); pv_one<3>(o[3], vb, pa0, pa1, pa2, pa3); }
}

#define ATT_VADD(acc, x) asm volatile("v_add_f32 %0, %1, %0" : "+v"(acc) : "v"(x))
template <int DV> __device__ __forceinline__ float sum_tail(const f32x16& e1, const float (&sm)[4], float odd);
template <int OFF> __device__ __forceinline__ bf16x8 k_read(int addr) { bf16x8 r; asm volatile("ds_read_b128 %0, %1 offset:%2" : "=&v"(r) : "v"(addr), "i"(OFF) : "memory"); return r; }
template <int G> __device__ __forceinline__ void qk_fill(const f32x16& e0, const f32x16& e1, unsigned (&w)[16], float (&so)[2]) {
    const f32x16& e = (G < 4) ? e0 : e1; constexpr int b = (G & 3) * 4;
    typedef __bf16 bf2_t __attribute__((ext_vector_type(2)));
    w[2 * G] = __builtin_bit_cast(unsigned, __builtin_convertvector((f32x2){e[b], e[b + 1]}, bf2_t)); w[2 * G + 1] = __builtin_bit_cast(unsigned, __builtin_convertvector((f32x2){e[b + 2], e[b + 3]}, bf2_t));
    if constexpr (G == 0) { so[0] = e[b + 1]; so[1] = e[b + 3]; } else { ATT_VADD(so[0], e[b + 1]); ATT_VADD(so[1], e[b + 3]); }
}
#define ATT_KW(n, x) asm volatile("s_waitcnt lgkmcnt(" #n ")" : "+v"(x) :: "memory")
template <int DV, int KOFF, int VB>
__device__ __forceinline__ void qk_sum(f32x16& p0, f32x16& p1, const int (&ka)[4], const bf16x8* qr, const f32x16& negm, const f32x16& e0, const f32x16& e1, const float (&smi)[4], float& l_reg,
                                       bf16x8& pa0, bf16x8& pa1, bf16x8& pa2, bf16x8& pa3, int vb, s16x4 (&f)[8], bf16x8& a0, bf16x8& b0, bf16x8& a1, bf16x8& b1) {
    unsigned w[16]; float so[2];
    ATT_KW(3, a0); asm volatile("v_mfma_f32_32x32x16_bf16 %0, %1, %2, %3" : "=&v"(p0) : "v"(a0), "v"(qr[0]), "v"(negm)); qk_fill<0>(e0, e1, w, so); ATT_SBAR();
    ATT_KW(2, b0); asm volatile("v_mfma_f32_32x32x16_bf16 %0, %1, %2, %3" : "=&v"(p1) : "v"(b0), "v"(qr[0]), "v"(negm));
    a0 = k_read<KOFF>(ka[2]); b0 = k_read<KOFF + 4096>(ka[2]); qk_fill<1>(e0, e1, w, so); ATT_SBAR();
    ATT_KW(3, a1); p0 = __builtin_amdgcn_mfma_f32_32x32x16_bf16(a1, qr[1], p0, 0, 0, 0); qk_fill<2>(e0, e1, w, so); ATT_SBAR();
    ATT_KW(2, b1); p1 = __builtin_amdgcn_mfma_f32_32x32x16_bf16(b1, qr[1], p1, 0, 0, 0);
    a1 = k_read<KOFF>(ka[3]); b1 = k_read<KOFF + 4096>(ka[3]); qk_fill<3>(e0, e1, w, so); ATT_SBAR();
    ATT_KW(3, a0); p0 = __builtin_amdgcn_mfma_f32_32x32x16_bf16(a0, qr[2], p0, 0, 0, 0);
    f[0] = tr_read<VB + v_rd_off(0, 0, 0)>(vb); f[1] = tr_read<VB + v_rd_off(0, 0, 1)>(vb); f[2] = tr_read<VB + v_rd_off(0, 1, 0)>(vb); f[3] = tr_read<VB + v_rd_off(0, 1, 1)>(vb);
    qk_fill<4>(e0, e1, w, so); ATT_SBAR();
    ATT_KW(6, b0); p1 = __builtin_amdgcn_mfma_f32_32x32x16_bf16(b0, qr[2], p1, 0, 0, 0);
    f[4] = tr_read<VB + v_rd_off(0, 2, 0)>(vb); f[5] = tr_read<VB + v_rd_off(0, 2, 1)>(vb); f[6] = tr_read<VB + v_rd_off(0, 3, 0)>(vb); f[7] = tr_read<VB + v_rd_off(0, 3, 1)>(vb);
    qk_fill<5>(e0, e1, w, so); ATT_SBAR();
    ATT_KW(9, a1); p0 = __builtin_amdgcn_mfma_f32_32x32x16_bf16(a1, qr[3], p0, 0, 0, 0); qk_fill<6>(e0, e1, w, so); ATT_SBAR();
    ATT_KW(8, b1); p1 = __builtin_amdgcn_mfma_f32_32x32x16_bf16(b1, qr[3], p1, 0, 0, 0); qk_fill<7>(e0, e1, w, so); ATT_SBAR();
    l_reg += sum_tail<DV>(e1, smi, so[0] + so[1]);
    pa0 = __builtin_bit_cast(bf16x8, (u32x4){w[0], w[1], w[2], w[3]}); pa1 = __builtin_bit_cast(bf16x8, (u32x4){w[4], w[5], w[6], w[7]});
    pa2 = __builtin_bit_cast(bf16x8, (u32x4){w[8], w[9], w[10], w[11]}); pa3 = __builtin_bit_cast(bf16x8, (u32x4){w[12], w[13], w[14], w[15]});
}
template <int DV, int G> __device__ __forceinline__ void pvx_fill(f32x16& q0, f32x16& q1, float (&sm)[4]) {
    constexpr int NG = DV / 8, EPG = 32 / NG;
#define ATT_QV(i) (((i) < 16) ? q0[(i) & 15] : q1[(i) & 15])
#pragma unroll
    for (int e = 0; e < EPG; ++e) { constexpr int i0 = G * EPG; const int i = i0 + e; if (i < 16) q0[i & 15] = __builtin_amdgcn_exp2f(q0[i & 15]); else q1[i & 15] = __builtin_amdgcn_exp2f(q1[i & 15]); }
    if constexpr (G > 0) {
#pragma unroll
        for (int e = 0; e < EPG; e += 2) { const int i = (G - 1) * EPG + e;
            if (i < 4) { sm[(i >> 1) & 1] = ATT_QV(i); asm volatile("" :: "v"(ATT_QV(i + 1))); } else asm volatile("v_add_f32 %0, %1, %0" : "+v"(sm[(i >> 1) & 1]) : "v"(ATT_QV(i)), "v"(ATT_QV(i + 1))); } }
#undef ATT_QV
}
template <int DV, int D0, int VB, bool NOWAIT = false> __device__ __forceinline__ void pvx_grp(f32x16& od, int vb, bf16x8 pa0, bf16x8 pa1, bf16x8 pa2, bf16x8 pa3, s16x4 (&f)[8], f32x16& q0, f32x16& q1, float (&sm)[4]) {
    constexpr int ND = DV / 32; constexpr bool NX = (D0 + 1 < ND);
#define ATT_PKV(L, H) (bf16x8){L[0], L[1], L[2], L[3], H[0], H[1], H[2], H[3]}
#define ATT_PVGAP(KS, PA, WNX, WLAST) do { \
    if constexpr (NOWAIT) { } else if constexpr (NX) asm volatile("s_waitcnt lgkmcnt(" #WNX ")" : "+v"(f[2 * KS]), "+v"(f[2 * KS + 1]) :: "memory"); else asm volatile("s_waitcnt lgkmcnt(" #WLAST ")" : "+v"(f[2 * KS]), "+v"(f[2 * KS + 1]) :: "memory"); \
    od = __builtin_amdgcn_mfma_f32_32x32x16_bf16(PA, ATT_PKV(f[2 * KS], f[2 * KS + 1]), od, 0, 0, 0); \
    if constexpr (NX) { f[2 * KS] = tr_read<VB + v_rd_off(NX ? D0 + 1 : 0, KS, 0)>(vb); f[2 * KS + 1] = tr_read<VB + v_rd_off(NX ? D0 + 1 : 0, KS, 1)>(vb); } \
    pvx_fill<DV, D0 * 4 + KS>(q0, q1, sm); ATT_SBAR(); } while (0)
    ATT_PVGAP(0, pa0, 6, 6); ATT_PVGAP(1, pa1, 6, 4); ATT_PVGAP(2, pa2, 6, 2); ATT_PVGAP(3, pa3, 6, 0);
#undef ATT_PVGAP
#undef ATT_PKV
}
template <int DV, int VB> __device__ __forceinline__ void pv_head(f32x16* o, int vb, bf16x8 pa0, bf16x8 pa1, bf16x8 pa2, bf16x8 pa3, s16x4 (&f)[8], f32x16& q0, f32x16& q1, float (&sm)[4]) {
    ATT_SBAR();
    pvx_grp<DV, 0, VB>(o[0], vb, pa0, pa1, pa2, pa3, f, q0, q1, sm);
    if constexpr (DV == 128) { pvx_grp<DV, 1, VB>(o[1], vb, pa0, pa1, pa2, pa3, f, q0, q1, sm); pvx_grp<DV, 2, VB>(o[2], vb, pa0, pa1, pa2, pa3, f, q0, q1, sm); }
}
template <int DV, int VB> __device__ __forceinline__ void pv_tail(f32x16* o, int vb, bf16x8 pa0, bf16x8 pa1, bf16x8 pa2, bf16x8 pa3, s16x4 (&f)[8], f32x16& q0, f32x16& q1, float (&sm)[4]) {
    ATT_SBAR();
    pvx_grp<DV, DV / 32 - 1, VB, true>(o[DV / 32 - 1], vb, pa0, pa1, pa2, pa3, f, q0, q1, sm);
}
template <int DV> __device__ __forceinline__ float sum_tail(const f32x16& e1, const float (&sm)[4], float odd) {
    float ps;
    if constexpr (DV == 128) ps = ((sm[0] + sm[1]) + e1[14]) + odd;
    else ps = ((sm[0] + e1[12]) + (sm[1] + e1[14])) + odd;
    auto rr = __builtin_amdgcn_permlane32_swap(__float_as_uint(ps), __float_as_uint(ps), false, false);
    return __uint_as_float(rr[0]) + __uint_as_float(rr[1]);
}
__device__ __forceinline__ unsigned na_colmask(int cq, int hi) {
    const int cst = min(max(cq - 8, 0), 48); unsigned m = 0u;
#pragma unroll
    for (int r = 0; r < 16; ++r) { const int kc = crow(r, hi); if (!((unsigned)(kc - cst) < 16u)) m |= 1u << r; if (!((unsigned)(kc + 32 - cst) < 16u)) m |= 1u << (16 + r); }
    return m;
}
__device__ __forceinline__ void na_mask(f32x16& p0, f32x16& p1, int krow, int qrow, int cq, int hi, unsigned cmi, const LAS float* tbl) {
    const int start = min(max(qrow - 4, 0), 56);
    if ((krow >= start) && (krow < start + 8)) {
        const LAS float* tb = tbl + (krow - qrow + 7) * RPB_PITCH + (63 - cq + 4 * hi);
#pragma unroll
        for (int r = 0; r < 16; ++r) { const int cr = (r & 3) + 8 * (r >> 2);
            const float pen0 = __uint_as_float((unsigned)__builtin_amdgcn_sbfe(cmi, r, 1) & 0xF149F2CAu), pen1 = __uint_as_float((unsigned)__builtin_amdgcn_sbfe(cmi, 16 + r, 1) & 0xF149F2CAu);
            p0[r] = (p0[r] + tb[cr]) + pen0; p1[r] = (p1[r] + tb[cr + 32]) + pen1; }
    } else {
#pragma unroll
        for (int r = 0; r < 16; ++r) { p0[r] = -1e30f; p1[r] = -1e30f; }
    }
}

template <int DV, int MODE>
__device__ __forceinline__ void attn_body(const bf16* __restrict__ Qp, const bf16* __restrict__ Kp, const bf16* __restrict__ Vp, int baseA, int nA, int baseB, int NT,
                                          LAS unsigned char* lds, f32x16 (&o)[DV / 32], int qrow, int kmin, unsigned long long* dbg = nullptr, const bf16* KpN = nullptr, const bf16* VpN = nullptr, bool pre_in = false) {
    const int tid = tid_opaque(), wid = __builtin_amdgcn_readfirstlane(tid >> 6), lane = tid & 63, r32 = lane & 31, hi = lane >> 5;
    LAS unsigned char* V_lds = lds + OFF_V; LAS unsigned char* K_lds = lds + OFF_K;
    LAS float* al_l = (LAS float*)(lds + OFF_WS) + wid * 64; LAS float* li_l = al_l + 32;
    const LAS float* tbl = (const LAS float*)(lds + OFF_RPB);
    const int cq = (wid & 1) * 32 + r32; const unsigned cmi = (MODE == 1) ? na_colmask(cq, hi) : 0u;
    float mhat = 0.f, l_reg = 0.f; f32x16 negm = f32x16{}; bf16x8 qr[4];
#pragma unroll
    for (int d = 0; d < DV / 32; ++d) o[d] = f32x16{};
    { const bf16* Qw = Qp + (size_t)(wid * 32 + r32) * PW + hi * 8;
#pragma unroll
      for (int d0 = 0; d0 < 4; ++d0) qr[d0] = *(const bf16x8*)(Qw + d0 * 16); }
    const int kr = tid >> 3;
    const unsigned voffK = (unsigned)(kr * PW + (((tid & 7) ^ ((kr >> 1) & 7)) * 8)) * 2u;
    const unsigned voffV = (DV == 128) ? (unsigned)((8 * (wid >> 1) + ((lane & 31) >> 2)) * PW + (2 * (wid & 1) + (lane >> 5)) * 32 + (lane & 3) * 8) * 2u
                                       : (unsigned)((8 * wid + ((lane & 31) >> 2)) * PW + (lane >> 5) * 32 + (lane & 3) * 8) * 2u;
    const unsigned ldsK = (unsigned)(uintptr_t)K_lds + (unsigned)wid * 1024u, ldsV = (unsigned)(uintptr_t)V_lds + (unsigned)wid * ((DV == 128) ? 1024u : 2048u);
    const int vb0 = (int)(unsigned)(uintptr_t)V_lds + v_rd_base(lane);
#define ATT_TROW(t) ((t) < nA ? baseA + 64 * (t) : baseB + 64 * ((t) - nA))
#define ATT_DMAV(vb, t) do { const char* vs_ = (const char*)(Vp + (size_t)ATT_TROW(t) * PW); pg8::glds16_s(vs_, voffV, ldsV + (vb) * SHM_V); \
    if constexpr (DV == 128) pg8::glds16_s(vs_ + (size_t)32 * PW * 2, voffV, ldsV + (vb) * SHM_V + 8192); } while (0)
#define ATT_DMAK(kb, t) do { pg8::glds16_s((const char*)(Kp + (size_t)ATT_TROW(t) * PW), voffK, ldsK + (kb) * SHM_K); } while (0)
#define ATT_SLOT_END() do { asm volatile("s_waitcnt vmcnt(0)" ::: "memory"); asm volatile("s_waitcnt lgkmcnt(0)" ::: "memory"); __builtin_amdgcn_s_barrier(); ATT_SBAR(); } while (0)
#define ATT_MASK(P0, P1, t) do { if constexpr (MODE == 1) { if ((t) >= nA) na_mask(P0, P1, kmin + (t) - nA, qrow, cq, hi, cmi, tbl); } } while (0)
    f32x16 pA0, pA1, pB0, pB1; bf16x8 pa0, pa1, pa2, pa3, ka0, kb0, ka1, kb1; s16x4 vf[8]; float sm[4];
    int ka[4];
#pragma unroll
    for (int d0 = 0; d0 < 4; ++d0) ka[d0] = (int)(unsigned)(uintptr_t)K_lds + ATT_KSWZ(r32, (d0 * 16 + hi * 8) * 2);
#define ATT_KPRE(KOFF) do { ka0 = k_read<KOFF>(ka[0]); kb0 = k_read<KOFF + 4096>(ka[0]); ka1 = k_read<KOFF>(ka[1]); kb1 = k_read<KOFF + 4096>(ka[1]); } while (0)
    __syncthreads();
    if (!pre_in) { ATT_DMAK(0, 0); ATT_DMAK(1, 1); ATT_DMAV(0, 0); }
    ATT_SLOT_END();
    if (!pre_in) { ATT_DMAK(2, 2); ATT_DMAK(3, 3); ATT_DMAV(1, 1); ATT_DMAV(2, 2); }
    qkt(pA0, pA1, K_lds, qr, negm, r32, hi); ATT_MASK(pA0, pA1, 0); firstSM(pA0, pA1, mhat, negm);
    { constexpr int NL = (DV == 128) ? 14 : 12; float t0 = 0.f, t1 = 0.f;
#pragma unroll
      for (int r = 0; r < 16; r += 4) { t0 += pA0[r]; t1 += pA0[r + 2]; }
#pragma unroll
      for (int r = 0; r < NL; r += 2) { if (r & 2) t1 += pA1[r]; else t0 += pA1[r]; }
      sm[0] = t0; sm[1] = t1; sm[2] = 0.f; sm[3] = 0.f; }
    ATT_KPRE(SHM_K); ATT_SBAR();
    qk_sum<DV, SHM_K, 0>(pB0, pB1, ka, qr, negm, pA0, pA1, sm, l_reg, pa0, pa1, pa2, pa3, vb0, vf, ka0, kb0, ka1, kb1); ATT_MASK(pB0, pB1, 1);
#ifdef ATT_PROBE
    const unsigned long long tc0 = __builtin_amdgcn_s_memtime();
#endif
#define ATT_STEP_BAR(VH, KQ, VN, QE0, QE1, QN0, QN1, tq, DMAS) do { \
        pv_head<DV, (VH) * SHM_V>(o, vb0, pa0, pa1, pa2, pa3, vf, QE0, QE1, sm); \
        ATT_SLOT_END(); ATT_KPRE((KQ) * SHM_K); ATT_SBAR(); \
        pv_tail<DV, (VH) * SHM_V>(o, vb0, pa0, pa1, pa2, pa3, vf, QE0, QE1, sm); DMAS; ATT_SBAR(); \
        qk_sum<DV, (KQ) * SHM_K, (VN) * SHM_V>(QN0, QN1, ka, qr, negm, QE0, QE1, sm, l_reg, pa0, pa1, pa2, pa3, vb0, vf, ka0, kb0, ka1, kb1); ATT_MASK(QN0, QN1, tq); } while (0)
#define ATT_STEP_NOBAR(VH, KQ, VN, QE0, QE1, QN0, QN1, tq, DMAS) do { \
        pv_head<DV, (VH) * SHM_V>(o, vb0, pa0, pa1, pa2, pa3, vf, QE0, QE1, sm); \
        ATT_KPRE((KQ) * SHM_K); asm volatile("s_waitcnt lgkmcnt(4)" ::: "memory"); ATT_SBAR();     \
        pv_tail<DV, (VH) * SHM_V>(o, vb0, pa0, pa1, pa2, pa3, vf, QE0, QE1, sm); DMAS; ATT_SBAR(); \
        qk_sum<DV, (KQ) * SHM_K, (VN) * SHM_V>(QN0, QN1, ka, qr, negm, QE0, QE1, sm, l_reg, pa0, pa1, pa2, pa3, vb0, vf, ka0, kb0, ka1, kb1); ATT_MASK(QN0, QN1, tq); } while (0)
    int t = 0;
    for (; t + 4 < NT; t += 4) {
        ATT_STEP_BAR(0, 2, 1, pB0, pB1, pA0, pA1, t + 2, { ATT_DMAV(3, t + 3); ATT_DMAK(0, t + 4); });
        ATT_STEP_NOBAR(1, 3, 2, pA0, pA1, pB0, pB1, t + 3, { ATT_DMAV(0, t + 4); ATT_DMAK(1, t + 5); });
        ATT_STEP_BAR(2, 0, 3, pB0, pB1, pA0, pA1, t + 4, { ATT_DMAV(1, t + 5); ATT_DMAK(2, t + 6); });
        ATT_STEP_NOBAR(3, 1, 0, pA0, pA1, pB0, pB1, t + 5, { ATT_DMAV(2, t + 6); ATT_DMAK(3, t + 7); });
    }
#ifdef ATT_PROBE
    if (DV == 128 && dbg && lane == 0 && wid == 0) { atomicAdd(dbg + 0, __builtin_amdgcn_s_memtime() - tc0); atomicAdd(dbg + 1, (unsigned long long)(NT - 4)); }
#endif
    ATT_STEP_BAR(0, 2, 1, pB0, pB1, pA0, pA1, t + 2, { ATT_DMAV(3, t + 3); });
    ATT_STEP_NOBAR(1, 3, 2, pA0, pA1, pB0, pB1, t + 3, { });
    pv_head<DV, 2 * SHM_V>(o, vb0, pa0, pa1, pa2, pa3, vf, pB0, pB1, sm);
    ATT_SLOT_END(); ATT_SBAR();
    if (KpN) {
#define ATT_DMAVN(vb, t) do { const char* vs_ = (const char*)(VpN + (size_t)ATT_TROW(t) * PW); pg8::glds16_s(vs_, voffV, ldsV + (vb) * SHM_V); \
    if constexpr (DV == 128) pg8::glds16_s(vs_ + (size_t)32 * PW * 2, voffV, ldsV + (vb) * SHM_V + 8192); } while (0)
#define ATT_DMAKN(kb, t) do { pg8::glds16_s((const char*)(KpN + (size_t)ATT_TROW(t) * PW), voffK, ldsK + (kb) * SHM_K); } while (0)
        ATT_DMAKN(0, 0); ATT_DMAKN(1, 1); ATT_DMAVN(0, 0); ATT_DMAKN(2, 2); ATT_DMAKN(3, 3); ATT_DMAVN(1, 1); ATT_DMAVN(2, 2); ATT_SBAR();
#undef ATT_DMAVN
#undef ATT_DMAKN
    }
    pv_tail<DV, 2 * SHM_V>(o, vb0, pa0, pa1, pa2, pa3, vf, pB0, pB1, sm);
    { float od = 0.f;
#pragma unroll
      for (int r = 1; r < 16; r += 2) od += pB0[r] + pB1[r];
      l_reg += sum_tail<DV>(pB1, sm, od); }
    { float dummy = 0.f; sumcvt(pB0, pB1, 1.f, dummy, pa0, pa1, pa2, pa3); } ATT_SBAR();
    pv_all<DV>(o, vb0 + 3 * SHM_V, pa0, pa1, pa2, pa3);
#undef ATT_STEP_BAR
#undef ATT_STEP_NOBAR
#undef ATT_KPRE
    if (hi == 0) li_l[r32] = l_reg; asm volatile("s_waitcnt lgkmcnt(0)" ::: "memory");
#pragma unroll
    for (int r = 0; r < 16; ++r) { const float rl = __builtin_amdgcn_rcpf(li_l[crow(r, hi)]);
#pragma unroll
        for (int d = 0; d < DV / 32; ++d) o[d][r] *= rl; }
#undef ATT_TROW
#undef ATT_DMAV
#undef ATT_DMAK
#undef ATT_SLOT_END
#undef ATT_MASK
}
}
struct Params { const float* in[34]; float* out; unsigned char* ws; };
#define CAS __attribute__((address_space(4)))
struct KA { const CAS unsigned char* k;
    __device__ __forceinline__ const float* in(int i) const { return *(const float* const CAS*)(k + 8 * i); }
    __device__ __forceinline__ float* out() const { return *(float* const CAS*)(k + 8 * 34); }
    __device__ __forceinline__ unsigned char* ws() const { return *(unsigned char* const CAS*)(k + 8 * 35); } };
enum { I_X = 0, I_C, I_CTX, I_CCTX, I_WMOD, I_BMOD, I_GMIX, I_GFFN, I_WIN, I_WOUT, I_LAMRE, I_LAMIM, I_BRE, I_BIM, I_CRE, I_CIM, I_LOGSTEP, I_SSMD, I_WGLU, I_BGLU,
       I_LQ1, I_LK1, I_LQ2, I_LK2, I_SUBLN, I_RPB, I_FW1, I_FW3, I_FW2, I_ROUTER, I_MW1, I_MW3, I_MW2, I_GFINAL };

__device__ __forceinline__ size_t res_off(int r, bool& is_ctx) { const int b = r / RB, n = r - b * RB; is_ctx = n >= SEQ; return is_ctx ? ((size_t)b * CTXL + (n - SEQ)) * DM : ((size_t)b * SEQ + n) * DM; }

using pg8::GUnit;
#define EPI_ROWS_COLS const int row0 = wr * 64 + fr, col0 = wc * 32 + 8 * fq
__device__ __forceinline__ u32x4 pack8(f32x4 a, f32x4 b) { u32x4 w; w.x = cvt_pk_bf16(a[0], a[1]); w.y = cvt_pk_bf16(a[2], a[3]); w.z = cvt_pk_bf16(b[0], b[1]); w.w = cvt_pk_bf16(b[2], b[3]); return w; }

struct EpiInProj {
    bf16* P; bf16* A2; const float* rope;
    __device__ __forceinline__ void operator()(const f32x4 (&acc)[2][2][4][2], const GUnit& u, int wr, int wc, int fr, int fq) const {
        EPI_ROWS_COLS; const int pl = u.pm % PPB; const bool lat = pl < 16;
        if (u.pn == 0) {
#pragma unroll
            for (int ai = 0; ai < 2; ++ai)
#pragma unroll
                for (int m = 0; m < 4; ++m) { const int r = u.pm * 256 + ai * 128 + row0 + m * 16;
#pragma unroll
                    for (int bj = 0; bj < 2; ++bj) { const int c = bj * 128 + col0, g = c >> 4, h0 = c & 15;
                        *(u32x4*)(A2 + ((size_t)g * NR16 + (r >> 4)) * 512 + 256 + (r & 15) * 16 + h0) = pack8(acc[ai][bj][m][0], acc[ai][bj][m][1]); } }
        } else {
            const bool rope_on = lat && u.pn <= 4; const int pcol0 = u.pn * 256 - 256;
            const float qs = (u.pn <= 2 || u.pn == 7) ? att::QSCALE : 1.f;
#pragma unroll
            for (int ai = 0; ai < 2; ++ai)
#pragma unroll
                for (int m = 0; m < 4; ++m) { const int rl = ai * 128 + row0 + m * 16, r = u.pm * 256 + rl, t = pl * 256 + rl;
#pragma unroll
                    for (int bj = 0; bj < 2; ++bj) { const int c = bj * 128 + col0; f32x4 v0 = acc[ai][bj][m][0] * qs, v1 = acc[ai][bj][m][1] * qs;
                        if (rope_on) { const int i0 = (c & 63) >> 1, axis = i0 >> 4, k0 = i0 & 15, pos = axis ? (t & 63) : (t >> 6);
                            const f32x4 cs0 = *(const f32x4*)(rope + (pos * 16 + k0) * 2), cs1 = *(const f32x4*)(rope + (pos * 16 + k0) * 2 + 4);
                            f32x4 w0, w1;
                            w0[0] = v0[0] * cs0[0] - v0[1] * cs0[1]; w0[1] = v0[0] * cs0[1] + v0[1] * cs0[0];
                            w0[2] = v0[2] * cs0[2] - v0[3] * cs0[3]; w0[3] = v0[2] * cs0[3] + v0[3] * cs0[2];
                            w1[0] = v1[0] * cs1[0] - v1[1] * cs1[1]; w1[1] = v1[0] * cs1[1] + v1[1] * cs1[0];
                            w1[2] = v1[2] * cs1[2] - v1[3] * cs1[3]; w1[3] = v1[2] * cs1[3] + v1[3] * cs1[2];
                            v0 = w0; v1 = w1; }
                        *(u32x4*)(P + (size_t)r * PW + pcol0 + c) = pack8(v0, v1); } }
        }
    }
};
struct EpiZ {
    float* Z;
    __device__ __forceinline__ void operator()(const f32x4 (&acc)[2][2][4][2], const GUnit& u, int wr, int wc, int fr, int fq) const {
        EPI_ROWS_COLS;
#pragma unroll
        for (int ai = 0; ai < 2; ++ai)
#pragma unroll
            for (int m = 0; m < 4; ++m) { float* rp = Z + ((size_t)u.aux * NR16 + u.pm * 256 + ai * 128 + row0 + m * 16) * 256;
#pragma unroll
                for (int bj = 0; bj < 2; ++bj) { *(f32x4*)(rp + bj * 128 + col0) = acc[ai][bj][m][0]; *(f32x4*)(rp + bj * 128 + col0 + 4) = acc[ai][bj][m][1]; } }
    }
};
struct EpiY {
    bf16* G;
    __device__ __forceinline__ void operator()(const f32x4 (&acc)[2][2][4][2], const GUnit& u, int wr, int wc, int fr, int fq) const {
        EPI_ROWS_COLS;
#pragma unroll
        for (int ai = 0; ai < 2; ++ai)
#pragma unroll
            for (int m = 0; m < 4; ++m) { const int r16 = u.pm * 256 + ai * 128 + row0 + m * 16;
#pragma unroll
                for (int bj = 0; bj < 2; ++bj) { const int c = bj * 128 + col0, i = c >> 4, h0 = c & 15; f32x4 v0 = acc[ai][bj][m][0], v1 = acc[ai][bj][m][1];
#pragma unroll
                    for (int k = 0; k < 4; ++k) { v0[k] = gelu_tanh(v0[k]); v1[k] = gelu_tanh(v1[k]); }
                    *(u32x4*)(G + ((size_t)r16 * 16 + i) * 256 + u.aux * 16 + h0) = pack8(v0, v1); } }
    }
};
struct EpiGlu {
    const bf16* G; bf16* Y; const float* bglu;
    __device__ __forceinline__ void operator()(const f32x4 (&acc)[2][2][4][2], const GUnit& u, int wr, int wc, int fr, int fq) const {
        EPI_ROWS_COLS;
#pragma unroll
        for (int bj = 0; bj < 2; ++bj) { const int c = bj * 128 + col0; const f32x4 b0 = *(const f32x4*)(bglu + c), b1 = *(const f32x4*)(bglu + c + 4);
#pragma unroll
            for (int ai = 0; ai < 2; ++ai)
#pragma unroll
                for (int m = 0; m < 4; ++m) { const size_t r = (size_t)u.pm * 256 + ai * 128 + row0 + m * 16;
                    const u32x4 gw = *(const u32x4*)(G + r * 256 + c); f32x4 v0 = acc[ai][bj][m][0] + b0, v1 = acc[ai][bj][m][1] + b1;
                    v0[0] = bf2f(gw.x & 0xffffu) * sigmoidf_(v0[0]); v0[1] = bf2f(gw.x >> 16) * sigmoidf_(v0[1]); v0[2] = bf2f(gw.y & 0xffffu) * sigmoidf_(v0[2]); v0[3] = bf2f(gw.y >> 16) * sigmoidf_(v0[3]);
                    v1[0] = bf2f(gw.z & 0xffffu) * sigmoidf_(v1[0]); v1[1] = bf2f(gw.z >> 16) * sigmoidf_(v1[1]); v1[2] = bf2f(gw.w & 0xffffu) * sigmoidf_(v1[2]); v1[3] = bf2f(gw.w >> 16) * sigmoidf_(v1[3]);
                    *(u32x4*)(Y + r * DM + c) = pack8(v0, v1); } }
    }
};
template <bool F32SRC>
struct EpiRes {
    const float* srcL; const float* srcC; bf16* XR; const float* gate;
    __device__ __forceinline__ void operator()(const f32x4 (&acc)[2][2][4][2], const GUnit& u, int wr, int wc, int fr, int fq) const {
        EPI_ROWS_COLS; const int b = u.pm / PPB, pl = u.pm - b * PPB; const bool isc = pl >= 16;
        const float* src = isc ? srcC + (size_t)b * CTXL * DM : srcL + ((size_t)b * SEQ + pl * 256) * DM; bf16* dst = XR + (size_t)u.pm * 256 * DM; const float* gv = gate + (isc ? 16 : b) * 6144;
        if constexpr (F32SRC) {
#pragma unroll
            for (int bj = 0; bj < 2; ++bj) { const int c = u.pn * 256 + bj * 128 + col0; const f32x4 g0 = *(const f32x4*)(gv + c), g1 = *(const f32x4*)(gv + c + 4);
#pragma unroll
                for (int ai = 0; ai < 2; ++ai)
#pragma unroll
                    for (int m = 0; m < 4; ++m) { const size_t o = (size_t)(ai * 128 + row0 + m * 16) * DM + c; const f32x4 x0 = *(const f32x4*)(src + o), x1 = *(const f32x4*)(src + o + 4);
                        *(u32x4*)(dst + o) = pack8(x0 + g0 * acc[ai][bj][m][0], x1 + g1 * acc[ai][bj][m][1]); } }
        } else {
            u32x4 xw[2][2][4];
#pragma unroll
            for (int bj = 0; bj < 2; ++bj)
#pragma unroll
                for (int ai = 0; ai < 2; ++ai)
#pragma unroll
                    for (int m = 0; m < 4; ++m) xw[bj][ai][m] = *(const u32x4*)(dst + (size_t)(ai * 128 + row0 + m * 16) * DM + u.pn * 256 + bj * 128 + col0);
#pragma unroll
            for (int bj = 0; bj < 2; ++bj) { const int c = u.pn * 256 + bj * 128 + col0; const f32x4 g0 = *(const f32x4*)(gv + c), g1 = *(const f32x4*)(gv + c + 4);
#pragma unroll
                for (int ai = 0; ai < 2; ++ai)
#pragma unroll
                    for (int m = 0; m < 4; ++m) { const size_t o = (size_t)(ai * 128 + row0 + m * 16) * DM + c; const u32x4 w = xw[bj][ai][m];
                        const f32x4 x0 = {bf2f(w.x & 0xffffu), bf2f(w.x >> 16), bf2f(w.y & 0xffffu), bf2f(w.y >> 16)}, x1 = {bf2f(w.z & 0xffffu), bf2f(w.z >> 16), bf2f(w.w & 0xffffu), bf2f(w.w >> 16)};
                        *(u32x4*)(dst + o) = pack8(x0 + g0 * acc[ai][bj][m][0], x1 + g1 * acc[ai][bj][m][1]); } }
        }
    }
};
struct EpiSwi {
    bf16* H;
    __device__ __forceinline__ void operator()(const f32x4 (&acc)[2][2][4][2], const GUnit& u, int wr, int wc, int fr, int fq) const {
        EPI_ROWS_COLS; const int c = u.pn * 128 + col0;
#pragma unroll
        for (int ai = 0; ai < 2; ++ai)
#pragma unroll
            for (int m = 0; m < 4; ++m) { const size_t r = (size_t)u.aux * 256 + ai * 128 + row0 + m * 16; f32x4 v[2];
#pragma unroll
                for (int n = 0; n < 2; ++n) { const f32x4 g = acc[ai][0][m][n], up = acc[ai][1][m][n];
                    const f32x4 e = {__builtin_amdgcn_exp2f(g[0]), __builtin_amdgcn_exp2f(g[1]), __builtin_amdgcn_exp2f(g[2]), __builtin_amdgcn_exp2f(g[3])};
                    const f32x4 d = e + 1.f; const f32x4 rr = {__builtin_amdgcn_rcpf(d[0]), __builtin_amdgcn_rcpf(d[1]), __builtin_amdgcn_rcpf(d[2]), __builtin_amdgcn_rcpf(d[3])};
                    v[n] = (g * up) * rr; }
                *(u32x4*)(H + r * FF + c) = pack8(v[0], v[1]); }
    }
};
struct EpiMoeDown {
    bf16* XR; const float* gate; const int* rsrc; const float* rgate;
    __device__ __forceinline__ void operator()(const f32x4 (&acc)[2][2][4][2], const GUnit& u, int wr, int wc, int fr, int fq) const {
        EPI_ROWS_COLS;
#pragma unroll
        for (int ai = 0; ai < 2; ++ai)
#pragma unroll
            for (int m = 0; m < 4; ++m) { const int pos = u.aux + ai * 128 + row0 + m * 16; const int tok = rsrc[pos];
                if (tok >= 0) { const float rg = rgate[pos]; const int b = tok / RB; const bool isc = (tok - b * RB) >= SEQ; bf16* dst = XR + (size_t)tok * DM; const float* gv = gate + (isc ? 16 : b) * 6144;
#pragma unroll
                    for (int bj = 0; bj < 2; ++bj) { const int c = u.pn * 256 + bj * 128 + col0;
                        const f32x4 g0 = *(const f32x4*)(gv + c) * rg, g1 = *(const f32x4*)(gv + c + 4) * rg; const u32x4 w = *(const u32x4*)(dst + c);
                        const f32x4 x0 = {bf2f(w.x & 0xffffu), bf2f(w.x >> 16), bf2f(w.y & 0xffffu), bf2f(w.y >> 16)}, x1 = {bf2f(w.z & 0xffffu), bf2f(w.z >> 16), bf2f(w.w & 0xffffu), bf2f(w.w >> 16)};
                        *(u32x4*)(dst + c) = pack8(x0 + g0 * acc[ai][bj][m][0], x1 + g1 * acc[ai][bj][m][1]); } } }
    }
};

struct SchedRows {
    const char* A; const char* B; size_t a_tile, b_tile; int nM, nN, pm0, a_local, wgm, lat_only, late = 0, xl = 0;
    __device__ __forceinline__ bool next(int i, GUnit& u) const { int pm, pn; if (!pg8::tile_order(i, GRID, bx_opaque(), nM, nN, wgm, pm, pn, late, xl)) return false;
        u.pm = lat_only ? pm + (pm >> 4) : pm0 + pm; u.pn = pn; u.aux = pm; u.rows = nullptr; u.A = A + (size_t)(a_local ? pm : u.pm) * a_tile; u.B = B + (size_t)pn * b_tile; return true; }
};
struct SchedS5 {
    const char* A; const char* B; size_t b_group; int mix = 0;
    __device__ __forceinline__ bool next(int i, GUnit& u) const { int L;
        if (!mix) L = i * GRID + bx_opaque();
        else { const int bx = bx_opaque(), vcu = (bx & 7) * (GRID / 8) + (bx >> 3), q = vcu & 31, gr = vcu >> 5;
            if ((unsigned)(q - 2) < 8u) return false;
            if ((unsigned)(q - 10) < 8u) { if (i > 0) return false; L = 208 + gr * 8 + (q - 10); }
            else { const int k = gr * 16 + (q < 2 ? q : q - 16); if (i > 1) return false; L = i * 128 + k; if (i == 1 && L >= 208) return false; } }
        if (L >= 17 * 16) return false;
        const int g = L & 15, pm = L >> 4; u.pm = pm; u.pn = 0; u.aux = g; u.rows = nullptr;
        u.A = A + ((size_t)g * NR16 + (size_t)pm * 256) * 512 * 2; u.B = B + (size_t)g * b_group; return true; }
};
struct SchedMoe {
    const char* A; const char* B; const int* rsrc; const LAS int* mbase; int np, nN, p0, slot, down; size_t b_exp, b_tile; int wgm, late = 0, xl = 0;
    __device__ __forceinline__ bool next(int i, GUnit& u) const { int pm, pn; if (!pg8::tile_order(i, GRID, bx_opaque(), np, nN, wgm, pm, pn, late, xl)) return false;
        const int gp = p0 + pm; int e = 0;
#pragma unroll
        for (int k = 1; k < 8; ++k) e += (gp * 256 >= mbase[slot * 8 + k]) ? 1 : 0;
        e = __builtin_amdgcn_readfirstlane(e);
        u.pm = gp; u.pn = pn; u.B = B + (size_t)e * b_exp + (size_t)pn * b_tile;
        if (down) { u.aux = gp * 256; u.rows = nullptr; u.A = A + (size_t)pm * 256 * FF * 2; }
        else { u.aux = pm; u.rows = rsrc + (size_t)gp * 256; u.A = A; }
        return true; }
};
__device__ __forceinline__ void transpose_item(const float* __restrict__ W, int N, bf16* __restrict__ WT, int Kd, int dst_row0, int k0, int n0, LAS float* scr, int lane, float scale = 1.f) {
    { const int kq = lane >> 3, n4 = (lane & 7) * 4; f32x4 v[8];
#pragma unroll
      for (int i = 0; i < 8; ++i) v[i] = *(const f32x4*)(W + (size_t)(k0 + kq + 8 * i) * N + n0 + n4);
#pragma unroll
      for (int i = 0; i < 8; ++i) { LAS float* d = scr + (kq + 8 * i) * 33 + n4; d[0] = v[i][0] * scale; d[1] = v[i][1] * scale; d[2] = v[i][2] * scale; d[3] = v[i][3] * scale; } }
    LDS_WAIT(); asm volatile("" ::: "memory");
    const int c = lane & 7;
#pragma unroll
    for (int j = 0; j < 4; ++j) { const int n = (lane >> 3) + 8 * j; const LAS float* s = scr + (8 * c) * 33 + n;
        u32x4 o; o.x = pk2(s[0 * 33], s[1 * 33]); o.y = pk2(s[2 * 33], s[3 * 33]); o.z = pk2(s[4 * 33], s[5 * 33]); o.w = pk2(s[6 * 33], s[7 * 33]);
        *(u32x4*)(WT + (size_t)(dst_row0 + n) * Kd + k0 + 8 * c) = o; }
    LDS_WAIT(); asm volatile("" ::: "memory");
}
constexpr int PW_PER_LAYER = 1280 + 512 + 32, PW_N_A = NLAYER * PW_PER_LAYER, PW_PER_F = 3 * 1408;
__device__ __forceinline__ void ffn_item(const KA& p, int r0, LAS float* scr, int lane) {
    unsigned char* ws = p.ws();
    const int f = r0 / PW_PER_F, r = r0 - f * PW_PER_F, which = r / 1408, q = r - which * 1408;
    const bool dense = f < 2; const int mi = dense ? f : f - 2;
    const size_t wo = (size_t)mi * DM * FF;
    if (which < 2) { const float* W = (which == 0 ? (dense ? p.in(I_FW1) : p.in(I_MW1)) : (dense ? p.in(I_FW3) : p.in(I_MW3))) + wo;
        bf16* WT = (bf16*)(ws + (dense ? WS_W13D : WS_W13M) + (size_t)mi * SZ_W13);
        const int kb = q / 88, nb = q % 88, n0 = 32 * nb;
        transpose_item(W, FF, WT, DM, (n0 >> 7) * 256 + which * 128 + (n0 & 127), 64 * kb, n0, scr, lane, which == 0 ? -1.4426950408889634f : -0.6931471805599453f);
    } else { const float* W = (dense ? p.in(I_FW2) : p.in(I_MW2)) + wo; bf16* WT = (bf16*)(ws + (dense ? WS_W2D : WS_W2M) + (size_t)mi * SZ_W2);
        const int kb = q / 32, nb = q % 32; transpose_item(W, DM, WT, FF, 32 * nb, 64 * kb, 32 * nb, scr, lane); }
}
constexpr int PW_INPROJ_PART = 3584;
constexpr int PW_PROLOGUE_F = 10;
constexpr int PW_DEFER_ITEMS = 8 * PW_PER_F, PW_DEFER_PART = PW_DEFER_ITEMS / 4;
static_assert(PW_DEFER_ITEMS % 4 == 0, "deferred items split in four");
__device__ __forceinline__ void prologue_weights(const KA& p, LAS unsigned char* lds, int wid, int lane) {
    LAS float* scr = (LAS float*)(lds + wid * 16384);
    const int bx = bx_opaque(); if (bx >= 128 && bx < 192) return;
    const int gw = (bx < 128 ? bx : bx - 64) * NWAVES + wid;
    constexpr int N_ALL = PW_N_A + PW_PROLOGUE_F * PW_PER_F - 2 * PW_INPROJ_PART;
    unsigned char* ws = p.ws();
    for (int it = gw; it < N_ALL; it += (GRID - 64) * NWAVES) {
        if (it < PW_N_A) { const int l = it / PW_PER_LAYER; int r = it - l * PW_PER_LAYER;
            if (r < 1280) { transpose_item(p.in(I_WIN) + (size_t)l * DM * INW, INW, (bf16*)(ws + WS_WIN) + (size_t)l * INW * DM, DM, 32 * (r % 80), 64 * (r / 80), 32 * (r % 80), scr, lane); continue; } r -= 1280;
            if (r < 512) { transpose_item(p.in(I_WOUT) + (size_t)l * DM * DM, DM, (bf16*)(ws + WS_WOUT) + (size_t)l * DM * DM, DM, 32 * (r % 32), 64 * (r / 32), 32 * (r % 32), scr, lane); continue; } r -= 512;
            transpose_item(p.in(I_WGLU) + (size_t)l * 65536, 256, (bf16*)(ws + WS_WGLU) + (size_t)l * 65536, 256, 32 * (r % 8), 64 * (r / 8), 32 * (r % 8), scr, lane);
        } else ffn_item(p, it - PW_N_A, scr, lane);
    }
}
__device__ __forceinline__ void deferred_weights(const KA& p, LAS unsigned char* lds, int wid, int lane, int first, int count, int nbusy) {
    const int bx = bx_opaque(); int idx = bx - nbusy, n = GRID - nbusy; if (n <= 0) { idx = bx; n = GRID; }
    if (idx < 0) return;
    LAS float* scr = (LAS float*)(lds + wid * 16384);
    for (int j = idx * NWAVES + wid; j < count; j += n * NWAVES) ffn_item(p, PW_PROLOGUE_F * PW_PER_F + first + j, scr, lane);
}
__device__ __forceinline__ void prologue_mod(const KA& p, LAS unsigned char* lds, int tid, int wid, int lane) {
    LAS float* sc = (LAS float*)lds; LAS float* red = (LAS float*)(lds + 17 * 1024 * 4);
    __syncthreads();
    for (int idx = tid; idx < 17 * 1024; idx += NTHREADS) { const int cond = idx >> 10, k = idx & 1023; const float v = cond < 16 ? p.in(I_C)[cond * 1024 + k] : p.in(I_CCTX)[k]; sc[idx] = v / (1.f + expf(-v)); }
    __syncthreads();
    float* MOD = (float*)(p.ws() + WS_MOD);
    for (int u = bx_opaque(); u < NLAYER * 96; u += GRID) { const int l = u / 96, cb = u % 96;
        float acc[17];
#pragma unroll
        for (int c = 0; c < 17; ++c) acc[c] = 0.f;
        const float* wp = p.in(I_WMOD) + ((size_t)l * 1024 + wid * 128) * 6144 + cb * 64 + lane;
        for (int k = 0; k < 128; k += 16) { float w[16];
#pragma unroll
            for (int q = 0; q < 16; ++q) w[q] = wp[(size_t)(k + q) * 6144];
#pragma unroll
            for (int q = 0; q < 16; q += 4)
#pragma unroll
                for (int c = 0; c < 17; ++c) { const f32x4 s = *(const LAS f32x4*)(sc + c * 1024 + wid * 128 + k + q); acc[c] += s[0] * w[q] + s[1] * w[q + 1] + s[2] * w[q + 2] + s[3] * w[q + 3]; } }
#pragma unroll
        for (int c = 0; c < 17; ++c) red[(wid * 17 + c) * 64 + lane] = acc[c];
        __syncthreads();
        for (int o = tid; o < 17 * 64; o += NTHREADS) { const int c = o >> 6, j = o & 63; float s = p.in(I_BMOD)[l * 6144 + cb * 64 + j];
#pragma unroll
            for (int w = 0; w < 8; ++w) s += red[(w * 17 + c) * 64 + j];
            MOD[((size_t)l * 17 + c) * 6144 + cb * 64 + j] = s; }
        __syncthreads();
    }
}
__device__ __forceinline__ void prologue_small_tables(const KA& p, int tid) {
    float* rope = (float*)(p.ws() + WS_ROPE); float* lamt = (float*)(p.ws() + WS_LAM);
    for (int i = tid; i < 1024; i += NTHREADS) { const int pos = i >> 4, k = i & 15; const float inv = exp2f(-(float)k * (13.287712379549449f / 16.f)); const float a = (float)pos * inv; rope[2 * i] = cosf(a); rope[2 * i + 1] = sinf(a); }
    if (tid < NLAYER) { const int l = tid; float d1 = 0.f, d2 = 0.f;
        for (int k = 0; k < 64; ++k) { d1 += p.in(I_LQ1)[l * 64 + k] * p.in(I_LK1)[l * 64 + k]; d2 += p.in(I_LQ2)[l * 64 + k] * p.in(I_LK2)[l * 64 + k]; }
        const float li = 0.8f - 0.6f * expf(-0.3f * (float)l); lamt[2 * l] = expf(d1) - expf(d2) + li; lamt[2 * l + 1] = li; }
}
__device__ __forceinline__ f32x2 cpow_turns(float lre_dt, double rev, int k) {
    const float mag = expf((float)k * lre_dt); double tk = rev * (double)k; tk -= __builtin_floor(tk + 0.5); const float ang = (float)(tk * 6.283185307179586);
    return (f32x2){mag * cosf(ang), mag * sinf(ang)};
}
__device__ __forceinline__ void prologue_s5(const KA& p, LAS unsigned char* lds, int tid, int l, int g) {
    LAS f32x2* apow = (LAS f32x2*)lds;
    LAS f32x2* bb = (LAS f32x2*)(lds + 17408);
    LAS f32x2* cc = (LAS f32x2*)(lds + 33792);
    LAS float* KT = (LAS float*)(lds + 50176);
    __syncthreads();
    if (tid < 128) { const int dir = tid >> 6, pp = tid & 63, gi = (l * 2 + dir) * 16 + g, idx = gi * 64 + pp;
        const float lre = p.in(I_LAMRE)[idx], lim = p.in(I_LAMIM)[idx], dt = expf(p.in(I_LOGSTEP)[gi]);
        const double rev = (double)lim * (double)dt * 0.15915494309189535; const float lre_dt = lre * dt;
        for (int k = 0; k <= 16; ++k) apow[(dir * 17 + k) * 64 + pp] = cpow_turns(lre_dt, rev, k);
        const f32x2 a1 = cpow_turns(lre_dt, rev, 1), a16 = cpow_turns(lre_dt, rev, 16), a544 = cpow_turns(lre_dt, rev, 544);
        ((f32x4*)(p.ws() + WS_A16))[idx] = (f32x4){a16.x, a16.y, a544.x, a544.y};
        const float nre = a1.x - 1.f, nim = a1.y, den = lre * lre + lim * lim, fre = (nre * lre + nim * lim) / den, fim = (nim * lre - nre * lim) / den;
        for (int h = 0; h < 16; ++h) { const float br = p.in(I_BRE)[(size_t)idx * 16 + h], bi = p.in(I_BIM)[(size_t)idx * 16 + h]; bb[(dir * 64 + pp) * 16 + h] = (f32x2){fre * br - fim * bi, fre * bi + fim * br}; } }
    for (int e = tid; e < 2048; e += NTHREADS) { const int dir = e >> 10, h = (e >> 6) & 15, pp = e & 63; const size_t ci = ((size_t)((l * 2 + dir) * 16 + g) * 16 + h) * 64 + pp;
        cc[e] = (f32x2){p.in(I_CRE)[ci], p.in(I_CIM)[ci]}; }
    __syncthreads();
    bf16* W1 = (bf16*)(p.ws() + WS_S5W1) + (size_t)(l * 16 + g) * 65536; bf16* W2 = (bf16*)(p.ws() + WS_S5W2) + (size_t)(l * 16 + g) * 131072;
    for (int it = 0; it < 128; ++it) { const int e = it * NTHREADS + tid, n = e >> 8, k = e & 255;
        { const int dir = n >> 7, part = (n >> 6) & 1, pp = n & 63, j = k >> 4, hh = k & 15, pw = dir == 0 ? 15 - j : j;
          const f32x2 a = apow[(dir * 17 + pw) * 64 + pp], b = bb[(dir * 64 + pp) * 16 + hh];
          W1[e] = (bf16)f2bf(part ? (a.x * b.y + a.y * b.x) : (a.x * b.x - a.y * b.y)); }
        { const int i = n >> 4, h = n & 15, dir = k >> 7, part = (k >> 6) & 1, pp = k & 63, pw = dir == 0 ? i + 1 : 16 - i;
          const f32x2 a = apow[(dir * 17 + pw) * 64 + pp], c = cc[(dir * 16 + h) * 64 + pp];
          W2[(size_t)n * 512 + k] = (bf16)f2bf(part ? -(c.x * a.y + c.y * a.x) : (c.x * a.x - c.y * a.y)); } }
    { const int dir = tid >> 8, h = (tid >> 4) & 15, hh = tid & 15;
      for (int lag = 0; lag < 16; ++lag) { float s = 0.f;
          for (int pp = 0; pp < 64; ++pp) { const f32x2 c = cc[(dir * 16 + h) * 64 + pp], a = apow[(dir * 17 + lag) * 64 + pp], b = bb[(dir * 64 + pp) * 16 + hh];
              const float cax = c.x * a.x - c.y * a.y, cay = c.x * a.y + c.y * a.x; s += cax * b.x - cay * b.y; }
          KT[(dir * 16 + lag) * 256 + h * 16 + hh] = s; } }
    __syncthreads();
    for (int it = 0; it < 128; ++it) { const int e = it * NTHREADS + tid, n = e >> 8, kk = e & 255, i = n >> 4, h = n & 15, j = kk >> 4, hh = kk & 15;
        float v = 0.f; if (j <= i) v += KT[(i - j) * 256 + h * 16 + hh]; if (j >= i) v += KT[(16 + j - i) * 256 + h * 16 + hh];
        if (i == j && h == hh) v += p.in(I_SSMD)[l * 256 + g * 16 + h];
        W2[(size_t)n * 512 + 256 + kk] = (bf16)f2bf(v); }
    __syncthreads();
}

template <bool ROUTER, bool F32SRC>
__device__ __forceinline__ void norm_phase(const KA& p, LAS unsigned char* lds, int tid, int wid, int lane, const float* srcL, const float* srcC, const float* gvec, const float* shiftv, const float* scalev,
                                           const float* router, bool skip_ctx) {
    bf16* HX = (bf16*)((unsigned char*)p.out() + OUT_HX); const bf16* XR = (const bf16*)(p.ws() + WS_XR);
    const int gw = bx_opaque() * NWAVES + wid;
    LAS int* wcnt = (LAS int*)lds + wid * 16;
    f32x4 wr0[ROUTER ? 16 : 1], wr1[ROUTER ? 16 : 1];
    if constexpr (ROUTER) {
        __syncthreads(); if (lane < 16) wcnt[lane] = 0;
        int* rsrc = (int*)(p.ws() + WS_RSRC); for (int i = bx_opaque() * NTHREADS + tid; i < MOE_ROWS; i += GRID * NTHREADS) rsrc[i] = -1;
#pragma unroll
        for (int j = 0; j < 4; ++j)
#pragma unroll
            for (int k = 0; k < 4; ++k) { const int c = 4 * lane + 256 * j + k; wr0[j * 4 + k] = *(const f32x4*)(router + (size_t)c * 8); wr1[j * 4 + k] = *(const f32x4*)(router + (size_t)c * 8 + 4); }
    }
    f32x4 Av[4], Bv[4]; int cur_cond = -1;
    constexpr int NB_ROWS = F32SRC ? 4 : (ROUTER ? 3 : 9);
    for (int rr0 = 0; rr0 < RPW; rr0 += NB_ROWS) {
        f32x4 rawf[F32SRC ? NB_ROWS : 1][4]; u32x2 rawh[F32SRC ? 1 : NB_ROWS][4];
#pragma unroll
        for (int d = 0; d < NB_ROWS; ++d) if (rr0 + d < RPW) { const int r = gw * RPW + rr0 + d;
            if constexpr (F32SRC) { bool isc; const size_t ro = res_off(r, isc); const float* xr = (isc ? srcC : srcL) + ro;
#pragma unroll
                for (int j = 0; j < 4; ++j) rawf[d][j] = *(const f32x4*)(xr + 4 * lane + 256 * j); }
            else {
#pragma unroll
                for (int j = 0; j < 4; ++j) rawh[d][j] = *(const u32x2*)(XR + (size_t)r * DM + 4 * lane + 256 * j); } }
#pragma unroll
        for (int d = 0; d < NB_ROWS; ++d) if (rr0 + d < RPW) { const int r = gw * RPW + rr0 + d; const int bq = r / RB; const bool isc = (r - bq * RB) >= SEQ; const int cond = isc ? 16 : bq;
        if (cond != cur_cond) { cur_cond = cond;
#pragma unroll
            for (int j = 0; j < 4; ++j) { const int c = 4 * lane + 256 * j; const f32x4 g = *(const f32x4*)(gvec + c), s = *(const f32x4*)(scalev + (size_t)cond * 6144 + c); Av[j] = g * (s + 1.f); Bv[j] = *(const f32x4*)(shiftv + (size_t)cond * 6144 + c); } }
        f32x4 v[4]; float ss = 0.f;
#pragma unroll
        for (int j = 0; j < 4; ++j) {
            if constexpr (F32SRC) v[j] = rawf[d][j];
            else { const u32x2 w = rawh[d][j]; v[j] = (f32x4){bf2f(w.x & 0xffffu), bf2f(w.x >> 16), bf2f(w.y & 0xffffu), bf2f(w.y >> 16)}; }
            ss += (v[j][0] * v[j][0] + v[j][1] * v[j][1]) + (v[j][2] * v[j][2] + v[j][3] * v[j][3]); }
        const float rinv = 1.f / sqrtf(wave_sum(ss) * (1.f / DM) + 1e-6f);
#pragma unroll
        for (int j = 0; j < 4; ++j) { v[j] = v[j] * rinv * Av[j] + Bv[j]; *(u32x2*)(HX + (size_t)r * DM + 4 * lane + 256 * j) = (u32x2){pk2(v[j][0], v[j][1]), pk2(v[j][2], v[j][3])}; }
        if constexpr (ROUTER) {
            int* toke = (int*)(p.ws() + WS_TOKE); f32x2* tokg = (f32x2*)(p.ws() + WS_TOKG);
            if (isc && skip_ctx) { if (lane == 0) toke[r] = 0xFFFF; }
            else { f32x4 l0 = {0.f, 0.f, 0.f, 0.f}, l1 = {0.f, 0.f, 0.f, 0.f};
#pragma unroll
                for (int j = 0; j < 4; ++j)
#pragma unroll
                    for (int k = 0; k < 4; ++k) { l0 += wr0[j * 4 + k] * v[j][k]; l1 += wr1[j * 4 + k] * v[j][k]; }
                float lg[8];
#pragma unroll
                for (int e = 0; e < 4; ++e) { lg[e] = wave_sum(l0[e]); lg[4 + e] = wave_sum(l1[e]); }
                int e0 = 0; float v0 = lg[0];
#pragma unroll
                for (int e = 1; e < 8; ++e) if (lg[e] > v0) { v0 = lg[e]; e0 = e; }
                int e1 = -1; float v1 = -3.0e38f;
#pragma unroll
                for (int e = 0; e < 8; ++e) if (e != e0 && lg[e] > v1) { v1 = lg[e]; e1 = e; }
                const float g0 = 1.f / (1.f + expf(v1 - v0));
                if (lane == 0) { toke[r] = e0 | (e1 << 8); tokg[r] = (f32x2){g0, 1.f - g0}; wcnt[e0] += 1; wcnt[8 + e1] += 1; } }
        }
        }
    }
    if constexpr (ROUTER) { LDS_WAIT(); if (lane < 16) ((int*)(p.ws() + WS_WCNT))[gw * 16 + lane] = wcnt[lane]; }
}
__device__ __forceinline__ void route2_phase(const KA& p, LAS unsigned char* lds, LAS int* mbase_lds, int tid, int wid, int lane) {
    LAS int* segsum = (LAS int*)lds;
    LAS int* wpre = segsum + 512;
    LAS int* tot = wpre + 128;
    LAS int* wstart = tot + 16;
    const int* wcnt = (const int*)(p.ws() + WS_WCNT);
    __syncthreads();
    { const int seg = tid >> 4, bin = tid & 15, myseg = bx_opaque() >> 3, wg0 = (bx_opaque() & 7) * 8; int s = 0;
      for (int k = 0; k < 64; ++k) { const int c = wcnt[(seg * 64 + k) * 16 + bin]; if (seg == myseg && k >= wg0 && k < wg0 + 8) wpre[(k - wg0) * 16 + bin] = s; s += c; }
      segsum[seg * 16 + bin] = s; }
    __syncthreads();
    if (tid < 16) { int s = 0; for (int k = 0; k < 32; ++k) s += segsum[k * 16 + tid]; tot[tid] = s; }
    __syncthreads();
    if (tid == 0) { int b = 0; for (int k = 0; k < 16; ++k) { mbase_lds[k] = b; b += (tot[k] + 255) & ~255; } mbase_lds[16] = b; }
    __syncthreads();
    if (bx_opaque() == 0 && tid < 17) ((int*)(p.ws() + WS_MBASE))[tid] = mbase_lds[tid];
    if (tid < 128) { const int w = tid >> 4, bin = tid & 15, myseg = bx_opaque() >> 3; int s = mbase_lds[bin] + wpre[w * 16 + bin]; for (int k = 0; k < myseg; ++k) s += segsum[k * 16 + bin]; wstart[w * 16 + bin] = s; }
    __syncthreads();
    { const int gw = bx_opaque() * NWAVES + wid; const int* toke = (const int*)(p.ws() + WS_TOKE); const f32x2* tokg = (const f32x2*)(p.ws() + WS_TOKG);
      int* rsrc = (int*)(p.ws() + WS_RSRC); float* rgate = (float*)(p.ws() + WS_RGATE);
      const bool act = lane < RPW; const int r = gw * RPW + (act ? lane : 0); const int te = act ? toke[r] : 0xFFFF; const f32x2 g = act ? tokg[r] : (f32x2){0.f, 0.f};
      const bool valid = te != 0xFFFF; const int e0 = te & 255, e1 = (te >> 8) & 255; int p0 = 0, p1 = 0;
      const unsigned long long ltm = (1ull << lane) - 1ull;
#pragma unroll
      for (int bin = 0; bin < 8; ++bin) { const unsigned long long m0 = __ballot(valid && e0 == bin), m1 = __ballot(valid && e1 == bin);
          if (e0 == bin) p0 = wstart[wid * 16 + bin] + __popcll(m0 & ltm);
          if (e1 == bin) p1 = wstart[wid * 16 + 8 + bin] + __popcll(m1 & ltm); }
      if (valid) { rsrc[p0] = r; rgate[p0] = g.x; rsrc[p1] = r; rgate[p1] = g.y; } }
    __syncthreads();
}
__device__ __forceinline__ void carry_phase(const KA& p, LAS unsigned char* lds, int tid, int wid, int lane, int l) {
    LAS f32x2* segend = (LAS f32x2*)lds;
    const float* Z = (const float*)(p.ws() + WS_ZLOC); bf16* A2 = (bf16*)((unsigned char*)p.out() + OUT_A2);
    for (int u = bx_opaque(); u < NB * 16 * 2; u += GRID) { const int dir = u & 1, g = (u >> 1) & 15, b = u >> 5;
        const f32x4 at = ((const f32x4*)(p.ws() + WS_A16))[((l * 2 + dir) * 16 + g) * 64 + lane];
        const float ar = at[0], ai = at[1];
        const size_t zrow0 = (size_t)g * NR16 + (size_t)b * 272;
        float lr[34], li[34];
#pragma unroll
        for (int k = 0; k < 34; ++k) { const int q = wid * 34 + k, cp = dir == 0 ? (q < 16 ? 256 + q : q - 16) : 271 - q; const float* zp = Z + (zrow0 + cp) * 256 + dir * 128 + lane; lr[k] = zp[0]; li[k] = zp[64]; }
        float zr = 0.f, zi = 0.f;
#pragma unroll
        for (int k = 0; k < 34; ++k) { const float nr = ar * zr - ai * zi + lr[k], ni = ar * zi + ai * zr + li[k]; zr = nr; zi = ni; }
        __syncthreads();
        segend[wid * 64 + lane] = (f32x2){zr, zi};
        __syncthreads();
        float cr = 0.f, ci = 0.f;
        for (int w = 0; w < wid; ++w) { const f32x2 s = segend[w * 64 + lane]; const float nr = at[2] * cr - at[3] * ci + s.x, ni = at[2] * ci + at[3] * cr + s.y; cr = nr; ci = ni; }
        zr = cr; zi = ci;
#pragma unroll
        for (int k = 0; k < 34; ++k) { const int q = wid * 34 + k, cp = dir == 0 ? (q < 16 ? 256 + q : q - 16) : 271 - q;
            bf16* ap = A2 + (zrow0 + cp) * 512 + dir * 128 + lane; ap[0] = (bf16)f2bf(zr); ap[64] = (bf16)f2bf(zi);
            const float nr = ar * zr - ai * zi + lr[k], ni = ar * zi + ai * zr + li[k]; zr = nr; zi = ni; }
    }
    __syncthreads();
}
__device__ __forceinline__ void final_phase(const KA& p, int wid, int lane) {
    const int gw = bx_opaque() * NWAVES + wid; f32x4 g[4]; const bf16* XR = (const bf16*)(p.ws() + WS_XR);
#pragma unroll
    for (int j = 0; j < 4; ++j) g[j] = *(const f32x4*)(p.in(I_GFINAL) + 4 * lane + 256 * j);
    for (int rl0 = gw * 32; rl0 < gw * 32 + 32; rl0 += 8) { u32x2 raw[8][4];
#pragma unroll
        for (int d = 0; d < 8; ++d) { const int rl = rl0 + d, b = rl >> 12, n = rl & 4095; const bf16* xr = XR + ((size_t)b * RB + n) * DM;
#pragma unroll
            for (int j = 0; j < 4; ++j) raw[d][j] = *(const u32x2*)(xr + 4 * lane + 256 * j); }
#pragma unroll
        for (int d = 0; d < 8; ++d) { float* orow = p.out() + (size_t)(rl0 + d) * DM; f32x4 v[4]; float ss = 0.f;
#pragma unroll
            for (int j = 0; j < 4; ++j) { const u32x2 w = raw[d][j]; v[j] = (f32x4){bf2f(w.x & 0xffffu), bf2f(w.x >> 16), bf2f(w.y & 0xffffu), bf2f(w.y >> 16)};
                ss += (v[j][0] * v[j][0] + v[j][1] * v[j][1]) + (v[j][2] * v[j][2] + v[j][3] * v[j][3]); }
            const float rinv = 1.f / sqrtf(wave_sum(ss) * (1.f / DM) + 1e-6f);
#pragma unroll
            for (int j = 0; j < 4; ++j) *(f32x4*)(orow + 4 * lane + 256 * j) = v[j] * rinv * g[j]; } }
}

constexpr int STAGE_LO = att::ATT_LDS, STAGE_HI = WTAB_OFF + 256;
static_assert(STAGE_LO % 16 == 0 && STAGE_HI % 16 == 0 && STAGE_LO + 5 * 4096 <= RING_BYTES && STAGE_HI + 3 * 4096 <= LDS_BYTES, "output stage placement");
__device__ __forceinline__ LAS bf16* stage_ptr(LAS unsigned char* lds, int wid) { return (LAS bf16*)(lds + (wid < 5 ? STAGE_LO + wid * 4096 : STAGE_HI + (wid - 5) * 4096)); }
__device__ __forceinline__ void diff_unit(const bf16* P, bf16* Y, int rows0, int h, int kbase, int NT, const float* lamp, const float* gsub, LAS unsigned char* lds, unsigned* gst, bool pre_in, bool has_next, size_t ndelta) {
    const int tid = tid_opaque(), lane = tid & 63, wid = __builtin_amdgcn_readfirstlane(tid >> 6), r32 = lane & 31, hi = lane >> 5;
    LAS bf16* st = stage_ptr(lds, wid) + r32;
    unsigned* gs = gst + ((size_t)(bx_opaque() * NWAVES + wid) * 32) * 64 + lane;
    {
        f32x16 o[4];
        att::attn_body<128, 0>(P + (size_t)rows0 * PW + PC_DQ + h * 128, P + PC_DK + h * 128, P + PC_DV + h * 128, kbase, NT, 0, NT, lds, o, 0, 0, nullptr, P + PC_DK + h * 128 + 64, P + PC_DV + h * 128, pre_in);
#pragma unroll
        for (int d = 0; d < 4; ++d)
#pragma unroll
            for (int j = 0; j < 8; ++j) gs[(d * 8 + j) * 64] = cvt_pk_bf16(o[d][2 * j], o[d][2 * j + 1]);
    }
    __builtin_amdgcn_sched_barrier(0);
    {
        f32x16 o[4];
        att::attn_body<128, 0>(P + (size_t)rows0 * PW + PC_DQ + h * 128 + 64, P + PC_DK + h * 128 + 64, P + PC_DV + h * 128, kbase, NT, 0, NT, lds, o, 0, 0, nullptr,
                               has_next ? P + PC_DK + h * 128 + ndelta : nullptr, has_next ? P + PC_DV + h * 128 + ndelta : nullptr, true);
        const float lam = lamp[0], lam_init = lamp[1];
        float ss[16];
#pragma unroll
        for (int r = 0; r < 16; ++r) ss[r] = 0.f;
        unsigned sw_[32];
#pragma unroll
        for (int k = 0; k < 32; ++k) sw_[k] = __hip_atomic_load(gs + k * 64, __ATOMIC_RELAXED, __HIP_MEMORY_SCOPE_AGENT);
        __builtin_amdgcn_sched_barrier(0);
#pragma unroll
        for (int d = 0; d < 4; ++d)
#pragma unroll
            for (int j = 0; j < 8; ++j) { const unsigned w = sw_[d * 8 + j];
                const float v0 = bf2f(w & 0xffffu) - lam * o[d][2 * j], v1 = bf2f(w >> 16) - lam * o[d][2 * j + 1]; o[d][2 * j] = v0; o[d][2 * j + 1] = v1; ss[2 * j] += v0 * v0; ss[2 * j + 1] += v1 * v1; }
#pragma unroll
        for (int r = 0; r < 16; ++r) {
            ss[r] = half_sum(ss[r]);
            ss[r] = (1.f / sqrtf(ss[r] * (1.f / 128.f) + 1e-5f)) * (1.f - lam_init); }
        float gs[4];
#pragma unroll
        for (int d = 0; d < 4; ++d) gs[d] = gsub[d * 32 + r32];
        { const LAS bf16* sw = stage_ptr(lds, wid); bf16* yo = Y + (size_t)(rows0 + wid * 32) * DM + 256 + h * 128;
#pragma unroll
          for (int q = 0; q < 2; ++q) {
#pragma unroll
            for (int r = 8 * q; r < 8 * q + 8; ++r)
#pragma unroll
                for (int d = 0; d < 4; ++d) st[(att::crow(r, hi) - 16 * q) * 128 + d * 32] = (bf16)f2bf(o[d][r] * ss[r] * gs[d]);
            asm volatile("s_waitcnt lgkmcnt(0)" ::: "memory");
#pragma unroll
            for (int i = 0; i < 4; ++i) { const int row = i * 4 + (lane >> 4), ch = lane & 15; *(u32x4*)(yo + (size_t)(16 * q + row) * DM + ch * 8) = *(const LAS u32x4*)(sw + row * 128 + ch * 8); }
            asm volatile("s_waitcnt lgkmcnt(0)" ::: "memory"); } }
    }
}
__device__ __forceinline__ void na_unit(const bf16* P, bf16* Y, const float* rpb_h, int b, int h, int qb, LAS unsigned char* lds, bool fill, bool pre_in, bool has_next, size_t ndelta) {
    const int tid = tid_opaque(), lane = tid & 63, wid = __builtin_amdgcn_readfirstlane(tid >> 6), r32 = lane & 31, hi = lane >> 5; const int rows0 = b * RB + qb * 256, r0 = qb * 4;
    const int kmin = min(min(max(r0 - 4, 0), 56), 52);
    __syncthreads();
    if (fill) { LAS float* tbl = (LAS float*)(lds + att::OFF_RPB);
      for (int i = tid; i < 15 * att::RPB_PITCH; i += NTHREADS) { const int ri = i >> 7, cj = (i & 127) - 48; tbl[i] = ((unsigned)cj < 31u) ? rpb_h[ri * 31 + cj] * 1.4426950408889634f : 0.f; } }
    f32x16 o[2];
    att::attn_body<64, 1>(P + (size_t)rows0 * PW + PC_NQ + h * 64, P + PC_NK + h * 64, P + PC_NV + h * 64, b * RB + SEQ, 4, b * RB + kmin * 64, 16, lds, o, r0 + (wid >> 1), kmin, nullptr,
                          has_next ? P + PC_NK + h * 64 + ndelta : nullptr, has_next ? P + PC_NV + h * 64 + ndelta : nullptr, pre_in);
    { LAS bf16* sw = stage_ptr(lds, wid);
#pragma unroll
      for (int r = 0; r < 16; ++r)
#pragma unroll
          for (int d = 0; d < 2; ++d) sw[att::crow(r, hi) * 64 + d * 32 + r32] = (bf16)f2bf(o[d][r]);
      asm volatile("s_waitcnt lgkmcnt(0)" ::: "memory");
      bf16* yo = Y + (size_t)(rows0 + wid * 32) * DM + 768 + h * 64;
#pragma unroll
      for (int i = 0; i < 4; ++i) { const int row = i * 8 + (lane >> 3), ch = lane & 7; *(u32x4*)(yo + (size_t)row * DM + ch * 8) = *(const LAS u32x4*)(sw + row * 64 + ch * 8); }
      asm volatile("s_waitcnt lgkmcnt(0)" ::: "memory"); }
}
__device__ __forceinline__ void na_ctx_unit(const bf16* P, bf16* Y, int b, int h, LAS unsigned char* lds) {
    const int tid = tid_opaque(), lane = tid & 63, wid = __builtin_amdgcn_readfirstlane(tid >> 6), r32 = lane & 31, hi = lane >> 5; const int rows0 = b * RB + SEQ;
    f32x16 o[2];
    att::attn_body<64, 0>(P + (size_t)rows0 * PW + PC_NQ + h * 64, P + PC_NK + h * 64, P + PC_NV + h * 64, rows0, 4, 0, 4, lds, o, 0, 0);
    { LAS bf16* sw = stage_ptr(lds, wid);
#pragma unroll
      for (int r = 0; r < 16; ++r)
#pragma unroll
          for (int d = 0; d < 2; ++d) sw[att::crow(r, hi) * 64 + d * 32 + r32] = (bf16)f2bf(o[d][r]);
      asm volatile("s_waitcnt lgkmcnt(0)" ::: "memory");
      bf16* yo = Y + (size_t)(rows0 + wid * 32) * DM + 768 + h * 64;
#pragma unroll
      for (int i = 0; i < 4; ++i) { const int row = i * 8 + (lane >> 3), ch = lane & 7; *(u32x4*)(yo + (size_t)row * DM + ch * 8) = *(const LAS u32x4*)(sw + row * 64 + ch * 8); }
      asm volatile("s_waitcnt lgkmcnt(0)" ::: "memory"); }
}
#ifndef WGM_IN
#define WGM_IN 4
#endif
#ifndef WGM_OUT
#define WGM_OUT 4
#endif
#ifndef WGM_UP
#define WGM_UP 4
#endif
#ifndef WGM_DOWN
#define WGM_DOWN 4
#endif
__global__ void __launch_bounds__(NTHREADS, 2) dit_fwd(Params p_unused) {
    (void)p_unused;
    LAS unsigned char* lds = (LAS unsigned char*)lds_raw;
    volatile LAS unsigned* MISC = (volatile LAS unsigned*)(lds + MISC_OFF);
    LAS int* mbase = (LAS int*)(lds + MISC_OFF + 128);
#define PH_ARGS KA p; p.k = (const CAS unsigned char*)__builtin_amdgcn_kernarg_segment_ptr(); asm volatile("" : "+s"(p.k)); unsigned char* const ws = p.ws(); (void)ws
#define PH_IDS PH_ARGS; const int tid = tid_opaque(), lane = tid & 63, wid = __builtin_amdgcn_readfirstlane(tid >> 6); (void)lane; (void)wid
#define BX (bx_opaque())
#define VCU ((BX & 7) * (GRID / 8) + (BX >> 3))
    for (int u = (int)threadIdx.x; u < (LDS_BYTES - LDSCTL_OFF) / 4; u += NTHREADS) ((LAS unsigned*)(lds + LDSCTL_OFF))[u] = 0u;
    __syncthreads();
    if ((threadIdx.x & 63) == 0) ((volatile LAS int*)(lds + WTAB_OFF))[hw_wave_slot()] = (int)(threadIdx.x >> 6);
    __syncthreads();
    { PH_ARGS; (void)xcd_barrier_post((unsigned*)(ws + WS_CTL) + CW_BAR, MISC + 8); }
#define GRID_BAR_T(FIRST) do { PH_ARGS; XcdBarrier b_; b_.bar = (unsigned*)(ws + WS_CTL) + CW_BAR; b_.x = xb_xcc_id(); b_.st = (volatile LAS unsigned*)(lds + MISC_OFF) + 8; xcd_barrier<FIRST>(b_); } while (0)
#define GRID_BAR() GRID_BAR_T(false)

#define MOD ((float*)(ws + WS_MOD))
#define OUTB ((unsigned char*)p.out())
#define XR ((bf16*)(ws + WS_XR))
#define HX ((bf16*)(OUTB + OUT_HX))
#define P ((bf16*)(ws + WS_P))
#define H ((bf16*)(ws + WS_H))
#define A2 ((bf16*)(OUTB + OUT_A2))
#define ZL ((float*)(ws + WS_ZLOC))
#define GB ((bf16*)(OUTB + OUT_GBUF))
#define MODL (MOD + (size_t)l * 17 * 6144)

    { PH_IDS; if (BX & 1) { prologue_mod(p, lds, tid, wid, lane); __syncthreads(); prologue_weights(p, lds, wid, lane); }
      else { prologue_weights(p, lds, wid, lane); prologue_mod(p, lds, tid, wid, lane); }
      if (BX >= 128 && BX < 192) prologue_s5(p, lds, tid, (BX - 128) >> 4, (BX - 128) & 15);
      if (BX == 255) prologue_small_tables(p, tid); }
    GRID_BAR_T(true);

    for (int l = 0; l < NLAYER; ++l) {
        const int last = (l == NLAYER - 1) ? 1 : 0;
        { PH_IDS; if (l == 0) norm_phase<false, true>(p, lds, tid, wid, lane, p.in(I_X), p.in(I_CTX), p.in(I_GMIX), MODL, MODL + 1024, nullptr, false);
          else norm_phase<false, false>(p, lds, tid, wid, lane, nullptr, nullptr, p.in(I_GMIX) + l * DM, MODL, MODL + 1024, nullptr, false); }
        GRID_BAR();
        { PH_ARGS; SchedRows S{(const char*)HX, (const char*)(ws + WS_WIN) + (size_t)l * INW * DM * 2, (size_t)256 * DM * 2, (size_t)256 * DM * 2, NPANEL, INW / 256, 0, 0, WGM_IN, 0};
          EpiInProj E{P, A2, (const float*)(ws + WS_ROPE)};
          pg8::gemm_phase<EpiInProj, SchedRows, false>(lds, DM, DM, DM, S, E); }
        if (l < 2) { PH_IDS; deferred_weights(p, lds, wid, lane, (l - 2) * PW_INPROJ_PART, PW_INPROJ_PART, (NPANEL * (INW / 256)) % GRID); }
        GRID_BAR();
        { PH_ARGS; SchedS5 S{(const char*)A2 + 512, (const char*)(ws + WS_S5W1) + (size_t)l * 16 * 65536 * 2, (size_t)65536 * 2}; EpiZ E{ZL};
          pg8::gemm_phase<EpiZ, SchedS5, false>(lds, 256, 512, 256, S, E); }
        GRID_BAR();
        { PH_IDS; carry_phase(p, lds, tid, wid, lane, l); }
        GRID_BAR();
        { PH_ARGS; SchedS5 S{(const char*)A2, (const char*)(ws + WS_S5W2) + (size_t)l * 16 * 131072 * 2, (size_t)131072 * 2, last ? 0 : 1}; EpiY E{GB};
          pg8::gemm_phase<EpiY, SchedS5, false>(lds, 512, 512, 512, S, E); }
        { PH_ARGS; const float* lamp = (const float*)(ws + WS_LAM) + 2 * l; const float* gsub = p.in(I_SUBLN) + l * 128; const int vcu = VCU;
          for (int it = 0; it < 4; ++it) { const int bh = (vcu >> 4) + 16 * it, b = bh >> 2, h = bh & 3, qb = vcu & 15;
              diff_unit(P, HX, b * RB + qb * 256, h, b * RB, RB / 64, lamp, gsub, lds, (unsigned*)(ws + WS_ZLOC), it > 0, it < 3, (size_t)4 * RB * PW); }
          if ((unsigned)((vcu & 31) - 2) < 8u && !last) { const int ci_ = (vcu >> 5) * 8 + (vcu & 31) - 2, b = ci_ >> 2, h = ci_ & 3; diff_unit(P, HX, b * RB + SEQ, h, b * RB + SEQ, CTXL / 64, lamp, gsub, lds, (unsigned*)(ws + WS_ZLOC), false, false, 0); }
          for (int it = 0; it < 4; ++it) { const int bh = (vcu >> 4) + 16 * it, b = bh >> 2, h = bh & 3, qb = vcu & 15;
              na_unit(P, HX, p.in(I_RPB) + (size_t)(l * 4 + h) * 465, b, h, qb, lds, it == 0, it > 0, it < 3, (size_t)4 * RB * PW); }
          if ((unsigned)((vcu & 31) - 10) < 8u && !last) { const int ci_ = (vcu >> 5) * 8 + (vcu & 31) - 10, b = ci_ >> 2, h = ci_ & 3; na_ctx_unit(P, HX, b, h, lds); }
          __syncthreads(); }
        GRID_BAR();
        { PH_ARGS; SchedRows S{(const char*)GB, (const char*)(ws + WS_WGLU) + (size_t)l * 65536 * 2, (size_t)256 * 256 * 2, (size_t)256 * 256 * 2, last ? NB * 16 : NPANEL, 1, 0, 0, 4, last};
          EpiGlu E{GB, HX, p.in(I_BGLU) + l * 256};
          pg8::gemm_phase<EpiGlu, SchedRows, false>(lds, 256, 256, 256, S, E); }
        GRID_BAR();
        { PH_ARGS; SchedRows S{(const char*)HX, (const char*)(ws + WS_WOUT) + (size_t)l * DM * DM * 2, (size_t)256 * DM * 2, (size_t)256 * DM * 2, last ? NB * 16 : NPANEL, 4, 0, 0, WGM_OUT, last};
          if (l == 0) { EpiRes<true> E{p.in(I_X), p.in(I_CTX), XR, MODL + 2 * 1024}; pg8::gemm_phase<EpiRes<true>, SchedRows, false>(lds, DM, DM, DM, S, E); }
          else { EpiRes<false> E{nullptr, nullptr, XR, MODL + 2 * 1024}; pg8::gemm_phase<EpiRes<false>, SchedRows, false>(lds, DM, DM, DM, S, E); } }
        if (l < 3) { PH_IDS; deferred_weights(p, lds, wid, lane, l * PW_DEFER_PART, PW_DEFER_PART, (NPANEL * 4) % GRID); }
        GRID_BAR();
        { PH_IDS; if (l & 1) norm_phase<true, false>(p, lds, tid, wid, lane, nullptr, nullptr, p.in(I_GFFN) + l * DM, MODL + 3 * 1024, MODL + 4 * 1024, p.in(I_ROUTER) + (size_t)(l >> 1) * DM * 8, l == NLAYER - 1);
          else norm_phase<false, false>(p, lds, tid, wid, lane, nullptr, nullptr, p.in(I_GFFN) + l * DM, MODL + 3 * 1024, MODL + 4 * 1024, nullptr, false); }
        GRID_BAR();
#define FFN_XL(nd, nup, xl_out) do { int best_ = 0x7fffffff; xl_out = 0x7fffff; if ((nd) > 0) { for (int x_ = 18; x_ <= 22; ++x_) { const int rest_ = (nup) - (nd) * x_; if (rest_ < 0) break; \
            const int oth_ = (rest_ + (GRID - (nd)) - 1) / (GRID - (nd)); const int cost_ = (5 + 2 * x_) > 2 * oth_ ? (5 + 2 * x_) : 2 * oth_; if (cost_ < best_) { best_ = cost_; xl_out = x_; } } } } while (0)
        if (!(l & 1)) {
            const int fi = l >> 1;
            for (int ci = 0; ci < 2; ++ci) { const int c = 1 - ci, pm0 = c * HCHUNK_PANELS, np = (NPANEL - pm0) < HCHUNK_PANELS ? (NPANEL - pm0) : HCHUNK_PANELS;
                const int nd = c == 0 ? (NPANEL - HCHUNK_PANELS) * 4 : 0; int xl; FFN_XL(nd, np * 22, xl);
                { PH_ARGS; bf16* const Hc = c == 1 ? A2 : H; SchedRows S{(const char*)HX, (const char*)(ws + WS_W13D) + (size_t)fi * SZ_W13, (size_t)256 * DM * 2, (size_t)256 * DM * 2, np, 22, pm0, 0, WGM_UP, 0, nd, xl}; EpiSwi E{Hc};
                  pg8::gemm_phase<EpiSwi, SchedRows, false>(lds, DM, DM, DM, S, E); }
                if (c == 1) { PH_IDS; deferred_weights(p, lds, wid, lane, 3 * PW_DEFER_PART + (l >> 1) * (PW_DEFER_PART / 2), PW_DEFER_PART / 2, (np * 22) % GRID); }
                GRID_BAR();
                { PH_ARGS; bf16* const Hc = c == 1 ? A2 : H; SchedRows S{(const char*)Hc, (const char*)(ws + WS_W2D) + (size_t)fi * SZ_W2, (size_t)256 * FF * 2, (size_t)256 * FF * 2, np, 4, pm0, 1, WGM_DOWN, 0};
                  EpiRes<false> E{nullptr, nullptr, XR, MODL + 5 * 1024};
                  pg8::gemm_phase<EpiRes<false>, SchedRows, false>(lds, FF, FF, FF, S, E); }
                if (c == 0) GRID_BAR(); }
        } else {
            const int mi = l >> 1;
            { PH_IDS; route2_phase(p, lds, mbase, tid, wid, lane); }
            GRID_BAR();
            for (int s = 0; s < 2; ++s) { const int P0 = __builtin_amdgcn_readfirstlane(mbase[8 * s] >> 8), P1 = __builtin_amdgcn_readfirstlane(mbase[8 * s + 8] >> 8);
                const int nrem = (P1 - P0) > HCHUNK_PANELS ? (P1 - P0) - HCHUNK_PANELS : 0;
                for (int ci = 0; ci < 2; ++ci) { const int c = 1 - ci; if (c == 1 && nrem == 0) continue;
                    const int p0 = P0 + c * HCHUNK_PANELS, np = c == 1 ? nrem : ((P1 - P0) < HCHUNK_PANELS ? (P1 - P0) : HCHUNK_PANELS);
                    const int nd = c == 0 ? nrem * 4 : 0; int xl; FFN_XL(nd, np * 22, xl);
                        { PH_ARGS; bf16* const Hc = c == 1 ? A2 : H; SchedMoe S{(const char*)HX, (const char*)(ws + WS_W13M) + (size_t)mi * 8 * SZ_W13, (const int*)(ws + WS_RSRC), mbase, np, 22, p0, s, 0, SZ_W13, (size_t)256 * DM * 2, WGM_UP, nd, xl}; EpiSwi E{Hc};
                      pg8::gemm_phase<EpiSwi, SchedMoe, true>(lds, DM, DM, DM, S, E); }
                    GRID_BAR();
                    { PH_ARGS; bf16* const Hc = c == 1 ? A2 : H; SchedMoe S{(const char*)Hc, (const char*)(ws + WS_W2M) + (size_t)mi * 8 * SZ_W2, (const int*)(ws + WS_RSRC), mbase, np, 4, p0, s, 1, SZ_W2, (size_t)256 * FF * 2, WGM_DOWN};
                      EpiMoeDown E{XR, MODL + 5 * 1024, (const int*)(ws + WS_RSRC), (const float*)(ws + WS_RGATE)};
                      pg8::gemm_phase<EpiMoeDown, SchedMoe, false>(lds, FF, FF, FF, S, E); }
                    if (c == 0) GRID_BAR(); } }
        }
#undef FFN_XL
    }
    { PH_IDS; final_phase(p, wid, lane); }
#undef GRID_BAR
#undef GRID_BAR_T
#undef BX
#undef VCU
#undef MOD
#undef XR
#undef OUTB
#undef HX
#undef P
#undef H
#undef A2
#undef ZL
#undef GB
#undef MODL
}

extern "C" void kernel_launch(void* const* d_in, const int* in_sizes, int n_in, void* d_out, int out_size, void* d_ws, size_t ws_size, hipStream_t stream) {
    static int ready = 0;
    if (ready == 0) {
        if (n_in != 34 || in_sizes[0] != NB * SEQ * DM || out_size != NB * SEQ * DM || ws_size < WS_END) {
            fprintf(stderr, "kernel_launch: shape/workspace mismatch (n_in %d, x %d, out %d, ws %zu, need %zu); nothing launched\n", n_in, n_in > 0 ? in_sizes[0] : -1, out_size, ws_size, (size_t)WS_END); ready = -1; return; }
        if (hipFuncSetAttribute((const void*)dit_fwd, hipFuncAttributeMaxDynamicSharedMemorySize, LDS_BYTES) != hipSuccess) { fprintf(stderr, "kernel_launch: hipFuncSetAttribute failed\n"); ready = -1; return; }
        int per_cu = 0;
        if (hipOccupancyMaxActiveBlocksPerMultiprocessor(&per_cu, (const void*)dit_fwd, NTHREADS, LDS_BYTES) != hipSuccess || per_cu < 1) fprintf(stderr, "kernel_launch: note: occupancy query reports %d workgroups per CU\n", per_cu);
        (void)hipGetLastError();
        ready = 1;
    }
    if (ready < 0) return;
    if (hipMemsetAsync((char*)d_ws + WS_CTL, 0, (size_t)(CW_BAR + XCD_BAR_WORDS) * 4, stream) != hipSuccess) { fprintf(stderr, "kernel_launch: memset failed\n"); return; }
    Params prm{};
    for (int i = 0; i < 34; ++i) prm.in[i] = (const float*)d_in[i];
    prm.out = (float*)d_out; prm.ws = (unsigned char*)d_ws;
    hipLaunchKernelGGL(dit_fwd, dim3(GRID), dim3(NTHREADS), LDS_BYTES, stream, prm);
    const hipError_t le = hipPeekAtLastError();
    if (le != hipSuccess) fprintf(stderr, "kernel_launch: launch failed: %s\n", hipGetErrorName(le));
}
```

```cpp
#include <hip/hip_runtime.h>
#include <cstdio>
#include <cstdint>

#define GAS __attribute__((address_space(1)))
#define LAS __attribute__((address_space(3)))
typedef unsigned short bf16;
typedef short bf16x8 __attribute__((ext_vector_type(8)));
typedef short s16x4 __attribute__((ext_vector_type(4)));
typedef float f32x2 __attribute__((ext_vector_type(2)));
typedef float f32x4 __attribute__((ext_vector_type(4)));
typedef float f32x8 __attribute__((ext_vector_type(8)));
typedef float f32x16 __attribute__((ext_vector_type(16)));
typedef unsigned u32x2 __attribute__((ext_vector_type(2)));
typedef unsigned u32x4 __attribute__((ext_vector_type(4)));

constexpr int DM = 1024, NB = 16, SEQ = 4096, CTXL = 256, RB = SEQ + CTXL, NR = NB * RB, NLAYER = 4;
constexpr int INW = 2560, PW = 2304, FF = 2816, NEXP = 8;
constexpr int PC_DQ = 0, PC_DK = 512, PC_DV = 1024, PC_NQ = 1536, PC_NK = 1792, PC_NV = 2048;
constexpr int NPANEL = NR / 256, PPB = RB / 256;
constexpr int NR16 = NR / 16;
constexpr int GRID = 256, NWAVES = 8, NTHREADS = 512, NGW = GRID * NWAVES, RPW = NR / NGW;
static_assert(RPW * NGW == NR, "rows per wave");
constexpr int MOE_ROWS = 2 * NR + 4096;
constexpr int HCHUNK_PANELS = 256;

constexpr size_t al4k(size_t x) { return (x + 4095) & ~(size_t)4095; }
constexpr size_t WS_CTL = 0, CTL_BYTES = 1u << 20;
constexpr size_t WS_MOD = WS_CTL + CTL_BYTES;                          constexpr size_t SZ_MOD = (size_t)NLAYER * 17 * 6144 * 4;
constexpr size_t WS_ROPE = al4k(WS_MOD + SZ_MOD);                      constexpr size_t SZ_ROPE = 64 * 16 * 8;
constexpr size_t WS_LAM = al4k(WS_ROPE + SZ_ROPE);                     constexpr size_t SZ_LAM = 4096;
constexpr size_t WS_A16 = al4k(WS_LAM + SZ_LAM);                       constexpr size_t SZ_A16 = (size_t)NLAYER * 2 * 16 * 64 * 16;
constexpr size_t WS_S5W1 = al4k(WS_A16 + SZ_A16);                      constexpr size_t SZ_S5W1 = (size_t)NLAYER * 16 * 256 * 256 * 2;
constexpr size_t WS_S5W2 = al4k(WS_S5W1 + SZ_S5W1);                    constexpr size_t SZ_S5W2 = (size_t)NLAYER * 16 * 256 * 512 * 2;
constexpr size_t WS_WIN = al4k(WS_S5W2 + SZ_S5W2);                     constexpr size_t SZ_WIN = (size_t)NLAYER * INW * DM * 2;
constexpr size_t WS_WOUT = al4k(WS_WIN + SZ_WIN);                      constexpr size_t SZ_WOUT = (size_t)NLAYER * DM * DM * 2;
constexpr size_t WS_WGLU = al4k(WS_WOUT + SZ_WOUT);                    constexpr size_t SZ_WGLU = (size_t)NLAYER * 256 * 256 * 2;
constexpr size_t WS_W13D = al4k(WS_WGLU + SZ_WGLU);                    constexpr size_t SZ_W13 = (size_t)2 * FF * DM * 2;
constexpr size_t WS_W2D = al4k(WS_W13D + 2 * SZ_W13);                  constexpr size_t SZ_W2 = (size_t)DM * FF * 2;
constexpr size_t WS_W13M = al4k(WS_W2D + 2 * SZ_W2);
constexpr size_t WS_W2M = al4k(WS_W13M + 16 * SZ_W13);
constexpr size_t SZ_HX = (size_t)NR * DM * 2;
constexpr size_t WS_XR = al4k(WS_W2M + 16 * SZ_W2);
constexpr size_t WS_P = al4k(WS_XR + SZ_HX);                           constexpr size_t SZ_P = (size_t)NR * PW * 2;
constexpr size_t WS_H = WS_P;                                          constexpr size_t SZ_H = (size_t)HCHUNK_PANELS * 256 * FF * 2;
constexpr size_t SZ_A2 = (size_t)16 * NR16 * 512 * 2, SZ_GBUF = (size_t)NR * 256 * 2;
constexpr size_t WS_ZLOC = al4k(WS_P + SZ_P);                          constexpr size_t SZ_ZLOC = (size_t)16 * NR16 * 256 * 4;
constexpr size_t WS_TOKE = al4k(WS_ZLOC + SZ_ZLOC);                    constexpr size_t SZ_TOKE = (size_t)NR * 4;
constexpr size_t WS_TOKG = al4k(WS_TOKE + SZ_TOKE);                    constexpr size_t SZ_TOKG = (size_t)NR * 8;
constexpr size_t WS_WCNT = al4k(WS_TOKG + SZ_TOKG);                    constexpr size_t SZ_WCNT = (size_t)NGW * 16 * 4;
constexpr size_t WS_MBASE = al4k(WS_WCNT + SZ_WCNT);                   constexpr size_t SZ_MBASE = 4096;
constexpr size_t WS_RSRC = al4k(WS_MBASE + SZ_MBASE);                  constexpr size_t SZ_RSRC = (size_t)MOE_ROWS * 4;
constexpr size_t WS_RGATE = al4k(WS_RSRC + SZ_RSRC);                   constexpr size_t SZ_RGATE = (size_t)MOE_ROWS * 4;
constexpr size_t WS_END = al4k(WS_RGATE + SZ_RGATE);
constexpr size_t OUT_HX = 0, OUT_A2 = OUT_HX + SZ_HX, OUT_GBUF = OUT_A2 + SZ_A2;
static_assert(OUT_GBUF + SZ_GBUF <= (size_t)NB * SEQ * DM * 4 && OUT_A2 % 4096 == 0 && OUT_GBUF % 4096 == 0, "scratch tensors inside d_out");
static_assert(WS_ZLOC == WS_P + SZ_P && SZ_H <= SZ_P + SZ_ZLOC, "hidden chunk overlays P and Zloc (both dead during the FFN)");
static_assert(WS_END <= ((size_t)1 << 30), "workspace map must fit 1 GiB");
constexpr int CW_BAR = 4096;

constexpr int RING_BYTES = 131072;
constexpr int LDSCTL_OFF = RING_BYTES;
constexpr int MISC_OFF = LDSCTL_OFF + 320;
constexpr int LDS_BYTES = 147456;

__device__ __forceinline__ unsigned f2bf(float f) { unsigned u = __builtin_bit_cast(unsigned, f); return (u + 0x7fffu + ((u >> 16) & 1u)) >> 16; }
__device__ __forceinline__ unsigned pk2(float lo, float hi) { return f2bf(lo) | (f2bf(hi) << 16); }
__device__ __forceinline__ float bf2f(unsigned h) { return __builtin_bit_cast(float, h << 16); }
__device__ __forceinline__ unsigned cvt_pk_bf16(float lo, float hi) { unsigned r; asm volatile("v_cvt_pk_bf16_f32 %0, %1, %2" : "=v"(r) : "v"(lo), "v"(hi)); return r; }
template <int X> __device__ __forceinline__ float swz_xor(float v) { return __builtin_bit_cast(float, __builtin_amdgcn_ds_swizzle(__builtin_bit_cast(int, v), (X << 10) | 0x1f)); }
__device__ __forceinline__ float half_sum(float v) {
    v += swz_xor<1>(v); v += swz_xor<2>(v); v += swz_xor<4>(v); v += swz_xor<8>(v); v += swz_xor<16>(v); return v; }
__device__ __forceinline__ float wave_sum(float v) {
    v = half_sum(v);
    auto rr = __builtin_amdgcn_permlane32_swap(__float_as_uint(v), __float_as_uint(v), false, false);
    return __uint_as_float(rr[0]) + __uint_as_float(rr[1]);
}
__device__ __forceinline__ int bx_opaque() { int b = (int)blockIdx.x; asm volatile("" : "+s"(b)); return b; }
extern __shared__ __attribute__((aligned(16))) unsigned char lds_raw[];
constexpr int WTAB_OFF = MISC_OFF + 256;
__device__ __forceinline__ int hw_wave_slot() { return (int)(__builtin_amdgcn_s_getreg((5 << 11) | 4) & 0x3fu); }
__device__ __forceinline__ int tid_opaque() {
    const int w = __builtin_amdgcn_readfirstlane(((volatile LAS int*)((LAS unsigned char*)lds_raw + WTAB_OFF))[hw_wave_slot()]);
    unsigned z = 0u; asm volatile("" : "+s"(z));
    int t = w * 64 + (int)__builtin_amdgcn_mbcnt_hi(~0u, __builtin_amdgcn_mbcnt_lo(~0u, z)); asm volatile("" : "+v"(t)); return t; }
#define LDS_WAIT() asm volatile("s_waitcnt lgkmcnt(0)" ::: "memory")
#define VM_WAIT() asm volatile("s_waitcnt vmcnt(0)" ::: "memory")
__device__ __forceinline__ float fast_exp(float x) { return __builtin_amdgcn_exp2f(x * 1.4426950408889634f); }
__device__ __forceinline__ float sigmoidf_(float x) { return __builtin_amdgcn_rcpf(1.f + fast_exp(-x)); }
__device__ __forceinline__ float siluf_(float x) { return x * sigmoidf_(x); }
__device__ __forceinline__ float gelu_tanh(float x) {
    const float u = 0.7978845608028654f * (x + 0.044715f * x * x * x);
    return x * sigmoidf_(2.f * u);
}

#define XB_TMO      128
#define XB_XCNT(j)  (256  + 64 * (j))
#define XB_XSUB(j)  (1280 + 64 * (j))
#define XB_XGEN(j)  (2304 + 64 * (j))
#define XB_TOP      3328
#define XB_TOPGEN   3392
#define XCD_BAR_WORDS 3456
#define XB_SPIN_CAP (1u << 18)

__device__ __forceinline__ unsigned xb_ld(unsigned* p)              { return __hip_atomic_load(p, __ATOMIC_RELAXED, __HIP_MEMORY_SCOPE_AGENT); }
__device__ __forceinline__ unsigned xb_add(unsigned* p, unsigned v) { return __hip_atomic_fetch_add(p, v, __ATOMIC_RELAXED, __HIP_MEMORY_SCOPE_AGENT); }
__device__ __forceinline__ unsigned xb_xcc_id() { return (unsigned)__builtin_amdgcn_s_getreg((3 << 11) | 20) & 0xFu; }
#define XB_SPIN(cond, bar) do { unsigned _sp = 0; while (cond) { __builtin_amdgcn_s_sleep(1); \
    if ((++_sp & 255u) == 0u) { if (xb_ld(&(bar)[XB_TMO])) break; if (_sp > XB_SPIN_CAP) { atomicAdd(&(bar)[XB_TMO], 1u); break; } } } } while (0)

struct XcdBarrier {
    unsigned* bar; unsigned x;
    volatile LAS unsigned* st;
};
__device__ __forceinline__ XcdBarrier xcd_barrier_post(unsigned* bar, volatile LAS unsigned* st) {
    XcdBarrier b; b.bar = bar; b.x = xb_xcc_id(); b.st = st;
    if (threadIdx.x == 0) (void)xb_add(&bar[XB_XCNT(b.x)], 1u);
    return b;
}
__device__ __forceinline__ void xcd_barrier_complete(unsigned* bar, unsigned x, unsigned& nloc, unsigned& nx) {
    const unsigned G = gridDim.x * gridDim.y * gridDim.z;
    unsigned sum, cnt, mine, sp = 0u;
    for (;;) {
        sum = 0u; cnt = 0u; mine = 0u;
#pragma unroll
        for (unsigned j = 0; j < 16; ++j) { const unsigned c = xb_ld(&bar[XB_XCNT(j)]); sum += c; cnt += (c > 0u) ? 1u : 0u; mine = (j == x) ? c : mine; }
        if (sum == G) break;
        __builtin_amdgcn_s_sleep(1);
        if ((++sp & 255u) == 0u) { if (xb_ld(&bar[XB_TMO])) break; if (sp > XB_SPIN_CAP) { atomicAdd(&bar[XB_TMO], 1u); break; } }
    }
    nloc = mine > 0u ? mine : 1u; nx = cnt > 0u ? cnt : 1u;
}
template <bool FIRST>
__device__ __forceinline__ void xcd_barrier(const XcdBarrier& b) {
    asm volatile("s_waitcnt vmcnt(0)" ::: "memory");
    __syncthreads();
    if (threadIdx.x == 0) {
        unsigned* bar = b.bar;
        __builtin_amdgcn_s_waitcnt(0);
        unsigned nloc = b.st[0], nx = b.st[1];
        if constexpr (FIRST) { if (nloc == 0u) { xcd_barrier_complete(bar, b.x, nloc, nx); b.st[0] = nloc; b.st[1] = nx; } }
        else { nloc = nloc ? nloc : 1u; nx = nx ? nx : 1u; }
        const unsigned old = xb_add(&bar[XB_XSUB(b.x)], 1u);
        const unsigned gen = old / nloc;
        if (old + 1u == (gen + 1u) * nloc) {
            __builtin_amdgcn_fence(__ATOMIC_RELEASE, "agent");
            asm volatile("s_waitcnt vmcnt(0)" ::: "memory");
            const unsigned og = xb_add(&bar[XB_TOP], 1u);
            const unsigned tg = og / nx;
            if (og + 1u == (tg + 1u) * nx) xb_add(&bar[XB_TOPGEN], 1u);
            else XB_SPIN(xb_ld(&bar[XB_TOPGEN]) == tg, bar);
            __builtin_amdgcn_fence(__ATOMIC_ACQUIRE, "agent");
            xb_add(&bar[XB_XGEN(b.x)], 1u);
            asm volatile("s_waitcnt vmcnt(0)" ::: "memory");
        } else {
            XB_SPIN(xb_ld(&bar[XB_XGEN(b.x)]) == gen, bar);
            __builtin_amdgcn_fence(__ATOMIC_ACQUIRE, "agent");
            asm volatile("s_waitcnt vmcnt(0)" ::: "memory");
        }
    }
    __syncthreads();
}

namespace pg8 {
__device__ __forceinline__ void glds16_s(const void* sbase, unsigned voff, unsigned lds_dst) {
    unsigned keep;
    asm volatile("s_mov_b32 %0, m0\n\ts_mov_b32 m0, %3\n\ts_nop 0\n\tglobal_load_lds_dwordx4 %1, %2\n\ts_mov_b32 m0, %0" : "=&s"(keep) : "v"(voff), "s"(sbase), "s"(lds_dst) : "memory");
}
constexpr int BM = 256, BK = 64, HALF = 128, HTB = HALF * BK * 2, STAGE_BYTES = 8 * HTB, NXCD = 8;
__host__ __device__ __forceinline__ int lds_byte(int r, int c) { const int st = (r >> 4) * 2 + (c >> 5), rr = r & 15, cc = c & 31, ob = rr * 64 + cc * 2; return st * 1024 + (ob ^ (((ob >> 9) & 1) << 5)); }
__host__ __device__ __forceinline__ void stage_rc(int b, int& R, int& C) { const int st = b / 1024, sb = b % 1024, swz = sb ^ (((sb >> 9) & 1) << 5); R = (st >> 1) * 16 + swz / 64; C = (st & 1) * 32 + (swz % 64) / 2; }
__host__ __device__ __forceinline__ int perm32(int rho) { const int n = rho >> 4, i = rho & 15; return 8 * (i >> 2) + 4 * n + (i & 3); }

struct GUnit { const char* A; const char* B; int pm, pn, aux; const int* rows; };

__device__ __forceinline__ long deal_index(int i, int G, int c, int late, int xl) { return (i < xl) ? (long)i * G + c : (c < late ? -1L : (long)xl * G + (long)(i - xl) * (G - late) + (c - late)); }
__device__ __forceinline__ bool tile_order(int i, int G, int c, int nM, int nN, int WGM, int& pm, int& pn, int late = 0, int xl = 0x7fffff) {
    const int nwg = nM * nN; const long L = late ? deal_index(i, G, c, late, xl) : (long)i * G + c; if (L < 0 || L >= nwg) return false;
    int wgid = (int)L; { const int q = nwg / NXCD, r = nwg % NXCD, xcd = wgid % NXCD, off = wgid / NXCD; wgid = (xcd < r ? xcd * (q + 1) : r * (q + 1) + (xcd - r) * q) + off; }
    const int nig = WGM * nN, gid = wgid / nig, fm = gid * WGM, gsz = (nM - fm) < WGM ? (nM - fm) : WGM;
    pm = fm + ((wgid % nig) % gsz); pn = (wgid % nig) / gsz; return true;
}

template <class Epi, class Sched, bool GATHER>
__device__ __forceinline__ void gemm_phase(LAS unsigned char* lds, const int K, const int lda, const int ldb, const Sched& S, const Epi& E) {
    const int tid = tid_opaque(), wid = __builtin_amdgcn_readfirstlane(tid >> 6), lane = tid & 63, wr = wid >> 2, wc = wid & 3, fr = lane & 15, fq = lane >> 4;
    int nt = K / BK; asm volatile("" : "+s"(nt));
    int sR[2], sC[2]; unsigned voffB[2];
#pragma unroll
    for (int i = 0; i < 2; ++i) { stage_rc(tid * 16 + i * 8192, sR[i], sC[i]); const int Rb = (sR[i] & ~31) + perm32(sR[i] & 31); voffB[i] = (unsigned)(Rb * ldb + sC[i]) * 2u; }
    const size_t kstep = (size_t)(BK * 2);
    const size_t hstepB = (size_t)HALF * ldb * 2;
    const unsigned ldsb = (unsigned)(uintptr_t)lds + (unsigned)wid * 1024u;
    const int aoff = lds_byte(wr * 64 + fr, fq * 8), boff = lds_byte(wc * 32 + fr, fq * 8);
#define PG8_SA(b, h) (((b) * 2 + (h)) * HTB)
#define PG8_SB(b, h) ((4 + (b) * 2 + (h)) * HTB)
#define PG8_STAGE(bufoff, gbase, voff) do { _Pragma("unroll") for (int _i = 0; _i < 2; ++_i) \
        glds16_s((const void*)(gbase), (voff)[_i], ldsb + (unsigned)((bufoff) + _i * 8192)); } while (0)
#define PG8_LDA(dst, b, h) do { _Pragma("unroll") for (int m = 0; m < 4; ++m) _Pragma("unroll") for (int k = 0; k < 2; ++k) dst[m][k] = *(const LAS bf16x8*)(lds + PG8_SA(b, h) + aoff + m * 2048 + k * 1024); } while (0)
#define PG8_LDB(dst, b, h) do { _Pragma("unroll") for (int n = 0; n < 2; ++n) _Pragma("unroll") for (int k = 0; k < 2; ++k) dst[n][k] = *(const LAS bf16x8*)(lds + PG8_SB(b, h) + boff + n * 2048 + k * 1024); } while (0)
#define PG8_MMA(ai, bj, At, Bt) do { __builtin_amdgcn_s_setprio(1); _Pragma("unroll") for (int m = 0; m < 4; ++m) _Pragma("unroll") for (int n = 0; n < 2; ++n) _Pragma("unroll") for (int k = 0; k < 2; ++k) \
        acc[ai][bj][m][n] = __builtin_amdgcn_mfma_f32_16x16x32_bf16(Bt[n][k], At[m][k], acc[ai][bj][m][n], 0, 0, 0); __builtin_amdgcn_s_setprio(0); } while (0)
#define PG8_WAIT_V(n) asm volatile("s_waitcnt vmcnt(" #n ")" ::: "memory")
#define PG8_WAIT_L(n) asm volatile("s_waitcnt lgkmcnt(" #n ")" ::: "memory")
#define PG8_BAR __builtin_amdgcn_s_barrier()
#define PG8_SCHED __builtin_amdgcn_sched_barrier(0)
#define PG8_AOFF(dst, u) do { _Pragma("unroll") for (int _h = 0; _h < 2; ++_h) _Pragma("unroll") for (int _i = 0; _i < 2; ++_i) { \
        if constexpr (GATHER) { int _r = (u).rows[_h * HALF + sR[_i]]; _r = _r < 0 ? 0 : _r; dst[_h][_i] = (unsigned)(_r * lda + sC[_i]) * 2u; } \
        else dst[_h][_i] = (unsigned)((_h * HALF + sR[_i]) * lda + sC[_i]) * 2u; } } while (0)
    GUnit cur, nxt; int ui = 0;
    if (!S.next(0, cur)) return;
    f32x4 acc[2][2][4][2];
#pragma unroll
    for (int a = 0; a < 2; ++a)
#pragma unroll
        for (int b = 0; b < 2; ++b)
#pragma unroll
            for (int m = 0; m < 4; ++m)
#pragma unroll
                for (int n = 0; n < 2; ++n) acc[a][b][m][n] = (f32x4){0.f, 0.f, 0.f, 0.f};
    bf16x8 At[4][2], B0[2][2], B1[2][2];
    unsigned oC[2][2], oN[2][2];
    PG8_AOFF(oC, cur);
    const char* cA = cur.A; const char* cB = cur.B;
    PG8_STAGE(PG8_SB(0, 0), cB, voffB); PG8_STAGE(PG8_SB(0, 1), cB + hstepB, voffB); PG8_STAGE(PG8_SA(0, 0), cA, oC[0]); PG8_STAGE(PG8_SA(0, 1), cA, oC[1]);
    if (wr == 1) PG8_BAR;
    PG8_WAIT_V(2); PG8_BAR;
    PG8_STAGE(PG8_SB(1, 0), cB + kstep, voffB); PG8_STAGE(PG8_SA(1, 0), cA + kstep, oC[0]); PG8_STAGE(PG8_SB(1, 1), cB + hstepB + kstep, voffB);
    PG8_WAIT_V(6); PG8_BAR;
    for (;;) {
        const bool has_next = S.next(ui + 1, nxt);
        const char* nA = has_next ? nxt.A : cA; const char* nB = has_next ? nxt.B : cB;
        if (has_next) { PG8_AOFF(oN, nxt); } else {
#pragma unroll
            for (int h = 0; h < 2; ++h)
#pragma unroll
                for (int i = 0; i < 2; ++i) oN[h][i] = oC[h][i]; }
        for (int t = 0; t < nt; t += 2) {
            const bool last = (t == nt - 2);
            const char* a1 = cA + (size_t)(t + 1) * kstep;
            const char* a2 = last ? nA : cA + (size_t)(t + 2) * kstep; const char* b2 = last ? nB : cB + (size_t)(t + 2) * kstep;
            const char* a3 = a2 + kstep; const char* b3 = b2 + kstep;
            unsigned o2[2][2];
#pragma unroll
            for (int h = 0; h < 2; ++h)
#pragma unroll
                for (int i = 0; i < 2; ++i) o2[h][i] = last ? oN[h][i] : oC[h][i];
            PG8_LDB(B0, 0, 0); PG8_LDB(B1, 0, 1); PG8_SCHED; PG8_LDA(At, 0, 0); PG8_STAGE(PG8_SA(1, 1), a1, oC[1]);
            PG8_WAIT_V(8); PG8_WAIT_L(0); PG8_BAR; PG8_MMA(0, 0, At, B0); PG8_MMA(0, 1, At, B1); PG8_BAR; PG8_SCHED;
            PG8_LDA(At, 0, 1); PG8_STAGE(PG8_SB(0, 0), b2, voffB); PG8_STAGE(PG8_SB(0, 1), b2 + hstepB, voffB); PG8_STAGE(PG8_SA(0, 0), a2, o2[0]);
            PG8_WAIT_V(8); PG8_WAIT_L(0); PG8_BAR; PG8_MMA(1, 0, At, B0); PG8_MMA(1, 1, At, B1); PG8_BAR; PG8_SCHED;
            PG8_LDB(B0, 1, 0); PG8_LDB(B1, 1, 1); PG8_SCHED; PG8_LDA(At, 1, 0); PG8_STAGE(PG8_SA(0, 1), a2, o2[1]);
            PG8_WAIT_V(8); PG8_WAIT_L(0); PG8_BAR; PG8_MMA(0, 0, At, B0); PG8_MMA(0, 1, At, B1); PG8_BAR; PG8_SCHED;
            PG8_LDA(At, 1, 1); PG8_STAGE(PG8_SB(1, 0), b3, voffB); PG8_STAGE(PG8_SB(1, 1), b3 + hstepB, voffB); PG8_STAGE(PG8_SA(1, 0), a3, o2[0]);
            PG8_WAIT_V(8); PG8_WAIT_L(0); PG8_BAR; PG8_MMA(1, 0, At, B0); PG8_MMA(1, 1, At, B1); PG8_BAR; PG8_SCHED;
        }
        if (wr == 0) PG8_BAR;
        E(acc, cur, wr, wc, fr, fq);
        if (!has_next) break;
#pragma unroll
        for (int a = 0; a < 2; ++a)
#pragma unroll
            for (int b = 0; b < 2; ++b)
#pragma unroll
                for (int m = 0; m < 4; ++m)
#pragma unroll
                    for (int n = 0; n < 2; ++n) acc[a][b][m][n] = (f32x4){0.f, 0.f, 0.f, 0.f};
        cur = nxt; cA = nA; cB = nB; ++ui;
#pragma unroll
        for (int h = 0; h < 2; ++h)
#pragma unroll
            for (int i = 0; i < 2; ++i) oC[h][i] = oN[h][i];
        if (wr == 1) PG8_BAR;
    }
    PG8_WAIT_V(0);
    PG8_BAR;
#undef PG8_SA
#undef PG8_SB
#undef PG8_STAGE
#undef PG8_LDA
#undef PG8_LDB
#undef PG8_MMA
#undef PG8_WAIT_V
#undef PG8_WAIT_L
#undef PG8_BAR
#undef PG8_SCHED
#undef PG8_AOFF
}
}
namespace att {
constexpr float QSCALE = 0.125f * 1.4426950408889634f;
constexpr int SHM_V = 16384, SHM_K = 8192;
constexpr int OFF_V = 0, OFF_K = 4 * SHM_V, OFF_WS = OFF_K + 4 * SHM_K, OFF_RPB = OFF_WS + NWAVES * 64 * 4, RPB_PITCH = 128, ATT_LDS = OFF_RPB + 15 * RPB_PITCH * 4;
#define ATT_KSWZ(row, colB) ((row) * 128 + ((colB) ^ ((((row) >> 1) & 7) << 4)))
#define ATT_SBAR() __builtin_amdgcn_sched_barrier(0)
__device__ __forceinline__ int crow(int r, int hi) { return (r & 3) + 8 * (r >> 2) + 4 * hi; }

__device__ __forceinline__ void firstSM(f32x16& p0, f32x16& p1, float& mhat, f32x16& negm) {
#define ATT_MX3(a, b, c) __builtin_fmaxf(__builtin_fmaxf((a), (b)), (c))
    float a = ATT_MX3(p0[0], p0[1], p1[0]), b = ATT_MX3(p0[2], p0[3], p1[1]); a = ATT_MX3(a, p1[2], p1[3]);
#pragma unroll
    for (int r = 4; r < 16; r += 4) { a = ATT_MX3(a, p0[r], p0[r + 1]); b = ATT_MX3(b, p0[r + 2], p0[r + 3]); a = ATT_MX3(a, p1[r], p1[r + 1]); b = ATT_MX3(b, p1[r + 2], p1[r + 3]); }
#undef ATT_MX3
    float pmax = fmaxf(a, b);
    { auto rr = __builtin_amdgcn_permlane32_swap(__float_as_uint(pmax), __float_as_uint(pmax), false, false);
      pmax = fmaxf(__uint_as_float(rr[0]), __uint_as_float(rr[1])); }
    mhat += pmax;
#pragma unroll
    for (int r = 0; r < 16; ++r) { p0[r] = __builtin_amdgcn_exp2f(p0[r] - pmax); p1[r] = __builtin_amdgcn_exp2f(p1[r] - pmax); negm[r] = -mhat; }
}
__device__ __forceinline__ void sumcvt(const f32x16& p0, const f32x16& p1, float alpha, float& l_reg, bf16x8& pa0, bf16x8& pa1, bf16x8& pa2, bf16x8& pa3) {
    { f32x2 s2 = (f32x2){p0[0], p0[1]} + (f32x2){p1[0], p1[1]};
#pragma unroll
      for (int r = 2; r < 16; r += 2) { s2 += (f32x2){p0[r], p0[r + 1]}; s2 += (f32x2){p1[r], p1[r + 1]}; }
      float ps = s2[0] + s2[1];
      auto rr = __builtin_amdgcn_permlane32_swap(__float_as_uint(ps), __float_as_uint(ps), false, false);
      ps = __uint_as_float(rr[0]) + __uint_as_float(rr[1]);
      l_reg = l_reg * alpha + ps; }
#define ATT_PK4(P, BASE, OUT) do { u32x4 w = {cvt_pk_bf16(P[BASE + 0], P[BASE + 1]), cvt_pk_bf16(P[BASE + 2], P[BASE + 3]), cvt_pk_bf16(P[BASE + 4], P[BASE + 5]), cvt_pk_bf16(P[BASE + 6], P[BASE + 7])}; \
    OUT = __builtin_bit_cast(bf16x8, w); } while (0)
    ATT_PK4(p0, 0, pa0); ATT_PK4(p0, 8, pa1); ATT_PK4(p1, 0, pa2); ATT_PK4(p1, 8, pa3);
#undef ATT_PK4
}
__device__ __forceinline__ void qkt(f32x16& p0, f32x16& p1, const LAS unsigned char* Ks, const bf16x8* qr, const f32x16& negm, int r32, int hi) {
    p0 = negm; p1 = negm;
#pragma unroll
    for (int d0 = 0; d0 < 4; ++d0) { const int cb = (d0 * 16 + hi * 8) * 2;
        const bf16x8 b0 = *(const LAS bf16x8*)(Ks + ATT_KSWZ(r32, cb));
        const bf16x8 b1 = *(const LAS bf16x8*)(Ks + ATT_KSWZ(32 + r32, cb));
        p0 = __builtin_amdgcn_mfma_f32_32x32x16_bf16(b0, qr[d0], p0, 0, 0, 0);
        p1 = __builtin_amdgcn_mfma_f32_32x32x16_bf16(b1, qr[d0], p1, 0, 0, 0); }
}
__device__ __forceinline__ int v_st(int k, int c) { const int kk = k;     return ((kk >> 3) * 4 + (c >> 5)) * 512 + ((kk & 7) * 32 + (c & 31)) * 2; }
__device__ __forceinline__ int v_rd_base(int lane) { return ((lane & 3) << 3) | (((lane >> 2) & 3) << 6) | (((lane >> 4) & 1) << 5) | (((lane >> 5) & 1) << 8); }
constexpr int v_rd_off(int d0, int ks, int half) { return d0 * 512 + ks * 4096 + half * 2048; }
template <int OFF> __device__ __forceinline__ s16x4 tr_read(int vb) {
    s16x4 r; asm volatile("ds_read_b64_tr_b16 %0, %1 offset:%2" : "=&v"(r) : "v"(vb), "i"(OFF) : "memory"); return r;
}
template <int D0> __device__ __forceinline__ void pv_one(f32x16& od, int vb, bf16x8 pa0, bf16x8 pa1, bf16x8 pa2, bf16x8 pa3) {
    const s16x4 l0 = tr_read<v_rd_off(D0, 0, 0)>(vb), h0 = tr_read<v_rd_off(D0, 0, 1)>(vb), l1 = tr_read<v_rd_off(D0, 1, 0)>(vb), h1 = tr_read<v_rd_off(D0, 1, 1)>(vb);
    const s16x4 l2 = tr_read<v_rd_off(D0, 2, 0)>(vb), h2 = tr_read<v_rd_off(D0, 2, 1)>(vb), l3 = tr_read<v_rd_off(D0, 3, 0)>(vb), h3 = tr_read<v_rd_off(D0, 3, 1)>(vb);
    asm volatile("s_waitcnt lgkmcnt(0)" ::: "memory"); ATT_SBAR();
#define ATT_PKV(L, H) (bf16x8){L[0], L[1], L[2], L[3], H[0], H[1], H[2], H[3]}
    od = __builtin_amdgcn_mfma_f32_32x32x16_bf16(pa0, ATT_PKV(l0, h0), od, 0, 0, 0);
    od = __builtin_amdgcn_mfma_f32_32x32x16_bf16(pa1, ATT_PKV(l1, h1), od, 0, 0, 0);
    od = __builtin_amdgcn_mfma_f32_32x32x16_bf16(pa2, ATT_PKV(l2, h2), od, 0, 0, 0);
    od = __builtin_amdgcn_mfma_f32_32x32x16_bf16(pa3, ATT_PKV(l3, h3), od, 0, 0, 0);
#undef ATT_PKV
}
template <int DV> __device__ __forceinline__ void pv_all(f32x16* o, int vb, bf16x8 pa0, bf16x8 pa1, bf16x8 pa2, bf16x8 pa3) {
    pv_one<0>(o[0], vb, pa0, pa1, pa2, pa3); pv_one<1>(o[1], vb, pa0, pa1, pa2, pa3);
    if constexpr (DV == 128) { pv_one<2>(o[2], vb, pa0, pa1, pa2, pa3); pv_one<3>(o[3], vb, pa0, pa1, pa2, pa3); }
}

#define ATT_VADD(acc, x) asm volatile("v_add_f32 %0, %1, %0" : "+v"(acc) : "v"(x))
template <int DV> __device__ __forceinline__ float sum_tail(const f32x16& e1, const float (&sm)[4], float odd);
template <int OFF> __device__ __forceinline__ bf16x8 k_read(int addr) { bf16x8 r; asm volatile("ds_read_b128 %0, %1 offset:%2" : "=&v"(r) : "v"(addr), "i"(OFF) : "memory"); return r; }
template <int G> __device__ __forceinline__ void qk_fill(const f32x16& e0, const f32x16& e1, unsigned (&w)[16], float (&so)[2]) {
    const f32x16& e = (G < 4) ? e0 : e1; constexpr int b = (G & 3) * 4;
    typedef __bf16 bf2_t __attribute__((ext_vector_type(2)));
    w[2 * G] = __builtin_bit_cast(unsigned, __builtin_convertvector((f32x2){e[b], e[b + 1]}, bf2_t)); w[2 * G + 1] = __builtin_bit_cast(unsigned, __builtin_convertvector((f32x2){e[b + 2], e[b + 3]}, bf2_t));
    if constexpr (G == 0) { so[0] = e[b + 1]; so[1] = e[b + 3]; } else { ATT_VADD(so[0], e[b + 1]); ATT_VADD(so[1], e[b + 3]); }
}
#define ATT_KW(n, x) asm volatile("s_waitcnt lgkmcnt(" #n ")" : "+v"(x) :: "memory")
template <int DV, int KOFF, int VB>
__device__ __forceinline__ void qk_sum(f32x16& p0, f32x16& p1, const int (&ka)[4], const bf16x8* qr, const f32x16& negm, const f32x16& e0, const f32x16& e1, const float (&smi)[4], float& l_reg,
                                       bf16x8& pa0, bf16x8& pa1, bf16x8& pa2, bf16x8& pa3, int vb, s16x4 (&f)[8], bf16x8& a0, bf16x8& b0, bf16x8& a1, bf16x8& b1) {
    unsigned w[16]; float so[2];
    ATT_KW(3, a0); asm volatile("v_mfma_f32_32x32x16_bf16 %0, %1, %2, %3" : "=&v"(p0) : "v"(a0), "v"(qr[0]), "v"(negm)); qk_fill<0>(e0, e1, w, so); ATT_SBAR();
    ATT_KW(2, b0); asm volatile("v_mfma_f32_32x32x16_bf16 %0, %1, %2, %3" : "=&v"(p1) : "v"(b0), "v"(qr[0]), "v"(negm));
    a0 = k_read<KOFF>(ka[2]); b0 = k_read<KOFF + 4096>(ka[2]); qk_fill<1>(e0, e1, w, so); ATT_SBAR();
    ATT_KW(3, a1); p0 = __builtin_amdgcn_mfma_f32_32x32x16_bf16(a1, qr[1], p0, 0, 0, 0); qk_fill<2>(e0, e1, w, so); ATT_SBAR();
    ATT_KW(2, b1); p1 = __builtin_amdgcn_mfma_f32_32x32x16_bf16(b1, qr[1], p1, 0, 0, 0);
    a1 = k_read<KOFF>(ka[3]); b1 = k_read<KOFF + 4096>(ka[3]); qk_fill<3>(e0, e1, w, so); ATT_SBAR();
    ATT_KW(3, a0); p0 = __builtin_amdgcn_mfma_f32_32x32x16_bf16(a0, qr[2], p0, 0, 0, 0);
    f[0] = tr_read<VB + v_rd_off(0, 0, 0)>(vb); f[1] = tr_read<VB + v_rd_off(0, 0, 1)>(vb); f[2] = tr_read<VB + v_rd_off(0, 1, 0)>(vb); f[3] = tr_read<VB + v_rd_off(0, 1, 1)>(vb);
    qk_fill<4>(e0, e1, w, so); ATT_SBAR();
    ATT_KW(6, b0); p1 = __builtin_amdgcn_mfma_f32_32x32x16_bf16(b0, qr[2], p1, 0, 0, 0);
    f[4] = tr_read<VB + v_rd_off(0, 2, 0)>(vb); f[5] = tr_read<VB + v_rd_off(0, 2, 1)>(vb); f[6] = tr_read<VB + v_rd_off(0, 3, 0)>(vb); f[7] = tr_read<VB + v_rd_off(0, 3, 1)>(vb);
    qk_fill<5>(e0, e1, w, so); ATT_SBAR();
    ATT_KW(9, a1); p0 = __builtin_amdgcn_mfma_f32_32x32x16_bf16(a1, qr[3], p0, 0, 0, 0); qk_fill<6>(e0, e1, w, so); ATT_SBAR();
    ATT_KW(8, b1); p1 = __builtin_amdgcn_mfma_f32_32x32x16_bf16(b1, qr[3], p1, 0, 0, 0); qk_fill<7>(e0, e1, w, so); ATT_SBAR();
    l_reg += sum_tail<DV>(e1, smi, so[0] + so[1]);
    pa0 = __builtin_bit_cast(bf16x8, (u32x4){w[0], w[1], w[2], w[3]}); pa1 = __builtin_bit_cast(bf16x8, (u32x4){w[4], w[5], w[6], w[7]});
    pa2 = __builtin_bit_cast(bf16x8, (u32x4){w[8], w[9], w[10], w[11]}); pa3 = __builtin_bit_cast(bf16x8, (u32x4){w[12], w[13], w[14], w[15]});
}
template <int DV, int G> __device__ __forceinline__ void pvx_fill(f32x16& q0, f32x16& q1, float (&sm)[4]) {
    constexpr int NG = DV / 8, EPG = 32 / NG;
#define ATT_QV(i) (((i) < 16) ? q0[(i) & 15] : q1[(i) & 15])
#pragma unroll
    for (int e = 0; e < EPG; ++e) { constexpr int i0 = G * EPG; const int i = i0 + e; if (i < 16) q0[i & 15] = __builtin_amdgcn_exp2f(q0[i & 15]); else q1[i & 15] = __builtin_amdgcn_exp2f(q1[i & 15]); }
    if constexpr (G > 0) {
#pragma unroll
        for (int e = 0; e < EPG; e += 2) { const int i = (G - 1) * EPG + e;
            if (i < 4) { sm[(i >> 1) & 1] = ATT_QV(i); asm volatile("" :: "v"(ATT_QV(i + 1))); } else asm volatile("v_add_f32 %0, %1, %0" : "+v"(sm[(i >> 1) & 1]) : "v"(ATT_QV(i)), "v"(ATT_QV(i + 1))); } }
#undef ATT_QV
}
template <int DV, int D0, int VB, bool NOWAIT = false> __device__ __forceinline__ void pvx_grp(f32x16& od, int vb, bf16x8 pa0, bf16x8 pa1, bf16x8 pa2, bf16x8 pa3, s16x4 (&f)[8], f32x16& q0, f32x16& q1, float (&sm)[4]) {
    constexpr int ND = DV / 32; constexpr bool NX = (D0 + 1 < ND);
#define ATT_PKV(L, H) (bf16x8){L[0], L[1], L[2], L[3], H[0], H[1], H[2], H[3]}
#define ATT_PVGAP(KS, PA, WNX, WLAST) do { \
    if constexpr (NOWAIT) { } else if constexpr (NX) asm volatile("s_waitcnt lgkmcnt(" #WNX ")" : "+v"(f[2 * KS]), "+v"(f[2 * KS + 1]) :: "memory"); else asm volatile("s_waitcnt lgkmcnt(" #WLAST ")" : "+v"(f[2 * KS]), "+v"(f[2 * KS + 1]) :: "memory"); \
    od = __builtin_amdgcn_mfma_f32_32x32x16_bf16(PA, ATT_PKV(f[2 * KS], f[2 * KS + 1]), od, 0, 0, 0); \
    if constexpr (NX) { f[2 * KS] = tr_read<VB + v_rd_off(NX ? D0 + 1 : 0, KS, 0)>(vb); f[2 * KS + 1] = tr_read<VB + v_rd_off(NX ? D0 + 1 : 0, KS, 1)>(vb); } \
    pvx_fill<DV, D0 * 4 + KS>(q0, q1, sm); ATT_SBAR(); } while (0)
    ATT_PVGAP(0, pa0, 6, 6); ATT_PVGAP(1, pa1, 6, 4); ATT_PVGAP(2, pa2, 6, 2); ATT_PVGAP(3, pa3, 6, 0);
#undef ATT_PVGAP
#undef ATT_PKV
}
template <int DV, int VB> __device__ __forceinline__ void pv_head(f32x16* o, int vb, bf16x8 pa0, bf16x8 pa1, bf16x8 pa2, bf16x8 pa3, s16x4 (&f)[8], f32x16& q0, f32x16& q1, float (&sm)[4]) {
    ATT_SBAR();
    pvx_grp<DV, 0, VB>(o[0], vb, pa0, pa1, pa2, pa3, f, q0, q1, sm);
    if constexpr (DV == 128) { pvx_grp<DV, 1, VB>(o[1], vb, pa0, pa1, pa2, pa3, f, q0, q1, sm); pvx_grp<DV, 2, VB>(o[2], vb, pa0, pa1, pa2, pa3, f, q0, q1, sm); }
}
template <int DV, int VB> __device__ __forceinline__ void pv_tail(f32x16* o, int vb, bf16x8 pa0, bf16x8 pa1, bf16x8 pa2, bf16x8 pa3, s16x4 (&f)[8], f32x16& q0, f32x16& q1, float (&sm)[4]) {
    ATT_SBAR();
    pvx_grp<DV, DV / 32 - 1, VB, true>(o[DV / 32 - 1], vb, pa0, pa1, pa2, pa3, f, q0, q1, sm);
}
template <int DV> __device__ __forceinline__ float sum_tail(const f32x16& e1, const float (&sm)[4], float odd) {
    float ps;
    if constexpr (DV == 128) ps = ((sm[0] + sm[1]) + e1[14]) + odd;
    else ps = ((sm[0] + e1[12]) + (sm[1] + e1[14])) + odd;
    auto rr = __builtin_amdgcn_permlane32_swap(__float_as_uint(ps), __float_as_uint(ps), false, false);
    return __uint_as_float(rr[0]) + __uint_as_float(rr[1]);
}
__device__ __forceinline__ unsigned na_colmask(int cq, int hi) {
    const int cst = min(max(cq - 8, 0), 48); unsigned m = 0u;
#pragma unroll
    for (int r = 0; r < 16; ++r) { const int kc = crow(r, hi); if (!((unsigned)(kc - cst) < 16u)) m |= 1u << r; if (!((unsigned)(kc + 32 - cst) < 16u)) m |= 1u << (16 + r); }
    return m;
}
__device__ __forceinline__ void na_mask(f32x16& p0, f32x16& p1, int krow, int qrow, int cq, int hi, unsigned cmi, const LAS float* tbl) {
    const int start = min(max(qrow - 4, 0), 56);
    if ((krow >= start) && (krow < start + 8)) {
        const LAS float* tb = tbl + (krow - qrow + 7) * RPB_PITCH + (63 - cq + 4 * hi);
#pragma unroll
        for (int r = 0; r < 16; ++r) { const int cr = (r & 3) + 8 * (r >> 2);
            const float pen0 = __uint_as_float((unsigned)__builtin_amdgcn_sbfe(cmi, r, 1) & 0xF149F2CAu), pen1 = __uint_as_float((unsigned)__builtin_amdgcn_sbfe(cmi, 16 + r, 1) & 0xF149F2CAu);
            p0[r] = (p0[r] + tb[cr]) + pen0; p1[r] = (p1[r] + tb[cr + 32]) + pen1; }
    } else {
#pragma unroll
        for (int r = 0; r < 16; ++r) { p0[r] = -1e30f; p1[r] = -1e30f; }
    }
}

template <int DV, int MODE>
__device__ __forceinline__ void attn_body(const bf16* __restrict__ Qp, const bf16* __restrict__ Kp, const bf16* __restrict__ Vp, int baseA, int nA, int baseB, int NT,
                                          LAS unsigned char* lds, f32x16 (&o)[DV / 32], int qrow, int kmin, unsigned long long* dbg = nullptr, const bf16* KpN = nullptr, const bf16* VpN = nullptr, bool pre_in = false) {
    const int tid = tid_opaque(), wid = __builtin_amdgcn_readfirstlane(tid >> 6), lane = tid & 63, r32 = lane & 31, hi = lane >> 5;
    LAS unsigned char* V_lds = lds + OFF_V; LAS unsigned char* K_lds = lds + OFF_K;
    LAS float* al_l = (LAS float*)(lds + OFF_WS) + wid * 64; LAS float* li_l = al_l + 32;
    const LAS float* tbl = (const LAS float*)(lds + OFF_RPB);
    const int cq = (wid & 1) * 32 + r32; const unsigned cmi = (MODE == 1) ? na_colmask(cq, hi) : 0u;
    float mhat = 0.f, l_reg = 0.f; f32x16 negm = f32x16{}; bf16x8 qr[4];
#pragma unroll
    for (int d = 0; d < DV / 32; ++d) o[d] = f32x16{};
    { const bf16* Qw = Qp + (size_t)(wid * 32 + r32) * PW + hi * 8;
#pragma unroll
      for (int d0 = 0; d0 < 4; ++d0) qr[d0] = *(const bf16x8*)(Qw + d0 * 16); }
    const int kr = tid >> 3;
    const unsigned voffK = (unsigned)(kr * PW + (((tid & 7) ^ ((kr >> 1) & 7)) * 8)) * 2u;
    const unsigned voffV = (DV == 128) ? (unsigned)((8 * (wid >> 1) + ((lane & 31) >> 2)) * PW + (2 * (wid & 1) + (lane >> 5)) * 32 + (lane & 3) * 8) * 2u
                                       : (unsigned)((8 * wid + ((lane & 31) >> 2)) * PW + (lane >> 5) * 32 + (lane & 3) * 8) * 2u;
    const unsigned ldsK = (unsigned)(uintptr_t)K_lds + (unsigned)wid * 1024u, ldsV = (unsigned)(uintptr_t)V_lds + (unsigned)wid * ((DV == 128) ? 1024u : 2048u);
    const int vb0 = (int)(unsigned)(uintptr_t)V_lds + v_rd_base(lane);
#define ATT_TROW(t) ((t) < nA ? baseA + 64 * (t) : baseB + 64 * ((t) - nA))
#define ATT_DMAV(vb, t) do { const char* vs_ = (const char*)(Vp + (size_t)ATT_TROW(t) * PW); pg8::glds16_s(vs_, voffV, ldsV + (vb) * SHM_V); \
    if constexpr (DV == 128) pg8::glds16_s(vs_ + (size_t)32 * PW * 2, voffV, ldsV + (vb) * SHM_V + 8192); } while (0)
#define ATT_DMAK(kb, t) do { pg8::glds16_s((const char*)(Kp + (size_t)ATT_TROW(t) * PW), voffK, ldsK + (kb) * SHM_K); } while (0)
#define ATT_SLOT_END() do { asm volatile("s_waitcnt vmcnt(0)" ::: "memory"); asm volatile("s_waitcnt lgkmcnt(0)" ::: "memory"); __builtin_amdgcn_s_barrier(); ATT_SBAR(); } while (0)
#define ATT_MASK(P0, P1, t) do { if constexpr (MODE == 1) { if ((t) >= nA) na_mask(P0, P1, kmin + (t) - nA, qrow, cq, hi, cmi, tbl); } } while (0)
    f32x16 pA0, pA1, pB0, pB1; bf16x8 pa0, pa1, pa2, pa3, ka0, kb0, ka1, kb1; s16x4 vf[8]; float sm[4];
    int ka[4];
#pragma unroll
    for (int d0 = 0; d0 < 4; ++d0) ka[d0] = (int)(unsigned)(uintptr_t)K_lds + ATT_KSWZ(r32, (d0 * 16 + hi * 8) * 2);
#define ATT_KPRE(KOFF) do { ka0 = k_read<KOFF>(ka[0]); kb0 = k_read<KOFF + 4096>(ka[0]); ka1 = k_read<KOFF>(ka[1]); kb1 = k_read<KOFF + 4096>(ka[1]); } while (0)
    __syncthreads();
    if (!pre_in) { ATT_DMAK(0, 0); ATT_DMAK(1, 1); ATT_DMAV(0, 0); }
    ATT_SLOT_END();
    if (!pre_in) { ATT_DMAK(2, 2); ATT_DMAK(3, 3); ATT_DMAV(1, 1); ATT_DMAV(2, 2); }
    qkt(pA0, pA1, K_lds, qr, negm, r32, hi); ATT_MASK(pA0, pA1, 0); firstSM(pA0, pA1, mhat, negm);
    { constexpr int NL = (DV == 128) ? 14 : 12; float t0 = 0.f, t1 = 0.f;
#pragma unroll
      for (int r = 0; r < 16; r += 4) { t0 += pA0[r]; t1 += pA0[r + 2]; }
#pragma unroll
      for (int r = 0; r < NL; r += 2) { if (r & 2) t1 += pA1[r]; else t0 += pA1[r]; }
      sm[0] = t0; sm[1] = t1; sm[2] = 0.f; sm[3] = 0.f; }
    ATT_KPRE(SHM_K); ATT_SBAR();
    qk_sum<DV, SHM_K, 0>(pB0, pB1, ka, qr, negm, pA0, pA1, sm, l_reg, pa0, pa1, pa2, pa3, vb0, vf, ka0, kb0, ka1, kb1); ATT_MASK(pB0, pB1, 1);
#ifdef ATT_PROBE
    const unsigned long long tc0 = __builtin_amdgcn_s_memtime();
#endif
#define ATT_STEP_BAR(VH, KQ, VN, QE0, QE1, QN0, QN1, tq, DMAS) do { \
        pv_head<DV, (VH) * SHM_V>(o, vb0, pa0, pa1, pa2, pa3, vf, QE0, QE1, sm); \
        ATT_SLOT_END(); ATT_KPRE((KQ) * SHM_K); ATT_SBAR(); \
        pv_tail<DV, (VH) * SHM_V>(o, vb0, pa0, pa1, pa2, pa3, vf, QE0, QE1, sm); DMAS; ATT_SBAR(); \
        qk_sum<DV, (KQ) * SHM_K, (VN) * SHM_V>(QN0, QN1, ka, qr, negm, QE0, QE1, sm, l_reg, pa0, pa1, pa2, pa3, vb0, vf, ka0, kb0, ka1, kb1); ATT_MASK(QN0, QN1, tq); } while (0)
#define ATT_STEP_NOBAR(VH, KQ, VN, QE0, QE1, QN0, QN1, tq, DMAS) do { \
        pv_head<DV, (VH) * SHM_V>(o, vb0, pa0, pa1, pa2, pa3, vf, QE0, QE1, sm); \
        ATT_KPRE((KQ) * SHM_K); asm volatile("s_waitcnt lgkmcnt(4)" ::: "memory"); ATT_SBAR();     \
        pv_tail<DV, (VH) * SHM_V>(o, vb0, pa0, pa1, pa2, pa3, vf, QE0, QE1, sm); DMAS; ATT_SBAR(); \
        qk_sum<DV, (KQ) * SHM_K, (VN) * SHM_V>(QN0, QN1, ka, qr, negm, QE0, QE1, sm, l_reg, pa0, pa1, pa2, pa3, vb0, vf, ka0, kb0, ka1, kb1); ATT_MASK(QN0, QN1, tq); } while (0)
    int t = 0;
    for (; t + 4 < NT; t += 4) {
        ATT_STEP_BAR(0, 2, 1, pB0, pB1, pA0, pA1, t + 2, { ATT_DMAV(3, t + 3); ATT_DMAK(0, t + 4); });
        ATT_STEP_NOBAR(1, 3, 2, pA0, pA1, pB0, pB1, t + 3, { ATT_DMAV(0, t + 4); ATT_DMAK(1, t + 5); });
        ATT_STEP_BAR(2, 0, 3, pB0, pB1, pA0, pA1, t + 4, { ATT_DMAV(1, t + 5); ATT_DMAK(2, t + 6); });
        ATT_STEP_NOBAR(3, 1, 0, pA0, pA1, pB0, pB1, t + 5, { ATT_DMAV(2, t + 6); ATT_DMAK(3, t + 7); });
    }
#ifdef ATT_PROBE
    if (DV == 128 && dbg && lane == 0 && wid == 0) { atomicAdd(dbg + 0, __builtin_amdgcn_s_memtime() - tc0); atomicAdd(dbg + 1, (unsigned long long)(NT - 4)); }
#endif
    ATT_STEP_BAR(0, 2, 1, pB0, pB1, pA0, pA1, t + 2, { ATT_DMAV(3, t + 3); });
    ATT_STEP_NOBAR(1, 3, 2, pA0, pA1, pB0, pB1, t + 3, { });
    pv_head<DV, 2 * SHM_V>(o, vb0, pa0, pa1, pa2, pa3, vf, pB0, pB1, sm);
    ATT_SLOT_END(); ATT_SBAR();
    if (KpN) {
#define ATT_DMAVN(vb, t) do { const char* vs_ = (const char*)(VpN + (size_t)ATT_TROW(t) * PW); pg8::glds16_s(vs_, voffV, ldsV + (vb) * SHM_V); \
    if constexpr (DV == 128) pg8::glds16_s(vs_ + (size_t)32 * PW * 2, voffV, ldsV + (vb) * SHM_V + 8192); } while (0)
#define ATT_DMAKN(kb, t) do { pg8::glds16_s((const char*)(KpN + (size_t)ATT_TROW(t) * PW), voffK, ldsK + (kb) * SHM_K); } while (0)
        ATT_DMAKN(0, 0); ATT_DMAKN(1, 1); ATT_DMAVN(0, 0); ATT_DMAKN(2, 2); ATT_DMAKN(3, 3); ATT_DMAVN(1, 1); ATT_DMAVN(2, 2); ATT_SBAR();
#undef ATT_DMAVN
#undef ATT_DMAKN
    }
    pv_tail<DV, 2 * SHM_V>(o, vb0, pa0, pa1, pa2, pa3, vf, pB0, pB1, sm);
    { float od = 0.f;
#pragma unroll
      for (int r = 1; r < 16; r += 2) od += pB0[r] + pB1[r];
      l_reg += sum_tail<DV>(pB1, sm, od); }
    { float dummy = 0.f; sumcvt(pB0, pB1, 1.f, dummy, pa0, pa1, pa2, pa3); } ATT_SBAR();
    pv_all<DV>(o, vb0 + 3 * SHM_V, pa0, pa1, pa2, pa3);
#undef ATT_STEP_BAR
#undef ATT_STEP_NOBAR
#undef ATT_KPRE
    if (hi == 0) li_l[r32] = l_reg; asm volatile("s_waitcnt lgkmcnt(0)" ::: "memory");
#pragma unroll
    for (int r = 0; r < 16; ++r) { const float rl = __builtin_amdgcn_rcpf(li_l[crow(r, hi)]);
#pragma unroll
        for (int d = 0; d < DV / 32; ++d) o[d][r] *= rl; }
#undef ATT_TROW
#undef ATT_DMAV
#undef ATT_DMAK
#undef ATT_SLOT_END
#undef ATT_MASK
}
}
struct Params { const float* in[34]; float* out; unsigned char* ws; };
#define CAS __attribute__((address_space(4)))
struct KA { const CAS unsigned char* k;
    __device__ __forceinline__ const float* in(int i) const { return *(const float* const CAS*)(k + 8 * i); }
    __device__ __forceinline__ float* out() const { return *(float* const CAS*)(k + 8 * 34); }
    __device__ __forceinline__ unsigned char* ws() const { return *(unsigned char* const CAS*)(k + 8 * 35); } };
enum { I_X = 0, I_C, I_CTX, I_CCTX, I_WMOD, I_BMOD, I_GMIX, I_GFFN, I_WIN, I_WOUT, I_LAMRE, I_LAMIM, I_BRE, I_BIM, I_CRE, I_CIM, I_LOGSTEP, I_SSMD, I_WGLU, I_BGLU,
       I_LQ1, I_LK1, I_LQ2, I_LK2, I_SUBLN, I_RPB, I_FW1, I_FW3, I_FW2, I_ROUTER, I_MW1, I_MW3, I_MW2, I_GFINAL };

__device__ __forceinline__ size_t res_off(int r, bool& is_ctx) { const int b = r / RB, n = r - b * RB; is_ctx = n >= SEQ; return is_ctx ? ((size_t)b * CTXL + (n - SEQ)) * DM : ((size_t)b * SEQ + n) * DM; }

using pg8::GUnit;
#define EPI_ROWS_COLS const int row0 = wr * 64 + fr, col0 = wc * 32 + 8 * fq
__device__ __forceinline__ u32x4 pack8(f32x4 a, f32x4 b) { u32x4 w; w.x = cvt_pk_bf16(a[0], a[1]); w.y = cvt_pk_bf16(a[2], a[3]); w.z = cvt_pk_bf16(b[0], b[1]); w.w = cvt_pk_bf16(b[2], b[3]); return w; }

struct EpiInProj {
    bf16* P; bf16* A2; const float* rope;
    __device__ __forceinline__ void operator()(const f32x4 (&acc)[2][2][4][2], const GUnit& u, int wr, int wc, int fr, int fq) const {
        EPI_ROWS_COLS; const int pl = u.pm % PPB; const bool lat = pl < 16;
        if (u.pn == 0) {
#pragma unroll
            for (int ai = 0; ai < 2; ++ai)
#pragma unroll
                for (int m = 0; m < 4; ++m) { const int r = u.pm * 256 + ai * 128 + row0 + m * 16;
#pragma unroll
                    for (int bj = 0; bj < 2; ++bj) { const int c = bj * 128 + col0, g = c >> 4, h0 = c & 15;
                        *(u32x4*)(A2 + ((size_t)g * NR16 + (r >> 4)) * 512 + 256 + (r & 15) * 16 + h0) = pack8(acc[ai][bj][m][0], acc[ai][bj][m][1]); } }
        } else {
            const bool rope_on = lat && u.pn <= 4; const int pcol0 = u.pn * 256 - 256;
            const float qs = (u.pn <= 2 || u.pn == 7) ? att::QSCALE : 1.f;
#pragma unroll
            for (int ai = 0; ai < 2; ++ai)
#pragma unroll
                for (int m = 0; m < 4; ++m) { const int rl = ai * 128 + row0 + m * 16, r = u.pm * 256 + rl, t = pl * 256 + rl;
#pragma unroll
                    for (int bj = 0; bj < 2; ++bj) { const int c = bj * 128 + col0; f32x4 v0 = acc[ai][bj][m][0] * qs, v1 = acc[ai][bj][m][1] * qs;
                        if (rope_on) { const int i0 = (c & 63) >> 1, axis = i0 >> 4, k0 = i0 & 15, pos = axis ? (t & 63) : (t >> 6);
                            const f32x4 cs0 = *(const f32x4*)(rope + (pos * 16 + k0) * 2), cs1 = *(const f32x4*)(rope + (pos * 16 + k0) * 2 + 4);
                            f32x4 w0, w1;
                            w0[0] = v0[0] * cs0[0] - v0[1] * cs0[1]; w0[1] = v0[0] * cs0[1] + v0[1] * cs0[0];
                            w0[2] = v0[2] * cs0[2] - v0[3] * cs0[3]; w0[3] = v0[2] * cs0[3] + v0[3] * cs0[2];
                            w1[0] = v1[0] * cs1[0] - v1[1] * cs1[1]; w1[1] = v1[0] * cs1[1] + v1[1] * cs1[0];
                            w1[2] = v1[2] * cs1[2] - v1[3] * cs1[3]; w1[3] = v1[2] * cs1[3] + v1[3] * cs1[2];
                            v0 = w0; v1 = w1; }
                        *(u32x4*)(P + (size_t)r * PW + pcol0 + c) = pack8(v0, v1); } }
        }
    }
};
struct EpiZ {
    float* Z;
    __device__ __forceinline__ void operator()(const f32x4 (&acc)[2][2][4][2], const GUnit& u, int wr, int wc, int fr, int fq) const {
        EPI_ROWS_COLS;
#pragma unroll
        for (int ai = 0; ai < 2; ++ai)
#pragma unroll
            for (int m = 0; m < 4; ++m) { float* rp = Z + ((size_t)u.aux * NR16 + u.pm * 256 + ai * 128 + row0 + m * 16) * 256;
#pragma unroll
                for (int bj = 0; bj < 2; ++bj) { *(f32x4*)(rp + bj * 128 + col0) = acc[ai][bj][m][0]; *(f32x4*)(rp + bj * 128 + col0 + 4) = acc[ai][bj][m][1]; } }
    }
};
struct EpiY {
    bf16* G;
    __device__ __forceinline__ void operator()(const f32x4 (&acc)[2][2][4][2], const GUnit& u, int wr, int wc, int fr, int fq) const {
        EPI_ROWS_COLS;
#pragma unroll
        for (int ai = 0; ai < 2; ++ai)
#pragma unroll
            for (int m = 0; m < 4; ++m) { const int r16 = u.pm * 256 + ai * 128 + row0 + m * 16;
#pragma unroll
                for (int bj = 0; bj < 2; ++bj) { const int c = bj * 128 + col0, i = c >> 4, h0 = c & 15; f32x4 v0 = acc[ai][bj][m][0], v1 = acc[ai][bj][m][1];
#pragma unroll
                    for (int k = 0; k < 4; ++k) { v0[k] = gelu_tanh(v0[k]); v1[k] = gelu_tanh(v1[k]); }
                    *(u32x4*)(G + ((size_t)r16 * 16 + i) * 256 + u.aux * 16 + h0) = pack8(v0, v1); } }
    }
};
struct EpiGlu {
    const bf16* G; bf16* Y; const float* bglu;
    __device__ __forceinline__ void operator()(const f32x4 (&acc)[2][2][4][2], const GUnit& u, int wr, int wc, int fr, int fq) const {
        EPI_ROWS_COLS;
#pragma unroll
        for (int bj = 0; bj < 2; ++bj) { const int c = bj * 128 + col0; const f32x4 b0 = *(const f32x4*)(bglu + c), b1 = *(const f32x4*)(bglu + c + 4);
#pragma unroll
            for (int ai = 0; ai < 2; ++ai)
#pragma unroll
                for (int m = 0; m < 4; ++m) { const size_t r = (size_t)u.pm * 256 + ai * 128 + row0 + m * 16;
                    const u32x4 gw = *(const u32x4*)(G + r * 256 + c); f32x4 v0 = acc[ai][bj][m][0] + b0, v1 = acc[ai][bj][m][1] + b1;
                    v0[0] = bf2f(gw.x & 0xffffu) * sigmoidf_(v0[0]); v0[1] = bf2f(gw.x >> 16) * sigmoidf_(v0[1]); v0[2] = bf2f(gw.y & 0xffffu) * sigmoidf_(v0[2]); v0[3] = bf2f(gw.y >> 16) * sigmoidf_(v0[3]);
                    v1[0] = bf2f(gw.z & 0xffffu) * sigmoidf_(v1[0]); v1[1] = bf2f(gw.z >> 16) * sigmoidf_(v1[1]); v1[2] = bf2f(gw.w & 0xffffu) * sigmoidf_(v1[2]); v1[3] = bf2f(gw.w >> 16) * sigmoidf_(v1[3]);
                    *(u32x4*)(Y + r * DM + c) = pack8(v0, v1); } }
    }
};
template <bool F32SRC>
struct EpiRes {
    const float* srcL; const float* srcC; bf16* XR; const float* gate;
    __device__ __forceinline__ void operator()(const f32x4 (&acc)[2][2][4][2], const GUnit& u, int wr, int wc, int fr, int fq) const {
        EPI_ROWS_COLS; const int b = u.pm / PPB, pl = u.pm - b * PPB; const bool isc = pl >= 16;
        const float* src = isc ? srcC + (size_t)b * CTXL * DM : srcL + ((size_t)b * SEQ + pl * 256) * DM; bf16* dst = XR + (size_t)u.pm * 256 * DM; const float* gv = gate + (isc ? 16 : b) * 6144;
        if constexpr (F32SRC) {
#pragma unroll
            for (int bj = 0; bj < 2; ++bj) { const int c = u.pn * 256 + bj * 128 + col0; const f32x4 g0 = *(const f32x4*)(gv + c), g1 = *(const f32x4*)(gv + c + 4);
#pragma unroll
                for (int ai = 0; ai < 2; ++ai)
#pragma unroll
                    for (int m = 0; m < 4; ++m) { const size_t o = (size_t)(ai * 128 + row0 + m * 16) * DM + c; const f32x4 x0 = *(const f32x4*)(src + o), x1 = *(const f32x4*)(src + o + 4);
                        *(u32x4*)(dst + o) = pack8(x0 + g0 * acc[ai][bj][m][0], x1 + g1 * acc[ai][bj][m][1]); } }
        } else {
            u32x4 xw[2][2][4];
#pragma unroll
            for (int bj = 0; bj < 2; ++bj)
#pragma unroll
                for (int ai = 0; ai < 2; ++ai)
#pragma unroll
                    for (int m = 0; m < 4; ++m) xw[bj][ai][m] = *(const u32x4*)(dst + (size_t)(ai * 128 + row0 + m * 16) * DM + u.pn * 256 + bj * 128 + col0);
#pragma unroll
            for (int bj = 0; bj < 2; ++bj) { const int c = u.pn * 256 + bj * 128 + col0; const f32x4 g0 = *(const f32x4*)(gv + c), g1 = *(const f32x4*)(gv + c + 4);
#pragma unroll
                for (int ai = 0; ai < 2; ++ai)
#pragma unroll
                    for (int m = 0; m < 4; ++m) { const size_t o = (size_t)(ai * 128 + row0 + m * 16) * DM + c; const u32x4 w = xw[bj][ai][m];
                        const f32x4 x0 = {bf2f(w.x & 0xffffu), bf2f(w.x >> 16), bf2f(w.y & 0xffffu), bf2f(w.y >> 16)}, x1 = {bf2f(w.z & 0xffffu), bf2f(w.z >> 16), bf2f(w.w & 0xffffu), bf2f(w.w >> 16)};
                        *(u32x4*)(dst + o) = pack8(x0 + g0 * acc[ai][bj][m][0], x1 + g1 * acc[ai][bj][m][1]); } }
        }
    }
};
struct EpiSwi {
    bf16* H;
    __device__ __forceinline__ void operator()(const f32x4 (&acc)[2][2][4][2], const GUnit& u, int wr, int wc, int fr, int fq) const {
        EPI_ROWS_COLS; const int c = u.pn * 128 + col0;
#pragma unroll
        for (int ai = 0; ai < 2; ++ai)
#pragma unroll
            for (int m = 0; m < 4; ++m) { const size_t r = (size_t)u.aux * 256 + ai * 128 + row0 + m * 16; f32x4 v[2];
#pragma unroll
                for (int n = 0; n < 2; ++n) { const f32x4 g = acc[ai][0][m][n], up = acc[ai][1][m][n];
                    const f32x4 e = {__builtin_amdgcn_exp2f(g[0]), __builtin_amdgcn_exp2f(g[1]), __builtin_amdgcn_exp2f(g[2]), __builtin_amdgcn_exp2f(g[3])};
                    const f32x4 d = e + 1.f; const f32x4 rr = {__builtin_amdgcn_rcpf(d[0]), __builtin_amdgcn_rcpf(d[1]), __builtin_amdgcn_rcpf(d[2]), __builtin_amdgcn_rcpf(d[3])};
                    v[n] = (g * up) * rr; }
                *(u32x4*)(H + r * FF + c) = pack8(v[0], v[1]); }
    }
};
struct EpiMoeDown {
    bf16* XR; const float* gate; const int* rsrc; const float* rgate;
    __device__ __forceinline__ void operator()(const f32x4 (&acc)[2][2][4][2], const GUnit& u, int wr, int wc, int fr, int fq) const {
        EPI_ROWS_COLS;
#pragma unroll
        for (int ai = 0; ai < 2; ++ai)
#pragma unroll
            for (int m = 0; m < 4; ++m) { const int pos = u.aux + ai * 128 + row0 + m * 16; const int tok = rsrc[pos];
                if (tok >= 0) { const float rg = rgate[pos]; const int b = tok / RB; const bool isc = (tok - b * RB) >= SEQ; bf16* dst = XR + (size_t)tok * DM; const float* gv = gate + (isc ? 16 : b) * 6144;
#pragma unroll
                    for (int bj = 0; bj < 2; ++bj) { const int c = u.pn * 256 + bj * 128 + col0;
                        const f32x4 g0 = *(const f32x4*)(gv + c) * rg, g1 = *(const f32x4*)(gv + c + 4) * rg; const u32x4 w = *(const u32x4*)(dst + c);
                        const f32x4 x0 = {bf2f(w.x & 0xffffu), bf2f(w.x >> 16), bf2f(w.y & 0xffffu), bf2f(w.y >> 16)}, x1 = {bf2f(w.z & 0xffffu), bf2f(w.z >> 16), bf2f(w.w & 0xffffu), bf2f(w.w >> 16)};
                        *(u32x4*)(dst + c) = pack8(x0 + g0 * acc[ai][bj][m][0], x1 + g1 * acc[ai][bj][m][1]); } } }
    }
};

struct SchedRows {
    const char* A; const char* B; size_t a_tile, b_tile; int nM, nN, pm0, a_local, wgm, lat_only, late = 0, xl = 0;
    __device__ __forceinline__ bool next(int i, GUnit& u) const { int pm, pn; if (!pg8::tile_order(i, GRID, bx_opaque(), nM, nN, wgm, pm, pn, late, xl)) return false;
        u.pm = lat_only ? pm + (pm >> 4) : pm0 + pm; u.pn = pn; u.aux = pm; u.rows = nullptr; u.A = A + (size_t)(a_local ? pm : u.pm) * a_tile; u.B = B + (size_t)pn * b_tile; return true; }
};
struct SchedS5 {
    const char* A; const char* B; size_t b_group; int mix = 0;
    __device__ __forceinline__ bool next(int i, GUnit& u) const { int L;
        if (!mix) L = i * GRID + bx_opaque();
        else { const int bx = bx_opaque(), vcu = (bx & 7) * (GRID / 8) + (bx >> 3), q = vcu & 31, gr = vcu >> 5;
            if ((unsigned)(q - 2) < 8u) return false;
            if ((unsigned)(q - 10) < 8u) { if (i > 0) return false; L = 208 + gr * 8 + (q - 10); }
            else { const int k = gr * 16 + (q < 2 ? q : q - 16); if (i > 1) return false; L = i * 128 + k; if (i == 1 && L >= 208) return false; } }
        if (L >= 17 * 16) return false;
        const int g = L & 15, pm = L >> 4; u.pm = pm; u.pn = 0; u.aux = g; u.rows = nullptr;
        u.A = A + ((size_t)g * NR16 + (size_t)pm * 256) * 512 * 2; u.B = B + (size_t)g * b_group; return true; }
};
struct SchedMoe {
    const char* A; const char* B; const int* rsrc; const LAS int* mbase; int np, nN, p0, slot, down; size_t b_exp, b_tile; int wgm, late = 0, xl = 0;
    __device__ __forceinline__ bool next(int i, GUnit& u) const { int pm, pn; if (!pg8::tile_order(i, GRID, bx_opaque(), np, nN, wgm, pm, pn, late, xl)) return false;
        const int gp = p0 + pm; int e = 0;
#pragma unroll
        for (int k = 1; k < 8; ++k) e += (gp * 256 >= mbase[slot * 8 + k]) ? 1 : 0;
        e = __builtin_amdgcn_readfirstlane(e);
        u.pm = gp; u.pn = pn; u.B = B + (size_t)e * b_exp + (size_t)pn * b_tile;
        if (down) { u.aux = gp * 256; u.rows = nullptr; u.A = A + (size_t)pm * 256 * FF * 2; }
        else { u.aux = pm; u.rows = rsrc + (size_t)gp * 256; u.A = A; }
        return true; }
};
__device__ __forceinline__ void transpose_item(const float* __restrict__ W, int N, bf16* __restrict__ WT, int Kd, int dst_row0, int k0, int n0, LAS float* scr, int lane, float scale = 1.f) {
    { const int kq = lane >> 3, n4 = (lane & 7) * 4; f32x4 v[8];
#pragma unroll
      for (int i = 0; i < 8; ++i) v[i] = *(const f32x4*)(W + (size_t)(k0 + kq + 8 * i) * N + n0 + n4);
#pragma unroll
      for (int i = 0; i < 8; ++i) { LAS float* d = scr + (kq + 8 * i) * 33 + n4; d[0] = v[i][0] * scale; d[1] = v[i][1] * scale; d[2] = v[i][2] * scale; d[3] = v[i][3] * scale; } }
    LDS_WAIT(); asm volatile("" ::: "memory");
    const int c = lane & 7;
#pragma unroll
    for (int j = 0; j < 4; ++j) { const int n = (lane >> 3) + 8 * j; const LAS float* s = scr + (8 * c) * 33 + n;
        u32x4 o; o.x = pk2(s[0 * 33], s[1 * 33]); o.y = pk2(s[2 * 33], s[3 * 33]); o.z = pk2(s[4 * 33], s[5 * 33]); o.w = pk2(s[6 * 33], s[7 * 33]);
        *(u32x4*)(WT + (size_t)(dst_row0 + n) * Kd + k0 + 8 * c) = o; }
    LDS_WAIT(); asm volatile("" ::: "memory");
}
constexpr int PW_PER_LAYER = 1280 + 512 + 32, PW_N_A = NLAYER * PW_PER_LAYER, PW_PER_F = 3 * 1408;
struct TItem { const float* W; bf16* WT; int N, Kd, dst_row0, k0, n0; float scale; };
__device__ __forceinline__ void titem_load(const TItem& t, int lane, f32x4 (&v)[8]) {
    const int kq = lane >> 3, n4 = (lane & 7) * 4;
#pragma unroll
    for (int i = 0; i < 8; ++i) v[i] = *(const f32x4*)(t.W + (size_t)(t.k0 + kq + 8 * i) * t.N + t.n0 + n4);
}
__device__ __forceinline__ void titem_finish(const TItem& t, const f32x4 (&v)[8], LAS float* scr, int lane) {
    { const int kq = lane >> 3, n4 = (lane & 7) * 4;
#pragma unroll
      for (int i = 0; i < 8; ++i) { LAS float* d = scr + (kq + 8 * i) * 33 + n4; d[0] = v[i][0] * t.scale; d[1] = v[i][1] * t.scale; d[2] = v[i][2] * t.scale; d[3] = v[i][3] * t.scale; } }
    LDS_WAIT(); asm volatile("" ::: "memory");
    const int c = lane & 7;
#pragma unroll
    for (int j = 0; j < 4; ++j) { const int n = (lane >> 3) + 8 * j; const LAS float* s = scr + (8 * c) * 33 + n;
        u32x4 o; o.x = pk2(s[0 * 33], s[1 * 33]); o.y = pk2(s[2 * 33], s[3 * 33]); o.z = pk2(s[4 * 33], s[5 * 33]); o.w = pk2(s[6 * 33], s[7 * 33]);
        *(u32x4*)(t.WT + (size_t)(t.dst_row0 + n) * t.Kd + t.k0 + 8 * c) = o; }
    LDS_WAIT(); asm volatile("" ::: "memory");
}
__device__ __forceinline__ TItem make_ffn_item(const KA& p, int r0) {
    unsigned char* ws = p.ws(); TItem t;
    const int f = r0 / PW_PER_F, r = r0 - f * PW_PER_F, which = r / 1408, q = r - which * 1408;
    const bool dense = f < 2; const int mi = dense ? f : f - 2;
    const size_t wo = (size_t)mi * DM * FF;
    if (which < 2) { t.W = (which == 0 ? (dense ? p.in(I_FW1) : p.in(I_MW1)) : (dense ? p.in(I_FW3) : p.in(I_MW3))) + wo; t.N = FF;
        t.WT = (bf16*)(ws + (dense ? WS_W13D : WS_W13M) + (size_t)mi * SZ_W13); t.Kd = DM;
        const int kb = q / 88, nb = q % 88, n0 = 32 * nb; t.dst_row0 = (n0 >> 7) * 256 + which * 128 + (n0 & 127); t.k0 = 64 * kb; t.n0 = n0;
        t.scale = which == 0 ? -1.4426950408889634f : -0.6931471805599453f;
    } else { t.W = (dense ? p.in(I_FW2) : p.in(I_MW2)) + wo; t.N = DM; t.WT = (bf16*)(ws + (dense ? WS_W2D : WS_W2M) + (size_t)mi * SZ_W2); t.Kd = FF;
        const int kb = q / 32, nb = q % 32; t.dst_row0 = 32 * nb; t.k0 = 64 * kb; t.n0 = 32 * nb; t.scale = 1.f; }
    return t;
}
__device__ __forceinline__ void ffn_item(const KA& p, int r0, LAS float* scr, int lane) { const TItem t = make_ffn_item(p, r0); f32x4 v[8]; titem_load(t, lane, v); titem_finish(t, v, scr, lane); }
__device__ __forceinline__ void convert_ffn_items(const KA& p, LAS float* scr, int lane, int first, int count, int j0, int stride) {
    for (int j = j0; j < count; j += 3 * stride) {
        const bool hb = j + stride < count, hc = j + 2 * stride < count;
        f32x4 va[8], vb[8], vc[8];
        const TItem ta = make_ffn_item(p, first + j), tb = make_ffn_item(p, first + (hb ? j + stride : j)), tc = make_ffn_item(p, first + (hc ? j + 2 * stride : j));
        titem_load(ta, lane, va); if (hb) titem_load(tb, lane, vb); if (hc) titem_load(tc, lane, vc);
        titem_finish(ta, va, scr, lane); if (hb) titem_finish(tb, vb, scr, lane); if (hc) titem_finish(tc, vc, scr, lane);
    }
}
constexpr int PW_M1 = 2 * PW_PER_F, PW_M2 = 10 * PW_PER_F;
constexpr int PK_IN = 6912, PK_OUT = 13824, PK_UP = 7680;
enum { POCK_IN = 0, POCK_OUT = 1, POCK_UP = 2 };
__device__ __forceinline__ void pocket_range(int kind, int l, int& first, int& count) {
    first = 0; count = 0;
    constexpr int R1 = 8 * PW_PER_F - (PK_IN + PK_OUT + PK_UP), R2 = 8 * PW_PER_F - (PK_OUT + PK_IN);
    static_assert(R1 > 0 && R1 <= PK_IN && R2 > 0 && R2 <= PK_OUT, "pocket sizes");
    if (kind == POCK_IN)  { if (l == 0) { first = PW_M1; count = PK_IN; } else if (l == 1) { first = PW_M1 + PK_IN + PK_OUT + PK_UP; count = R1; } else if (l == 2) { first = PW_M2 + PK_OUT; count = PK_IN; } }
    else if (kind == POCK_OUT) { if (l == 0) { first = PW_M1 + PK_IN; count = PK_OUT; } else if (l == 1) { first = PW_M2; count = PK_OUT; } else if (l == 2) { first = PW_M2 + PK_OUT + PK_IN; count = R2; } }
    else if (kind == POCK_UP)  { if (l == 0) { first = PW_M1 + PK_IN + PK_OUT; count = PK_UP; } }
}
__device__ __forceinline__ void prologue_weights(const KA& p, LAS unsigned char* lds, int wid, int lane) {
    LAS float* scr = (LAS float*)(lds + wid * 16384);
    const int bx = bx_opaque(); if (bx >= 128 && bx < 192) return;
    const int gw = (bx < 128 ? bx : bx - 64) * NWAVES + wid;
    constexpr int N_ALL = PW_N_A + PW_M1;
    unsigned char* ws = p.ws();
    for (int it = gw; it < N_ALL; it += (GRID - 64) * NWAVES) {
        if (it < PW_N_A) { const int l = it / PW_PER_LAYER; int r = it - l * PW_PER_LAYER;
            if (r < 1280) { transpose_item(p.in(I_WIN) + (size_t)l * DM * INW, INW, (bf16*)(ws + WS_WIN) + (size_t)l * INW * DM, DM, 32 * (r % 80), 64 * (r / 80), 32 * (r % 80), scr, lane); continue; } r -= 1280;
            if (r < 512) { transpose_item(p.in(I_WOUT) + (size_t)l * DM * DM, DM, (bf16*)(ws + WS_WOUT) + (size_t)l * DM * DM, DM, 32 * (r % 32), 64 * (r / 32), 32 * (r % 32), scr, lane); continue; } r -= 512;
            transpose_item(p.in(I_WGLU) + (size_t)l * 65536, 256, (bf16*)(ws + WS_WGLU) + (size_t)l * 65536, 256, 32 * (r % 8), 64 * (r / 8), 32 * (r % 8), scr, lane);
        } else ffn_item(p, it - PW_N_A, scr, lane);
    }
}
__device__ __forceinline__ void deferred_weights(const KA& p, LAS unsigned char* lds, int wid, int lane, int kind, int l, int nbusy) {
    int first, count; pocket_range(kind, l, first, count); if (count == 0) return;
    const int bx = bx_opaque(); int idx = bx - nbusy, n = GRID - nbusy; if (n <= 0) { idx = bx; n = GRID; }
    if (idx < 0) return;
    LAS float* scr = (LAS float*)(lds + wid * 16384);
    convert_ffn_items(p, scr, lane, first, count, idx * NWAVES + wid, n * NWAVES);
}
__device__ __forceinline__ void prologue_mod(const KA& p, LAS unsigned char* lds, int tid, int wid, int lane) {
    LAS float* sc = (LAS float*)lds; LAS float* red = (LAS float*)(lds + 17 * 1024 * 4);
    __syncthreads();
    for (int idx = tid; idx < 17 * 1024; idx += NTHREADS) { const int cond = idx >> 10, k = idx & 1023; const float v = cond < 16 ? p.in(I_C)[cond * 1024 + k] : p.in(I_CCTX)[k]; sc[idx] = v / (1.f + expf(-v)); }
    __syncthreads();
    float* MOD = (float*)(p.ws() + WS_MOD);
    for (int u = bx_opaque(); u < NLAYER * 96; u += GRID) { const int l = u / 96, cb = u % 96;
        float acc[17];
#pragma unroll
        for (int c = 0; c < 17; ++c) acc[c] = 0.f;
        const float* wp = p.in(I_WMOD) + ((size_t)l * 1024 + wid * 128) * 6144 + cb * 64 + lane;
        for (int k = 0; k < 128; k += 16) { float w[16];
#pragma unroll
            for (int q = 0; q < 16; ++q) w[q] = wp[(size_t)(k + q) * 6144];
#pragma unroll
            for (int q = 0; q < 16; q += 4)
#pragma unroll
                for (int c = 0; c < 17; ++c) { const f32x4 s = *(const LAS f32x4*)(sc + c * 1024 + wid * 128 + k + q); acc[c] += s[0] * w[q] + s[1] * w[q + 1] + s[2] * w[q + 2] + s[3] * w[q + 3]; } }
#pragma unroll
        for (int c = 0; c < 17; ++c) red[(wid * 17 + c) * 64 + lane] = acc[c];
        __syncthreads();
        for (int o = tid; o < 17 * 64; o += NTHREADS) { const int c = o >> 6, j = o & 63; float s = p.in(I_BMOD)[l * 6144 + cb * 64 + j];
#pragma unroll
            for (int w = 0; w < 8; ++w) s += red[(w * 17 + c) * 64 + j];
            MOD[((size_t)l * 17 + c) * 6144 + cb * 64 + j] = s; }
        __syncthreads();
    }
}
__device__ __forceinline__ void prologue_small_tables(const KA& p, int tid) {
    float* rope = (float*)(p.ws() + WS_ROPE); float* lamt = (float*)(p.ws() + WS_LAM);
    for (int i = tid; i < 1024; i += NTHREADS) { const int pos = i >> 4, k = i & 15; const float inv = exp2f(-(float)k * (13.287712379549449f / 16.f)); const float a = (float)pos * inv; rope[2 * i] = cosf(a); rope[2 * i + 1] = sinf(a); }
    if (tid < NLAYER) { const int l = tid; float d1 = 0.f, d2 = 0.f;
        for (int k = 0; k < 64; ++k) { d1 += p.in(I_LQ1)[l * 64 + k] * p.in(I_LK1)[l * 64 + k]; d2 += p.in(I_LQ2)[l * 64 + k] * p.in(I_LK2)[l * 64 + k]; }
        const float li = 0.8f - 0.6f * expf(-0.3f * (float)l); lamt[2 * l] = expf(d1) - expf(d2) + li; lamt[2 * l + 1] = li; }
}
__device__ __forceinline__ f32x2 cpow_turns(float lre_dt, double rev, int k) {
    const float mag = expf((float)k * lre_dt); double tk = rev * (double)k; tk -= __builtin_floor(tk + 0.5); const float ang = (float)(tk * 6.283185307179586);
    return (f32x2){mag * cosf(ang), mag * sinf(ang)};
}
__device__ __forceinline__ void prologue_s5(const KA& p, LAS unsigned char* lds, int tid, int l, int g) {
    LAS f32x2* apow = (LAS f32x2*)lds;
    LAS f32x2* bb = (LAS f32x2*)(lds + 17408);
    LAS f32x2* cc = (LAS f32x2*)(lds + 33792);
    LAS float* KT = (LAS float*)(lds + 50176);
    __syncthreads();
    if (tid < 128) { const int dir = tid >> 6, pp = tid & 63, gi = (l * 2 + dir) * 16 + g, idx = gi * 64 + pp;
        const float lre = p.in(I_LAMRE)[idx], lim = p.in(I_LAMIM)[idx], dt = expf(p.in(I_LOGSTEP)[gi]);
        const double rev = (double)lim * (double)dt * 0.15915494309189535; const float lre_dt = lre * dt;
        for (int k = 0; k <= 16; ++k) apow[(dir * 17 + k) * 64 + pp] = cpow_turns(lre_dt, rev, k);
        const f32x2 a1 = cpow_turns(lre_dt, rev, 1), a16 = cpow_turns(lre_dt, rev, 16), a544 = cpow_turns(lre_dt, rev, 544);
        ((f32x4*)(p.ws() + WS_A16))[idx] = (f32x4){a16.x, a16.y, a544.x, a544.y};
        const float nre = a1.x - 1.f, nim = a1.y, den = lre * lre + lim * lim, fre = (nre * lre + nim * lim) / den, fim = (nim * lre - nre * lim) / den;
        for (int h = 0; h < 16; ++h) { const float br = p.in(I_BRE)[(size_t)idx * 16 + h], bi = p.in(I_BIM)[(size_t)idx * 16 + h]; bb[(dir * 64 + pp) * 16 + h] = (f32x2){fre * br - fim * bi, fre * bi + fim * br}; } }
    for (int e = tid; e < 2048; e += NTHREADS) { const int dir = e >> 10, h = (e >> 6) & 15, pp = e & 63; const size_t ci = ((size_t)((l * 2 + dir) * 16 + g) * 16 + h) * 64 + pp;
        cc[e] = (f32x2){p.in(I_CRE)[ci], p.in(I_CIM)[ci]}; }
    __syncthreads();
    bf16* W1 = (bf16*)(p.ws() + WS_S5W1) + (size_t)(l * 16 + g) * 65536; bf16* W2 = (bf16*)(p.ws() + WS_S5W2) + (size_t)(l * 16 + g) * 131072;
    for (int it = 0; it < 128; ++it) { const int e = it * NTHREADS + tid, n = e >> 8, k = e & 255;
        { const int dir = n >> 7, part = (n >> 6) & 1, pp = n & 63, j = k >> 4, hh = k & 15, pw = dir == 0 ? 15 - j : j;
          const f32x2 a = apow[(dir * 17 + pw) * 64 + pp], b = bb[(dir * 64 + pp) * 16 + hh];
          W1[e] = (bf16)f2bf(part ? (a.x * b.y + a.y * b.x) : (a.x * b.x - a.y * b.y)); }
        { const int i = n >> 4, h = n & 15, dir = k >> 7, part = (k >> 6) & 1, pp = k & 63, pw = dir == 0 ? i + 1 : 16 - i;
          const f32x2 a = apow[(dir * 17 + pw) * 64 + pp], c = cc[(dir * 16 + h) * 64 + pp];
          W2[(size_t)n * 512 + k] = (bf16)f2bf(part ? -(c.x * a.y + c.y * a.x) : (c.x * a.x - c.y * a.y)); } }
    { const int dir = tid >> 8, h = (tid >> 4) & 15, hh = tid & 15;
      for (int lag = 0; lag < 16; ++lag) { float s = 0.f;
          for (int pp = 0; pp < 64; ++pp) { const f32x2 c = cc[(dir * 16 + h) * 64 + pp], a = apow[(dir * 17 + lag) * 64 + pp], b = bb[(dir * 64 + pp) * 16 + hh];
              const float cax = c.x * a.x - c.y * a.y, cay = c.x * a.y + c.y * a.x; s += cax * b.x - cay * b.y; }
          KT[(dir * 16 + lag) * 256 + h * 16 + hh] = s; } }
    __syncthreads();
    for (int it = 0; it < 128; ++it) { const int e = it * NTHREADS + tid, n = e >> 8, kk = e & 255, i = n >> 4, h = n & 15, j = kk >> 4, hh = kk & 15;
        float v = 0.f; if (j <= i) v += KT[(i - j) * 256 + h * 16 + hh]; if (j >= i) v += KT[(16 + j - i) * 256 + h * 16 + hh];
        if (i == j && h == hh) v += p.in(I_SSMD)[l * 256 + g * 16 + h];
        W2[(size_t)n * 512 + 256 + kk] = (bf16)f2bf(v); }
    __syncthreads();
}

template <bool ROUTER, bool F32SRC>
__device__ __forceinline__ void norm_phase(const KA& p, LAS unsigned char* lds, int tid, int wid, int lane, const float* srcL, const float* srcC, const float* gvec, const float* shiftv, const float* scalev,
                                           const float* router, bool skip_ctx) {
    bf16* HX = (bf16*)((unsigned char*)p.out() + OUT_HX); const bf16* XR = (const bf16*)(p.ws() + WS_XR);
    const int gw = bx_opaque() * NWAVES + wid;
    LAS int* wcnt = (LAS int*)lds + wid * 16;
    f32x4 wr0[ROUTER ? 16 : 1], wr1[ROUTER ? 16 : 1];
    if constexpr (ROUTER) {
        __syncthreads(); if (lane < 16) wcnt[lane] = 0;
        int* rsrc = (int*)(p.ws() + WS_RSRC); for (int i = bx_opaque() * NTHREADS + tid; i < MOE_ROWS; i += GRID * NTHREADS) rsrc[i] = -1;
#pragma unroll
        for (int j = 0; j < 4; ++j)
#pragma unroll
            for (int k = 0; k < 4; ++k) { const int c = 4 * lane + 256 * j + k; wr0[j * 4 + k] = *(const f32x4*)(router + (size_t)c * 8); wr1[j * 4 + k] = *(const f32x4*)(router + (size_t)c * 8 + 4); }
    }
    f32x4 Av[4], Bv[4]; int cur_cond = -1;
    constexpr int NB_ROWS = F32SRC ? 4 : (ROUTER ? 3 : 9);
    for (int rr0 = 0; rr0 < RPW; rr0 += NB_ROWS) {
        f32x4 rawf[F32SRC ? NB_ROWS : 1][4]; u32x2 rawh[F32SRC ? 1 : NB_ROWS][4];
#pragma unroll
        for (int d = 0; d < NB_ROWS; ++d) if (rr0 + d < RPW) { const int r = gw * RPW + rr0 + d;
            if constexpr (F32SRC) { bool isc; const size_t ro = res_off(r, isc); const float* xr = (isc ? srcC : srcL) + ro;
#pragma unroll
                for (int j = 0; j < 4; ++j) rawf[d][j] = *(const f32x4*)(xr + 4 * lane + 256 * j); }
            else {
#pragma unroll
                for (int j = 0; j < 4; ++j) rawh[d][j] = *(const u32x2*)(XR + (size_t)r * DM + 4 * lane + 256 * j); } }
#pragma unroll
        for (int d = 0; d < NB_ROWS; ++d) if (rr0 + d < RPW) { const int r = gw * RPW + rr0 + d; const int bq = r / RB; const bool isc = (r - bq * RB) >= SEQ; const int cond = isc ? 16 : bq;
        if (cond != cur_cond) { cur_cond = cond;
#pragma unroll
            for (int j = 0; j < 4; ++j) { const int c = 4 * lane + 256 * j; const f32x4 g = *(const f32x4*)(gvec + c), s = *(const f32x4*)(scalev + (size_t)cond * 6144 + c); Av[j] = g * (s + 1.f); Bv[j] = *(const f32x4*)(shiftv + (size_t)cond * 6144 + c); } }
        f32x4 v[4]; float ss = 0.f;
#pragma unroll
        for (int j = 0; j < 4; ++j) {
            if constexpr (F32SRC) v[j] = rawf[d][j];
            else { const u32x2 w = rawh[d][j]; v[j] = (f32x4){bf2f(w.x & 0xffffu), bf2f(w.x >> 16), bf2f(w.y & 0xffffu), bf2f(w.y >> 16)}; }
            ss += (v[j][0] * v[j][0] + v[j][1] * v[j][1]) + (v[j][2] * v[j][2] + v[j][3] * v[j][3]); }
        const float rinv = 1.f / sqrtf(wave_sum(ss) * (1.f / DM) + 1e-6f);
#pragma unroll
        for (int j = 0; j < 4; ++j) { v[j] = v[j] * rinv * Av[j] + Bv[j]; *(u32x2*)(HX + (size_t)r * DM + 4 * lane + 256 * j) = (u32x2){pk2(v[j][0], v[j][1]), pk2(v[j][2], v[j][3])}; }
        if constexpr (ROUTER) {
            int* toke = (int*)(p.ws() + WS_TOKE); f32x2* tokg = (f32x2*)(p.ws() + WS_TOKG);
            if (isc && skip_ctx) { if (lane == 0) toke[r] = 0xFFFF; }
            else { f32x4 l0 = {0.f, 0.f, 0.f, 0.f}, l1 = {0.f, 0.f, 0.f, 0.f};
#pragma unroll
                for (int j = 0; j < 4; ++j)
#pragma unroll
                    for (int k = 0; k < 4; ++k) { l0 += wr0[j * 4 + k] * v[j][k]; l1 += wr1[j * 4 + k] * v[j][k]; }
                float lg[8];
#pragma unroll
                for (int e = 0; e < 4; ++e) { lg[e] = wave_sum(l0[e]); lg[4 + e] = wave_sum(l1[e]); }
                int e0 = 0; float v0 = lg[0];
#pragma unroll
                for (int e = 1; e < 8; ++e) if (lg[e] > v0) { v0 = lg[e]; e0 = e; }
                int e1 = -1; float v1 = -3.0e38f;
#pragma unroll
                for (int e = 0; e < 8; ++e) if (e != e0 && lg[e] > v1) { v1 = lg[e]; e1 = e; }
                const float g0 = 1.f / (1.f + expf(v1 - v0));
                if (lane == 0) { toke[r] = e0 | (e1 << 8); tokg[r] = (f32x2){g0, 1.f - g0}; wcnt[e0] += 1; wcnt[8 + e1] += 1; } }
        }
        }
    }
    if constexpr (ROUTER) { LDS_WAIT(); if (lane < 16) ((int*)(p.ws() + WS_WCNT))[gw * 16 + lane] = wcnt[lane]; }
}
__device__ __forceinline__ void route2_phase(const KA& p, LAS unsigned char* lds, LAS int* mbase_lds, int tid, int wid, int lane) {
    LAS int* segsum = (LAS int*)lds;
    LAS int* wpre = segsum + 512;
    LAS int* tot = wpre + 128;
    LAS int* wstart = tot + 16;
    const int* wcnt = (const int*)(p.ws() + WS_WCNT);
    __syncthreads();
    { const int seg = tid >> 4, bin = tid & 15, myseg = bx_opaque() >> 3, wg0 = (bx_opaque() & 7) * 8; int s = 0;
      for (int k = 0; k < 64; ++k) { const int c = wcnt[(seg * 64 + k) * 16 + bin]; if (seg == myseg && k >= wg0 && k < wg0 + 8) wpre[(k - wg0) * 16 + bin] = s; s += c; }
      segsum[seg * 16 + bin] = s; }
    __syncthreads();
    if (tid < 16) { int s = 0; for (int k = 0; k < 32; ++k) s += segsum[k * 16 + tid]; tot[tid] = s; }
    __syncthreads();
    if (tid == 0) { int b = 0; for (int k = 0; k < 16; ++k) { mbase_lds[k] = b; b += (tot[k] + 255) & ~255; } mbase_lds[16] = b; }
    __syncthreads();
    if (bx_opaque() == 0 && tid < 17) ((int*)(p.ws() + WS_MBASE))[tid] = mbase_lds[tid];
    if (tid < 128) { const int w = tid >> 4, bin = tid & 15, myseg = bx_opaque() >> 3; int s = mbase_lds[bin] + wpre[w * 16 + bin]; for (int k = 0; k < myseg; ++k) s += segsum[k * 16 + bin]; wstart[w * 16 + bin] = s; }
    __syncthreads();
    { const int gw = bx_opaque() * NWAVES + wid; const int* toke = (const int*)(p.ws() + WS_TOKE); const f32x2* tokg = (const f32x2*)(p.ws() + WS_TOKG);
      int* rsrc = (int*)(p.ws() + WS_RSRC); float* rgate = (float*)(p.ws() + WS_RGATE);
      const bool act = lane < RPW; const int r = gw * RPW + (act ? lane : 0); const int te = act ? toke[r] : 0xFFFF; const f32x2 g = act ? tokg[r] : (f32x2){0.f, 0.f};
      const bool valid = te != 0xFFFF; const int e0 = te & 255, e1 = (te >> 8) & 255; int p0 = 0, p1 = 0;
      const unsigned long long ltm = (1ull << lane) - 1ull;
#pragma unroll
      for (int bin = 0; bin < 8; ++bin) { const unsigned long long m0 = __ballot(valid && e0 == bin), m1 = __ballot(valid && e1 == bin);
          if (e0 == bin) p0 = wstart[wid * 16 + bin] + __popcll(m0 & ltm);
          if (e1 == bin) p1 = wstart[wid * 16 + 8 + bin] + __popcll(m1 & ltm); }
      if (valid) { rsrc[p0] = r; rgate[p0] = g.x; rsrc[p1] = r; rgate[p1] = g.y; } }
    __syncthreads();
}
__device__ __forceinline__ void carry_phase(const KA& p, LAS unsigned char* lds, int tid, int wid, int lane, int l) {
    LAS f32x2* segend = (LAS f32x2*)lds;
    const float* Z = (const float*)(p.ws() + WS_ZLOC); bf16* A2 = (bf16*)((unsigned char*)p.out() + OUT_A2);
    for (int u = bx_opaque(); u < NB * 16 * 2; u += GRID) { const int dir = u & 1, g = (u >> 1) & 15, b = u >> 5;
        const f32x4 at = ((const f32x4*)(p.ws() + WS_A16))[((l * 2 + dir) * 16 + g) * 64 + lane];
        const float ar = at[0], ai = at[1];
        const size_t zrow0 = (size_t)g * NR16 + (size_t)b * 272;
        float lr[34], li[34];
#pragma unroll
        for (int k = 0; k < 34; ++k) { const int q = wid * 34 + k, cp = dir == 0 ? (q < 16 ? 256 + q : q - 16) : 271 - q; const float* zp = Z + (zrow0 + cp) * 256 + dir * 128 + lane; lr[k] = zp[0]; li[k] = zp[64]; }
        float zr = 0.f, zi = 0.f;
#pragma unroll
        for (int k = 0; k < 34; ++k) { const float nr = ar * zr - ai * zi + lr[k], ni = ar * zi + ai * zr + li[k]; zr = nr; zi = ni; }
        __syncthreads();
        segend[wid * 64 + lane] = (f32x2){zr, zi};
        __syncthreads();
        float cr = 0.f, ci = 0.f;
        for (int w = 0; w < wid; ++w) { const f32x2 s = segend[w * 64 + lane]; const float nr = at[2] * cr - at[3] * ci + s.x, ni = at[2] * ci + at[3] * cr + s.y; cr = nr; ci = ni; }
        zr = cr; zi = ci;
#pragma unroll
        for (int k = 0; k < 34; ++k) { const int q = wid * 34 + k, cp = dir == 0 ? (q < 16 ? 256 + q : q - 16) : 271 - q;
            bf16* ap = A2 + (zrow0 + cp) * 512 + dir * 128 + lane; ap[0] = (bf16)f2bf(zr); ap[64] = (bf16)f2bf(zi);
            const float nr = ar * zr - ai * zi + lr[k], ni = ar * zi + ai * zr + li[k]; zr = nr; zi = ni; }
    }
    __syncthreads();
}
__device__ __forceinline__ void final_phase(const KA& p, int wid, int lane) {
    const int gw = bx_opaque() * NWAVES + wid; f32x4 g[4]; const bf16* XR = (const bf16*)(p.ws() + WS_XR);
#pragma unroll
    for (int j = 0; j < 4; ++j) g[j] = *(const f32x4*)(p.in(I_GFINAL) + 4 * lane + 256 * j);
    for (int rl0 = gw * 32; rl0 < gw * 32 + 32; rl0 += 8) { u32x2 raw[8][4];
#pragma unroll
        for (int d = 0; d < 8; ++d) { const int rl = rl0 + d, b = rl >> 12, n = rl & 4095; const bf16* xr = XR + ((size_t)b * RB + n) * DM;
#pragma unroll
            for (int j = 0; j < 4; ++j) raw[d][j] = *(const u32x2*)(xr + 4 * lane + 256 * j); }
#pragma unroll
        for (int d = 0; d < 8; ++d) { float* orow = p.out() + (size_t)(rl0 + d) * DM; f32x4 v[4]; float ss = 0.f;
#pragma unroll
            for (int j = 0; j < 4; ++j) { const u32x2 w = raw[d][j]; v[j] = (f32x4){bf2f(w.x & 0xffffu), bf2f(w.x >> 16), bf2f(w.y & 0xffffu), bf2f(w.y >> 16)};
                ss += (v[j][0] * v[j][0] + v[j][1] * v[j][1]) + (v[j][2] * v[j][2] + v[j][3] * v[j][3]); }
            const float rinv = 1.f / sqrtf(wave_sum(ss) * (1.f / DM) + 1e-6f);
#pragma unroll
            for (int j = 0; j < 4; ++j) *(f32x4*)(orow + 4 * lane + 256 * j) = v[j] * rinv * g[j]; } }
}

constexpr int STAGE_LO = att::ATT_LDS, STAGE_HI = WTAB_OFF + 256;
static_assert(STAGE_LO % 16 == 0 && STAGE_HI % 16 == 0 && STAGE_LO + 5 * 4096 <= RING_BYTES && STAGE_HI + 3 * 4096 <= LDS_BYTES, "output stage placement");
__device__ __forceinline__ LAS bf16* stage_ptr(LAS unsigned char* lds, int wid) { return (LAS bf16*)(lds + (wid < 5 ? STAGE_LO + wid * 4096 : STAGE_HI + (wid - 5) * 4096)); }
__device__ __forceinline__ void diff_unit(const bf16* P, bf16* Y, int rows0, int h, int kbase, int NT, const float* lamp, const float* gsub, LAS unsigned char* lds, unsigned* gst, bool pre_in, bool has_next, size_t ndelta) {
    const int tid = tid_opaque(), lane = tid & 63, wid = __builtin_amdgcn_readfirstlane(tid >> 6), r32 = lane & 31, hi = lane >> 5;
    LAS bf16* st = stage_ptr(lds, wid) + r32;
    unsigned* gs = gst + ((size_t)(bx_opaque() * NWAVES + wid) * 32) * 64 + lane;
    {
        f32x16 o[4];
        att::attn_body<128, 0>(P + (size_t)rows0 * PW + PC_DQ + h * 128, P + PC_DK + h * 128, P + PC_DV + h * 128, kbase, NT, 0, NT, lds, o, 0, 0, nullptr, P + PC_DK + h * 128 + 64, P + PC_DV + h * 128, pre_in);
#pragma unroll
        for (int d = 0; d < 4; ++d)
#pragma unroll
            for (int j = 0; j < 8; ++j) gs[(d * 8 + j) * 64] = cvt_pk_bf16(o[d][2 * j], o[d][2 * j + 1]);
    }
    __builtin_amdgcn_sched_barrier(0);
    {
        f32x16 o[4];
        att::attn_body<128, 0>(P + (size_t)rows0 * PW + PC_DQ + h * 128 + 64, P + PC_DK + h * 128 + 64, P + PC_DV + h * 128, kbase, NT, 0, NT, lds, o, 0, 0, nullptr,
                               has_next ? P + PC_DK + h * 128 + ndelta : nullptr, has_next ? P + PC_DV + h * 128 + ndelta : nullptr, true);
        const float lam = lamp[0], lam_init = lamp[1];
        float ss[16];
#pragma unroll
        for (int r = 0; r < 16; ++r) ss[r] = 0.f;
        unsigned sw_[32];
#pragma unroll
        for (int k = 0; k < 32; ++k) sw_[k] = __hip_atomic_load(gs + k * 64, __ATOMIC_RELAXED, __HIP_MEMORY_SCOPE_AGENT);
        __builtin_amdgcn_sched_barrier(0);
#pragma unroll
        for (int d = 0; d < 4; ++d)
#pragma unroll
            for (int j = 0; j < 8; ++j) { const unsigned w = sw_[d * 8 + j];
                const float v0 = bf2f(w & 0xffffu) - lam * o[d][2 * j], v1 = bf2f(w >> 16) - lam * o[d][2 * j + 1]; o[d][2 * j] = v0; o[d][2 * j + 1] = v1; ss[2 * j] += v0 * v0; ss[2 * j + 1] += v1 * v1; }
#pragma unroll
        for (int r = 0; r < 16; ++r) {
            ss[r] = half_sum(ss[r]);
            ss[r] = (1.f / sqrtf(ss[r] * (1.f / 128.f) + 1e-5f)) * (1.f - lam_init); }
        float gs[4];
#pragma unroll
        for (int d = 0; d < 4; ++d) gs[d] = gsub[d * 32 + r32];
        { const LAS bf16* sw = stage_ptr(lds, wid); bf16* yo = Y + (size_t)(rows0 + wid * 32) * DM + 256 + h * 128;
#pragma unroll
          for (int q = 0; q < 2; ++q) {
#pragma unroll
            for (int r = 8 * q; r < 8 * q + 8; ++r)
#pragma unroll
                for (int d = 0; d < 4; ++d) st[(att::crow(r, hi) - 16 * q) * 128 + d * 32] = (bf16)f2bf(o[d][r] * ss[r] * gs[d]);
            asm volatile("s_waitcnt lgkmcnt(0)" ::: "memory");
#pragma unroll
            for (int i = 0; i < 4; ++i) { const int row = i * 4 + (lane >> 4), ch = lane & 15; *(u32x4*)(yo + (size_t)(16 * q + row) * DM + ch * 8) = *(const LAS u32x4*)(sw + row * 128 + ch * 8); }
            asm volatile("s_waitcnt lgkmcnt(0)" ::: "memory"); } }
    }
}
__device__ __forceinline__ void na_unit(const bf16* P, bf16* Y, const float* rpb_h, int b, int h, int qb, LAS unsigned char* lds, bool fill, bool pre_in, bool has_next, size_t ndelta) {
    const int tid = tid_opaque(), lane = tid & 63, wid = __builtin_amdgcn_readfirstlane(tid >> 6), r32 = lane & 31, hi = lane >> 5; const int rows0 = b * RB + qb * 256, r0 = qb * 4;
    const int kmin = min(min(max(r0 - 4, 0), 56), 52);
    __syncthreads();
    if (fill) { LAS float* tbl = (LAS float*)(lds + att::OFF_RPB);
      for (int i = tid; i < 15 * att::RPB_PITCH; i += NTHREADS) { const int ri = i >> 7, cj = (i & 127) - 48; tbl[i] = ((unsigned)cj < 31u) ? rpb_h[ri * 31 + cj] * 1.4426950408889634f : 0.f; } }
    f32x16 o[2];
    att::attn_body<64, 1>(P + (size_t)rows0 * PW + PC_NQ + h * 64, P + PC_NK + h * 64, P + PC_NV + h * 64, b * RB + SEQ, 4, b * RB + kmin * 64, 16, lds, o, r0 + (wid >> 1), kmin, nullptr,
                          has_next ? P + PC_NK + h * 64 + ndelta : nullptr, has_next ? P + PC_NV + h * 64 + ndelta : nullptr, pre_in);
    { LAS bf16* sw = stage_ptr(lds, wid);
#pragma unroll
      for (int r = 0; r < 16; ++r)
#pragma unroll
          for (int d = 0; d < 2; ++d) sw[att::crow(r, hi) * 64 + d * 32 + r32] = (bf16)f2bf(o[d][r]);
      asm volatile("s_waitcnt lgkmcnt(0)" ::: "memory");
      bf16* yo = Y + (size_t)(rows0 + wid * 32) * DM + 768 + h * 64;
#pragma unroll
      for (int i = 0; i < 4; ++i) { const int row = i * 8 + (lane >> 3), ch = lane & 7; *(u32x4*)(yo + (size_t)row * DM + ch * 8) = *(const LAS u32x4*)(sw + row * 64 + ch * 8); }
      asm volatile("s_waitcnt lgkmcnt(0)" ::: "memory"); }
}
__device__ __forceinline__ void na_ctx_unit(const bf16* P, bf16* Y, int b, int h, LAS unsigned char* lds) {
    const int tid = tid_opaque(), lane = tid & 63, wid = __builtin_amdgcn_readfirstlane(tid >> 6), r32 = lane & 31, hi = lane >> 5; const int rows0 = b * RB + SEQ;
    f32x16 o[2];
    att::attn_body<64, 0>(P + (size_t)rows0 * PW + PC_NQ + h * 64, P + PC_NK + h * 64, P + PC_NV + h * 64, rows0, 4, 0, 4, lds, o, 0, 0);
    { LAS bf16* sw = stage_ptr(lds, wid);
#pragma unroll
      for (int r = 0; r < 16; ++r)
#pragma unroll
          for (int d = 0; d < 2; ++d) sw[att::crow(r, hi) * 64 + d * 32 + r32] = (bf16)f2bf(o[d][r]);
      asm volatile("s_waitcnt lgkmcnt(0)" ::: "memory");
      bf16* yo = Y + (size_t)(rows0 + wid * 32) * DM + 768 + h * 64;
#pragma unroll
      for (int i = 0; i < 4; ++i) { const int row = i * 8 + (lane >> 3), ch = lane & 7; *(u32x4*)(yo + (size_t)row * DM + ch * 8) = *(const LAS u32x4*)(sw + row * 64 + ch * 8); }
      asm volatile("s_waitcnt lgkmcnt(0)" ::: "memory"); }
}
#ifndef WGM_IN
#define WGM_IN 4
#endif
#ifndef WGM_OUT
#define WGM_OUT 4
#endif
#ifndef WGM_UP
#define WGM_UP 4
#endif
#ifndef WGM_DOWN
#define WGM_DOWN 4
#endif
__global__ void __launch_bounds__(NTHREADS, 2) dit_fwd(Params p_unused) {
    (void)p_unused;
    LAS unsigned char* lds = (LAS unsigned char*)lds_raw;
    volatile LAS unsigned* MISC = (volatile LAS unsigned*)(lds + MISC_OFF);
    LAS int* mbase = (LAS int*)(lds + MISC_OFF + 128);
#define PH_ARGS KA p; p.k = (const CAS unsigned char*)__builtin_amdgcn_kernarg_segment_ptr(); asm volatile("" : "+s"(p.k)); unsigned char* const ws = p.ws(); (void)ws
#define PH_IDS PH_ARGS; const int tid = tid_opaque(), lane = tid & 63, wid = __builtin_amdgcn_readfirstlane(tid >> 6); (void)lane; (void)wid
#define BX (bx_opaque())
#define VCU ((BX & 7) * (GRID / 8) + (BX >> 3))
    for (int u = (int)threadIdx.x; u < (LDS_BYTES - LDSCTL_OFF) / 4; u += NTHREADS) ((LAS unsigned*)(lds + LDSCTL_OFF))[u] = 0u;
    __syncthreads();
    if ((threadIdx.x & 63) == 0) ((volatile LAS int*)(lds + WTAB_OFF))[hw_wave_slot()] = (int)(threadIdx.x >> 6);
    __syncthreads();
    { PH_ARGS; (void)xcd_barrier_post((unsigned*)(ws + WS_CTL) + CW_BAR, MISC + 8); }
#define GRID_BAR_T(FIRST) do { PH_ARGS; XcdBarrier b_; b_.bar = (unsigned*)(ws + WS_CTL) + CW_BAR; b_.x = xb_xcc_id(); b_.st = (volatile LAS unsigned*)(lds + MISC_OFF) + 8; xcd_barrier<FIRST>(b_); } while (0)
#define GRID_BAR() GRID_BAR_T(false)

#define MOD ((float*)(ws + WS_MOD))
#define OUTB ((unsigned char*)p.out())
#define XR ((bf16*)(ws + WS_XR))
#define HX ((bf16*)(OUTB + OUT_HX))
#define P ((bf16*)(ws + WS_P))
#define H ((bf16*)(ws + WS_H))
#define A2 ((bf16*)(OUTB + OUT_A2))
#define ZL ((float*)(ws + WS_ZLOC))
#define GB ((bf16*)(OUTB + OUT_GBUF))
#define MODL (MOD + (size_t)l * 17 * 6144)

    { PH_IDS; if (BX & 1) { prologue_mod(p, lds, tid, wid, lane); __syncthreads(); prologue_weights(p, lds, wid, lane); }
      else { prologue_weights(p, lds, wid, lane); prologue_mod(p, lds, tid, wid, lane); }
      if (BX >= 128 && BX < 192) prologue_s5(p, lds, tid, (BX - 128) >> 4, (BX - 128) & 15);
      if (BX == 255) prologue_small_tables(p, tid); }
    GRID_BAR_T(true);

    for (int l = 0; l < NLAYER; ++l) {
        const int last = (l == NLAYER - 1) ? 1 : 0;
        { PH_IDS; if (l == 0) norm_phase<false, true>(p, lds, tid, wid, lane, p.in(I_X), p.in(I_CTX), p.in(I_GMIX), MODL, MODL + 1024, nullptr, false);
          else norm_phase<false, false>(p, lds, tid, wid, lane, nullptr, nullptr, p.in(I_GMIX) + l * DM, MODL, MODL + 1024, nullptr, false); }
        GRID_BAR();
        { PH_ARGS; SchedRows S{(const char*)HX, (const char*)(ws + WS_WIN) + (size_t)l * INW * DM * 2, (size_t)256 * DM * 2, (size_t)256 * DM * 2, NPANEL, INW / 256, 0, 0, WGM_IN, 0};
          EpiInProj E{P, A2, (const float*)(ws + WS_ROPE)};
          pg8::gemm_phase<EpiInProj, SchedRows, false>(lds, DM, DM, DM, S, E); }
        { PH_IDS; deferred_weights(p, lds, wid, lane, POCK_IN, l, (NPANEL * (INW / 256)) % GRID); }
        GRID_BAR();
        { PH_ARGS; SchedS5 S{(const char*)A2 + 512, (const char*)(ws + WS_S5W1) + (size_t)l * 16 * 65536 * 2, (size_t)65536 * 2}; EpiZ E{ZL};
          pg8::gemm_phase<EpiZ, SchedS5, false>(lds, 256, 512, 256, S, E); }
        GRID_BAR();
        { PH_IDS; carry_phase(p, lds, tid, wid, lane, l); }
        GRID_BAR();
        { PH_ARGS; SchedS5 S{(const char*)A2, (const char*)(ws + WS_S5W2) + (size_t)l * 16 * 131072 * 2, (size_t)131072 * 2, last ? 0 : 1}; EpiY E{GB};
          pg8::gemm_phase<EpiY, SchedS5, false>(lds, 512, 512, 512, S, E); }
        { PH_ARGS; const float* lamp = (const float*)(ws + WS_LAM) + 2 * l; const float* gsub = p.in(I_SUBLN) + l * 128; const int vcu = VCU;
          for (int it = 0; it < 4; ++it) { const int bh = (vcu >> 4) + 16 * it, b = bh >> 2, h = bh & 3, qb = vcu & 15;
              diff_unit(P, HX, b * RB + qb * 256, h, b * RB, RB / 64, lamp, gsub, lds, (unsigned*)(ws + WS_ZLOC), it > 0, it < 3, (size_t)4 * RB * PW); }
          if ((unsigned)((vcu & 31) - 2) < 8u && !last) { const int ci_ = (vcu >> 5) * 8 + (vcu & 31) - 2, b = ci_ >> 2, h = ci_ & 3; diff_unit(P, HX, b * RB + SEQ, h, b * RB + SEQ, CTXL / 64, lamp, gsub, lds, (unsigned*)(ws + WS_ZLOC), false, false, 0); }
          for (int it = 0; it < 4; ++it) { const int bh = (vcu >> 4) + 16 * it, b = bh >> 2, h = bh & 3, qb = vcu & 15;
              na_unit(P, HX, p.in(I_RPB) + (size_t)(l * 4 + h) * 465, b, h, qb, lds, it == 0, it > 0, it < 3, (size_t)4 * RB * PW); }
          if ((unsigned)((vcu & 31) - 10) < 8u && !last) { const int ci_ = (vcu >> 5) * 8 + (vcu & 31) - 10, b = ci_ >> 2, h = ci_ & 3; na_ctx_unit(P, HX, b, h, lds); }
          __syncthreads(); }
        GRID_BAR();
        { PH_ARGS; SchedRows S{(const char*)GB, (const char*)(ws + WS_WGLU) + (size_t)l * 65536 * 2, (size_t)256 * 256 * 2, (size_t)256 * 256 * 2, last ? NB * 16 : NPANEL, 1, 0, 0, 4, last};
          EpiGlu E{GB, HX, p.in(I_BGLU) + l * 256};
          pg8::gemm_phase<EpiGlu, SchedRows, false>(lds, 256, 256, 256, S, E); }
        GRID_BAR();
        { PH_ARGS; SchedRows S{(const char*)HX, (const char*)(ws + WS_WOUT) + (size_t)l * DM * DM * 2, (size_t)256 * DM * 2, (size_t)256 * DM * 2, last ? NB * 16 : NPANEL, 4, 0, 0, WGM_OUT, last};
          if (l == 0) { EpiRes<true> E{p.in(I_X), p.in(I_CTX), XR, MODL + 2 * 1024}; pg8::gemm_phase<EpiRes<true>, SchedRows, false>(lds, DM, DM, DM, S, E); }
          else { EpiRes<false> E{nullptr, nullptr, XR, MODL + 2 * 1024}; pg8::gemm_phase<EpiRes<false>, SchedRows, false>(lds, DM, DM, DM, S, E); } }
        if (l < 3) { PH_IDS; deferred_weights(p, lds, wid, lane, POCK_OUT, l, (NPANEL * 4) % GRID); }
        GRID_BAR();
        { PH_IDS; if (l & 1) norm_phase<true, false>(p, lds, tid, wid, lane, nullptr, nullptr, p.in(I_GFFN) + l * DM, MODL + 3 * 1024, MODL + 4 * 1024, p.in(I_ROUTER) + (size_t)(l >> 1) * DM * 8, l == NLAYER - 1);
          else norm_phase<false, false>(p, lds, tid, wid, lane, nullptr, nullptr, p.in(I_GFFN) + l * DM, MODL + 3 * 1024, MODL + 4 * 1024, nullptr, false); }
        GRID_BAR();
#define FFN_XL(nd, nup, xl_out) do { int best_ = 0x7fffffff; xl_out = 0x7fffff; if ((nd) > 0) { for (int x_ = 18; x_ <= 22; ++x_) { const int rest_ = (nup) - (nd) * x_; if (rest_ < 0) break; \
            const int oth_ = (rest_ + (GRID - (nd)) - 1) / (GRID - (nd)); const int cost_ = (5 + 2 * x_) > 2 * oth_ ? (5 + 2 * x_) : 2 * oth_; if (cost_ < best_) { best_ = cost_; xl_out = x_; } } } } while (0)
        if (!(l & 1)) {
            const int fi = l >> 1;
            for (int ci = 0; ci < 2; ++ci) { const int c = 1 - ci, pm0 = c * HCHUNK_PANELS, np = (NPANEL - pm0) < HCHUNK_PANELS ? (NPANEL - pm0) : HCHUNK_PANELS;
                const int nd = c == 0 ? (NPANEL - HCHUNK_PANELS) * 4 : 0; int xl; FFN_XL(nd, np * 22, xl);
                { PH_ARGS; bf16* const Hc = c == 1 ? A2 : H; SchedRows S{(const char*)HX, (const char*)(ws + WS_W13D) + (size_t)fi * SZ_W13, (size_t)256 * DM * 2, (size_t)256 * DM * 2, np, 22, pm0, 0, WGM_UP, 0, nd, xl}; EpiSwi E{Hc};
                  pg8::gemm_phase<EpiSwi, SchedRows, false>(lds, DM, DM, DM, S, E); }
                if (c == 1) { PH_IDS; deferred_weights(p, lds, wid, lane, POCK_UP, l, (np * 22) % GRID); }
                GRID_BAR();
                { PH_ARGS; bf16* const Hc = c == 1 ? A2 : H; SchedRows S{(const char*)Hc, (const char*)(ws + WS_W2D) + (size_t)fi * SZ_W2, (size_t)256 * FF * 2, (size_t)256 * FF * 2, np, 4, pm0, 1, WGM_DOWN, 0};
                  EpiRes<false> E{nullptr, nullptr, XR, MODL + 5 * 1024};
                  pg8::gemm_phase<EpiRes<false>, SchedRows, false>(lds, FF, FF, FF, S, E); }
                if (c == 0) GRID_BAR(); }
        } else {
            const int mi = l >> 1;
            { PH_IDS; route2_phase(p, lds, mbase, tid, wid, lane); }
            GRID_BAR();
            for (int s = 0; s < 2; ++s) { const int P0 = __builtin_amdgcn_readfirstlane(mbase[8 * s] >> 8), P1 = __builtin_amdgcn_readfirstlane(mbase[8 * s + 8] >> 8);
                const int nrem = (P1 - P0) > HCHUNK_PANELS ? (P1 - P0) - HCHUNK_PANELS : 0;
                for (int ci = 0; ci < 2; ++ci) { const int c = 1 - ci; if (c == 1 && nrem == 0) continue;
                    const int p0 = P0 + c * HCHUNK_PANELS, np = c == 1 ? nrem : ((P1 - P0) < HCHUNK_PANELS ? (P1 - P0) : HCHUNK_PANELS);
                    const int nd = c == 0 ? nrem * 4 : 0; int xl; FFN_XL(nd, np * 22, xl);
                        { PH_ARGS; bf16* const Hc = c == 1 ? A2 : H; SchedMoe S{(const char*)HX, (const char*)(ws + WS_W13M) + (size_t)mi * 8 * SZ_W13, (const int*)(ws + WS_RSRC), mbase, np, 22, p0, s, 0, SZ_W13, (size_t)256 * DM * 2, WGM_UP, nd, xl}; EpiSwi E{Hc};
                      pg8::gemm_phase<EpiSwi, SchedMoe, true>(lds, DM, DM, DM, S, E); }
                    GRID_BAR();
                    { PH_ARGS; bf16* const Hc = c == 1 ? A2 : H; SchedMoe S{(const char*)Hc, (const char*)(ws + WS_W2M) + (size_t)mi * 8 * SZ_W2, (const int*)(ws + WS_RSRC), mbase, np, 4, p0, s, 1, SZ_W2, (size_t)256 * FF * 2, WGM_DOWN};
                      EpiMoeDown E{XR, MODL + 5 * 1024, (const int*)(ws + WS_RSRC), (const float*)(ws + WS_RGATE)};
                      pg8::gemm_phase<EpiMoeDown, SchedMoe, false>(lds, FF, FF, FF, S, E); }
                    if (c == 0) GRID_BAR(); } }
        }
#undef FFN_XL
    }
    { PH_IDS; final_phase(p, wid, lane); }
#undef GRID_BAR
#undef GRID_BAR_T
#undef BX
#undef VCU
#undef MOD
#undef XR
#undef OUTB
#undef HX
#undef P
#undef H
#undef A2
#undef ZL
#undef GB
#undef MODL
}

extern "C" void kernel_launch(void* const* d_in, const int* in_sizes, int n_in, void* d_out, int out_size, void* d_ws, size_t ws_size, hipStream_t stream) {
    static int ready = 0;
    if (ready == 0) {
        if (n_in != 34 || in_sizes[0] != NB * SEQ * DM || out_size != NB * SEQ * DM || ws_size < WS_END) {
            fprintf(stderr, "kernel_launch: shape/workspace mismatch (n_in %d, x %d, out %d, ws %zu, need %zu); nothing launched\n", n_in, n_in > 0 ? in_sizes[0] : -1, out_size, ws_size, (size_t)WS_END); ready = -1; return; }
        if (hipFuncSetAttribute((const void*)dit_fwd, hipFuncAttributeMaxDynamicSharedMemorySize, LDS_BYTES) != hipSuccess) { fprintf(stderr, "kernel_launch: hipFuncSetAttribute failed\n"); ready = -1; return; }
        int per_cu = 0;
        if (hipOccupancyMaxActiveBlocksPerMultiprocessor(&per_cu, (const void*)dit_fwd, NTHREADS, LDS_BYTES) != hipSuccess || per_cu < 1) fprintf(stderr, "kernel_launch: note: occupancy query reports %d workgroups per CU\n", per_cu);
        (void)hipGetLastError();
        ready = 1;
    }
    if (ready < 0) return;
    if (hipMemsetAsync((char*)d_ws + WS_CTL, 0, (size_t)(CW_BAR + XCD_BAR_WORDS) * 4, stream) != hipSuccess) { fprintf(stderr, "kernel_launch: memset failed\n"); return; }
    Params prm{};
    for (int i = 0; i < 34; ++i) prm.in[i] = (const float*)d_in[i];
    prm.out = (float*)d_out; prm.ws = (unsigned char*)d_ws;
    hipLaunchKernelGGL(dit_fwd, dim3(GRID), dim3(NTHREADS), LDS_BYTES, stream, prm);
    const hipError_t le = hipPeekAtLastError();
    if (le != hipSuccess) fprintf(stderr, "kernel_launch: launch failed: %s\n", hipGetErrorName(le));
}
```
